# Optimizing an MI355X kernel written in HIP

```python
import jax, jax.numpy as jnp
from jax import lax
import numpy as np

D_MODEL = 1024
BATCH = 8
SEQ = 2048
DEPTH = 1
DEC_BATCH = 32
DEC_SEQ = 1
PAST_LEN = 16384
PAGE_SIZE = 128

HEAD_DIM = 64
A_HEADS = 8
A_GROUPS = ((128, 1), (512, 4), (2048, 16))
A_WIDTH = A_HEADS * HEAD_DIM
B_HEADS = D_MODEL // HEAD_DIM
B_WIDTH = B_HEADS * HEAD_DIM
DECAY_LORA = 64
AAA_LORA = 64
GATE_LORA = 160
D_FF = -(-8 * D_MODEL // (3 * 256)) * 256
ROPE_THETA = 10000.0
NORM_EPS = 1e-6
GN_EPS = 64e-5
STREAM_BLOCK = 128
A_COLS = len(A_GROUPS) * 3 * A_WIDTH
SHIFT_COLS = 3 * B_WIDTH + DECAY_LORA + AAA_LORA + GATE_LORA
IN_COLS = A_COLS + SHIFT_COLS + 2 * D_MODEL

kernel_name = 'dilated_window_rwkv7_hybrid_step'


def split_cols(t, sizes):
    offs = [int(o) for o in np.cumsum(sizes)[:-1]]
    return jnp.split(t, offs, axis=-1)


def rms_norm(x, g):
    xf = x.astype(jnp.float32)
    y = xf * lax.rsqrt(jnp.mean(xf * xf, axis=-1, keepdims=True) + NORM_EPS)
    return (y * g.astype(jnp.float32)).astype(x.dtype)


def rope(x, pos):
    half = HEAD_DIM // 2
    freqs = ROPE_THETA ** (-jnp.arange(half, dtype=jnp.float32) / half)
    ang = pos.astype(jnp.float32)[:, None] * freqs[None, :]
    cos = jnp.cos(ang)[:, None, :]
    sin = jnp.sin(ang)[:, None, :]
    xf = x.astype(jnp.float32)
    x1, x2 = xf[..., :half], xf[..., half:]
    return jnp.concatenate([x1 * cos - x2 * sin, x1 * sin + x2 * cos], axis=-1).astype(x.dtype)


def masked_softmax(s, mask):
    s = jnp.where(mask, s, -jnp.inf)
    m = jnp.max(s, axis=-1, keepdims=True)
    p = jnp.exp(s - m)
    den = jnp.sum(p, axis=-1, keepdims=True)
    return p / den, (m + jnp.log(den))[..., 0]


def dilated_window_prompt(q, k, v, window, dilation):
    Bn, T = q.shape[0], q.shape[1]
    L = T // dilation
    nb = -(-L // STREAM_BLOCK)
    Lp = nb * STREAM_BLOCK
    span = window // dilation

    def streams(t):
        t = t.reshape(Bn, L, dilation, A_HEADS, HEAD_DIM).transpose(0, 2, 1, 3, 4)
        return jnp.pad(t, ((0, 0), (0, 0), (0, Lp - L), (0, 0), (0, 0)))

    def band(t):
        tb = jnp.pad(t, ((0, 0), (0, 0), (STREAM_BLOCK, 0), (0, 0), (0, 0)))
        tb = tb.reshape(Bn, dilation, nb + 1, STREAM_BLOCK, A_HEADS, HEAD_DIM)
        return jnp.concatenate([tb[:, :, :-1], tb[:, :, 1:]], axis=3)

    qb = streams(q).reshape(Bn, dilation, nb, STREAM_BLOCK, A_HEADS, HEAD_DIM)
    kb, vb = band(streams(k)), band(streams(v))
    qi = jnp.arange(STREAM_BLOCK)[:, None]
    kj = jnp.arange(2 * STREAM_BLOCK)[None, :]
    dist = qi + STREAM_BLOCK - kj
    blk = jnp.arange(nb)[:, None, None]
    valid = (dist >= 0) & (dist <= span) & ((blk > 0) | (kj >= STREAM_BLOCK))
    s = jnp.einsum('bgnqhd,bgnkhd->bgnhqk', qb.astype(jnp.float32), kb.astype(jnp.float32)) * HEAD_DIM ** -0.5
    p, lse = masked_softmax(s, valid[:, None])
    o = jnp.einsum('bgnhqk,bgnkhd->bgnqhd', p, vb.astype(jnp.float32))
    o = o.reshape(Bn, dilation, Lp, A_HEADS, HEAD_DIM)[:, :, :L]
    o = o.transpose(0, 2, 1, 3, 4).reshape(Bn, T, A_HEADS, HEAD_DIM)
    lse = lse.transpose(0, 1, 2, 4, 3).reshape(Bn, dilation, Lp, A_HEADS)[:, :, :L]
    lse = lse.transpose(0, 2, 1, 3).reshape(Bn, T, A_HEADS)
    return o, lse


def dilated_window_sample(q, k_all, v_all, window, dilation, buf_len):
    T = q.shape[1]
    span = window // dilation
    idx = buf_len + jnp.arange(T)[:, None] - dilation * jnp.arange(span + 1)[None, :]
    valid = idx >= 0
    idx_c = jnp.maximum(idx, 0)
    kg = k_all[:, idx_c].astype(jnp.float32)
    vg = v_all[:, idx_c].astype(jnp.float32)
    s = jnp.einsum('bqhd,bqmhd->bhqm', q.astype(jnp.float32), kg) * HEAD_DIM ** -0.5
    p, lse = masked_softmax(s, valid[None, None])
    o = jnp.einsum('bhqm,bqmhd->bqhd', p, vg)
    return o, lse.transpose(0, 2, 1)


def rwkv7_time_mix(p, prev, wkv0, lw):
    Bn, T = p.shape[0], p.shape[1]
    pf = p.astype(jnp.float32)
    shifted = jnp.concatenate([prev.astype(jnp.float32)[:, None], pf[:, :-1]], axis=1)
    xm = pf + (shifted - pf) * lw['mu_shift']
    r, k, v, xw, xa, xg = split_cols(xm, [B_WIDTH] * 3 + [DECAY_LORA, AAA_LORA, GATE_LORA])
    log_w = -jax.nn.softplus(-(lw['w0'] + jnp.tanh(xw) @ lw['w2'])) - 0.5
    decay = jnp.exp(-jnp.exp(log_w))
    a = jax.nn.sigmoid(lw['a0'] + xa @ lw['a2'])
    gate = jax.nn.sigmoid(xg) @ lw['g2']

    def heads(t):
        return t.reshape(Bn, T, B_HEADS, HEAD_DIM)

    kk = heads(k * lw['k_k'])
    kk = kk / jnp.maximum(jnp.sqrt(jnp.sum(kk * kk, axis=-1, keepdims=True)), 1e-12)
    k = k * (1.0 + (a - 1.0) * lw['k_a'])
    rh, wh, kh, vh, ah = heads(r), heads(decay), heads(k), heads(v), heads(a)

    def step(S, inp):
        r_t, w_t, k_t, v_t, kk_t, a_t = inp
        sa = jnp.einsum('bhij,bhj->bhi', S, -kk_t)
        S = (S * w_t[:, :, None, :] + sa[..., None] * (kk_t * a_t)[:, :, None, :]
             + v_t[..., None] * k_t[:, :, None, :])
        return S, jnp.einsum('bhij,bhj->bhi', S, r_t)

    xs = tuple(jnp.moveaxis(t, 1, 0) for t in (rh, wh, kh, vh, kk, ah))
    S_last, ys = lax.scan(step, wkv0.astype(jnp.float32), xs)
    y = jnp.moveaxis(ys, 0, 1)
    mean = jnp.mean(y, axis=-1, keepdims=True)
    var = jnp.mean(jnp.square(y - mean), axis=-1, keepdims=True)
    yn = ((y - mean) * lax.rsqrt(var + GN_EPS)).reshape(Bn, T, B_WIDTH) * lw['gn_w'] + lw['gn_b']
    bonus = jnp.sum(rh * kh * lw['r_k'], axis=-1, keepdims=True) * vh
    out = (yn + bonus.reshape(Bn, T, B_WIDTH)) * gate
    return out, p[:, -1], S_last


def hybrid_mixer(h, pos, kv_bufs, shift_prev, wkv_prev, lw):
    Bn, T = h.shape[0], h.shape[1]
    proj = jnp.einsum('btd,dc->btc', h, lw['w_in'])
    a_cols, s_cols, gate_a, gate_b = split_cols(proj, [A_COLS, SHIFT_COLS, D_MODEL, D_MODEL])
    a_parts = split_cols(a_cols, [A_WIDTH] * (3 * len(A_GROUPS)))
    outs, lses, new_kv = [], [], []
    for g, (window, dilation) in enumerate(A_GROUPS):
        q, k, v = (t.reshape(Bn, T, A_HEADS, HEAD_DIM) for t in a_parts[3 * g:3 * g + 3])
        q, k = rope(q, pos), rope(k, pos)
        if kv_bufs is None:
            o, lse = dilated_window_prompt(q, k, v, window, dilation)
            keep = min(window, T)
            new_kv.append(jnp.stack([k[:, T - keep:], v[:, T - keep:]], axis=2))
        else:
            buf = kv_bufs[g]
            k_all = jnp.concatenate([buf[:, :, 0], k], axis=1)
            v_all = jnp.concatenate([buf[:, :, 1], v], axis=1)
            o, lse = dilated_window_sample(q, k_all, v_all, window, dilation, buf.shape[1])
            new_kv.append(jnp.stack([k, v], axis=2))
        outs.append(o)
        lses.append(lse)
    alpha = jax.nn.softmax(jnp.stack(lses, axis=0), axis=0)[..., None]
    o_a = jnp.sum(alpha * jnp.stack(outs, axis=0), axis=0).reshape(Bn, T, A_WIDTH)
    o_b, shift_last, wkv_last = rwkv7_time_mix(s_cols, shift_prev, wkv_prev, lw)
    y_a = o_a @ lw['w_proj_a']
    y_b = o_b @ lw['w_proj_b']
    merged = jax.nn.sigmoid(gate_a.astype(jnp.float32)) * y_a + jax.nn.sigmoid(gate_b.astype(jnp.float32)) * y_b
    out = (merged @ lw['w_out']).astype(h.dtype)
    return out, new_kv, shift_last, wkv_last


def trunk_layer(x, pos, kv_bufs, shift_prev, wkv_prev, lw):
    mix, new_kv, shift_last, wkv_last = hybrid_mixer(rms_norm(x, lw['norm_mix']), pos, kv_bufs, shift_prev, wkv_prev, lw)
    x = x + mix
    hn = rms_norm(x, lw['norm_ffn'])
    ffn = (jax.nn.silu(hn @ lw['w_gate']) * (hn @ lw['w_up'])) @ lw['w_down']
    return x + ffn, new_kv, shift_last, wkv_last


def setup_inputs(seed: int = 0) -> dict:
    key = jax.random.key(seed)
    ks = jax.random.split(key, 32)
    nrm = jax.random.normal
    buf_lens = [min(w, PAST_LEN) for (w, _) in A_GROUPS]
    return {
        'x_prompt': nrm(ks[0], (BATCH, SEQ, D_MODEL), jnp.float32),
        'x_sample': nrm(ks[1], (DEC_BATCH, DEC_SEQ, D_MODEL), jnp.float32),
        'cache_kv_g1': nrm(ks[2], (DEPTH, DEC_BATCH, buf_lens[0], 2, A_HEADS, HEAD_DIM), jnp.float32),
        'cache_kv_g2': nrm(ks[3], (DEPTH, DEC_BATCH, buf_lens[1], 2, A_HEADS, HEAD_DIM), jnp.float32),
        'cache_kv_g3': nrm(ks[4], (DEPTH, DEC_BATCH, buf_lens[2], 2, A_HEADS, HEAD_DIM), jnp.float32),
        'state_shift': nrm(ks[5], (DEPTH, DEC_BATCH, SHIFT_COLS), jnp.float32),
        'state_wkv': 0.3 * nrm(ks[6], (DEPTH, DEC_BATCH, B_HEADS, HEAD_DIM, HEAD_DIM), jnp.float32),
        'norm_mix': 1.0 + 0.05 * nrm(ks[7], (DEPTH, D_MODEL), jnp.float32),
        'w_in': nrm(ks[8], (DEPTH, D_MODEL, IN_COLS), jnp.float32) * D_MODEL ** -0.5,
        'mu_shift': jax.random.uniform(ks[9], (DEPTH, SHIFT_COLS), jnp.float32),
        'w0': -1.0 + 0.5 * nrm(ks[10], (DEPTH, B_WIDTH), jnp.float32),
        'w2': 0.5 * nrm(ks[11], (DEPTH, DECAY_LORA, B_WIDTH), jnp.float32) * DECAY_LORA ** -0.5,
        'a0': 0.1 * nrm(ks[12], (DEPTH, B_WIDTH), jnp.float32),
        'a2': 0.5 * nrm(ks[13], (DEPTH, AAA_LORA, B_WIDTH), jnp.float32) * AAA_LORA ** -0.5,
        'g2': nrm(ks[14], (DEPTH, GATE_LORA, B_WIDTH), jnp.float32) * GATE_LORA ** -0.5,
        'k_k': 0.85 + 0.05 * nrm(ks[15], (DEPTH, B_WIDTH), jnp.float32),
        'k_a': 1.0 + 0.05 * nrm(ks[16], (DEPTH, B_WIDTH), jnp.float32),
        'r_k': 0.1 * nrm(ks[17], (DEPTH, B_HEADS, HEAD_DIM), jnp.float32),
        'gn_w': 1.0 + 0.05 * nrm(ks[18], (DEPTH, B_WIDTH), jnp.float32),
        'gn_b': 0.02 * nrm(ks[19], (DEPTH, B_WIDTH), jnp.float32),
        'w_proj_a': nrm(ks[20], (DEPTH, A_WIDTH, D_MODEL), jnp.float32) * A_WIDTH ** -0.5,
        'w_proj_b': nrm(ks[21], (DEPTH, B_WIDTH, D_MODEL), jnp.float32) * B_WIDTH ** -0.5,
        'w_out': nrm(ks[22], (DEPTH, D_MODEL, D_MODEL), jnp.float32) * D_MODEL ** -0.5,
        'norm_ffn': 1.0 + 0.05 * nrm(ks[23], (DEPTH, D_MODEL), jnp.float32),
        'w_gate': nrm(ks[24], (DEPTH, D_MODEL, D_FF), jnp.float32) * D_MODEL ** -0.5,
        'w_up': nrm(ks[25], (DEPTH, D_MODEL, D_FF), jnp.float32) * D_MODEL ** -0.5,
        'w_down': nrm(ks[26], (DEPTH, D_FF, D_MODEL), jnp.float32) * D_FF ** -0.5,
        'norm_final': 1.0 + 0.05 * nrm(ks[27], (D_MODEL,), jnp.float32),
    }


def reference(x_prompt, x_sample, cache_kv_g1, cache_kv_g2, cache_kv_g3, state_shift, state_wkv,
              norm_mix, w_in, mu_shift, w0, w2, a0, a2, g2, k_k, k_a, r_k, gn_w, gn_b,
              w_proj_a, w_proj_b, w_out, norm_ffn, w_gate, w_up, w_down, norm_final):
    Bp, Tp = x_prompt.shape[0], x_prompt.shape[1]
    pos_p = jnp.arange(Tp, dtype=jnp.int32)
    pos_s = PAST_LEN + jnp.arange(x_sample.shape[1], dtype=jnp.int32)
    hp, hs = x_prompt, x_sample
    kv_p, kv_s = ([], [], []), ([], [], [])
    sh_p, sh_s, wkv_p, wkv_s = [], [], [], []
    for l in range(DEPTH):
        lw = {'norm_mix': norm_mix[l], 'w_in': w_in[l], 'mu_shift': mu_shift[l], 'w0': w0[l], 'w2': w2[l],
              'a0': a0[l], 'a2': a2[l], 'g2': g2[l], 'k_k': k_k[l], 'k_a': k_a[l], 'r_k': r_k[l],
              'gn_w': gn_w[l], 'gn_b': gn_b[l], 'w_proj_a': w_proj_a[l], 'w_proj_b': w_proj_b[l],
              'w_out': w_out[l], 'norm_ffn': norm_ffn[l], 'w_gate': w_gate[l], 'w_up': w_up[l],
              'w_down': w_down[l]}
        zero_shift = jnp.zeros((Bp, SHIFT_COLS), x_prompt.dtype)
        zero_wkv = jnp.zeros((Bp, B_HEADS, HEAD_DIM, HEAD_DIM), jnp.float32)
        hp, nkv, nsh, nwkv = trunk_layer(hp, pos_p, None, zero_shift, zero_wkv, lw)
        for g in range(3):
            kv_p[g].append(nkv[g])
        sh_p.append(nsh)
        wkv_p.append(nwkv)
        bufs = (cache_kv_g1[l], cache_kv_g2[l], cache_kv_g3[l])
        hs, nkv, nsh, nwkv = trunk_layer(hs, pos_s, bufs, state_shift[l], state_wkv[l], lw)
        for g in range(3):
            kv_s[g].append(nkv[g])
        sh_s.append(nsh)
        wkv_s.append(nwkv)
    y_prompt = rms_norm(hp, norm_final)
    y_sample = rms_norm(hs, norm_final)
    new_kv_g1_prompt = jnp.stack(kv_p[0], axis=0)
    new_kv_g2_prompt = jnp.stack(kv_p[1], axis=0)
    new_kv_g3_prompt = jnp.stack(kv_p[2], axis=0)
    new_shift_prompt = jnp.stack(sh_p, axis=0)
    new_wkv_prompt = jnp.stack(wkv_p, axis=0)
    new_kv_g1_sample = jnp.stack(kv_s[0], axis=0)
    new_kv_g2_sample = jnp.stack(kv_s[1], axis=0)
    new_kv_g3_sample = jnp.stack(kv_s[2], axis=0)
    new_shift_sample = jnp.stack(sh_s, axis=0)
    new_wkv_sample = jnp.stack(wkv_s, axis=0)
    return (y_prompt, y_sample, new_kv_g1_prompt, new_kv_g2_prompt, new_kv_g3_prompt, new_shift_prompt, new_wkv_prompt,
            new_kv_g1_sample, new_kv_g2_sample, new_kv_g3_sample, new_shift_sample, new_wkv_sample)
```

```cpp
#include <hip/hip_runtime.h>
#include <cstdio>
#include <cstdint>
namespace pg8 {
#define PG8_LAS __attribute__((address_space(3)))
typedef unsigned short bf16_t;
typedef short bf16x8 __attribute__((ext_vector_type(8)));
typedef float f32x4 __attribute__((ext_vector_type(4)));
typedef unsigned u32x4 __attribute__((ext_vector_type(4)));
constexpr int BM = 256, BK = 64, HALF = 128, HTB = HALF * BK * 2  , STAGE_BYTES = 8 * HTB, NXCD = 8, WGM = 8;

__host__ __device__ __forceinline__ int lds_byte(int r, int c) { const int st = (r >> 4) * 2 + (c >> 5), rr = r & 15, cc = c & 31, ob = rr * 64 + cc * 2; return st * 1024 + (ob ^ (((ob >> 9) & 1) << 5)); }
__host__ __device__ __forceinline__ void stage_rc(int b, int& R, int& C) { const int st = b / 1024, sb = b % 1024, swz = sb ^ (((sb >> 9) & 1) << 5); R = (st >> 1) * 16 + swz / 64; C = (st & 1) * 32 + (swz % 64) / 2; }
__host__ __device__ __forceinline__ int perm32(int rho) { const int n = rho >> 4, i = rho & 15; return 8 * (i >> 2) + 4 * n + (i & 3); }

struct Unit { int pm, pn; };
struct Gemm { const bf16_t* A; const bf16_t* Bt; int M, N, K; };

struct StaticOrder {
    int nM, nN, nwg, G, c;
    __host__ __device__ void init(int M, int N, int G_, int c_) { nM = M / BM; nN = N / BM; nwg = nM * nN; G = G_; c = c_; }
    __host__ __device__ bool next(int i, Unit& u) const {
        const long L = (long)i * G + c; if (L >= nwg) return false;
        int wgid = (int)L; { const int q = nwg / NXCD, r = nwg % NXCD, xcd = wgid % NXCD, off = wgid / NXCD; wgid = (xcd < r ? xcd * (q + 1) : r * (q + 1) + (xcd - r) * q) + off; }
        const int nig = WGM * nN, gid = wgid / nig, fm = gid * WGM, gsz = (nM - fm) < WGM ? (nM - fm) : WGM;
        u.pm = fm + ((wgid % nig) % gsz); u.pn = (wgid % nig) / gsz; return true;
    }
    __device__ __forceinline__ void a_ready(const Unit&) const {}
    __device__ __forceinline__ void done(const Unit&) const {}
};

__device__ __forceinline__ unsigned cvt_pk_bf16(float lo, float hi) { unsigned r; asm volatile("v_cvt_pk_bf16_f32 %0, %1, %2" : "=v"(r) : "v"(lo), "v"(hi)); return r; }
template <class Epi, class Sched, bool ALIGN_EPI = false, bool SP2 = false>
__device__ __forceinline__ void gemm_phase(PG8_LAS unsigned char* lds, const Gemm g, const Sched& S, const Epi& E) {
    int tid_ = threadIdx.x; asm volatile("" : "+v"(tid_));
    const int tid = tid_, wid = __builtin_amdgcn_readfirstlane(tid >> 6), lane = tid & 63, wr = wid >> 2, wc = wid & 3, fr = lane & 15, fq = lane >> 4;
    const int K = g.K, nt = K / BK;
    unsigned voffA[2], voffB[2];
#pragma unroll
    for (int i = 0; i < 2; ++i) { int R, C; stage_rc(tid * 16 + i * 8192, R, C); const int Rb = Epi::PERM ? ((R & ~31) + perm32(R & 31)) : R;
        voffA[i] = (unsigned)(R * K + C) * 2u; voffB[i] = (unsigned)(Rb * K + C) * 2u; }
    const size_t kstep = (size_t)(BK * 2);
    const size_t hstep = (size_t)HALF * K * 2;
    const size_t tstep = 2 * hstep;
    const unsigned ldsw = (unsigned)wid * 1024u;
    const int aoff = lds_byte(wr * 64 + fr, fq * 8), boff = lds_byte(wc * 32 + fr, fq * 8);
#define PG8_SA(b, h) (((b) * 2 + (h)) * HTB)
#define PG8_SB(b, h) ((4 + (b) * 2 + (h)) * HTB)
#define PG8_STAGE(bufoff, gbase, voff) do { _Pragma("unroll") for (int _i = 0; _i < 2; ++_i) \
        __builtin_amdgcn_global_load_lds((const unsigned*)((const char*)(gbase) + (voff)[_i]), (PG8_LAS unsigned*)(lds + (bufoff) + ldsw + _i * 8192), 16, 0, 0); } while (0)
#define PG8_LDA(dst, b, h) do { _Pragma("unroll") for (int m = 0; m < 4; ++m) _Pragma("unroll") for (int k = 0; k < 2; ++k) dst[m][k] = *(const PG8_LAS bf16x8*)(lds + PG8_SA(b, h) + aoff + m * 2048 + k * 1024); } while (0)
#define PG8_LDB(dst, b, h) do { _Pragma("unroll") for (int n = 0; n < 2; ++n) _Pragma("unroll") for (int k = 0; k < 2; ++k) dst[n][k] = *(const PG8_LAS bf16x8*)(lds + PG8_SB(b, h) + boff + n * 2048 + k * 1024); } while (0)
#define PG8_MMA(ai, bj, At, Bt) do { __builtin_amdgcn_s_setprio(1); _Pragma("unroll") for (int m = 0; m < 4; ++m) _Pragma("unroll") for (int n = 0; n < 2; ++n) _Pragma("unroll") for (int k = 0; k < 2; ++k) \
        acc[ai][bj][m][n] = __builtin_amdgcn_mfma_f32_16x16x32_bf16(Bt[n][k], At[m][k], acc[ai][bj][m][n], 0, 0, 0); __builtin_amdgcn_s_setprio(0); } while (0)
#define PG8_WAIT_V(n) asm volatile("s_waitcnt vmcnt(" #n ")" ::: "memory")
#define PG8_WAIT_L(n) asm volatile("s_waitcnt lgkmcnt(" #n ")" ::: "memory")
#define PG8_BAR __builtin_amdgcn_s_barrier()
#define PG8_SCHED __builtin_amdgcn_sched_barrier(0)
    Unit cur, nxt; int ui = 0;
    if (!S.next(0, cur)) return;
    f32x4 acc[2][2][4][2];
#pragma unroll
    for (int a = 0; a < 2; ++a)
#pragma unroll
        for (int b = 0; b < 2; ++b)
#pragma unroll
            for (int m = 0; m < 4; ++m)
#pragma unroll
                for (int n = 0; n < 2; ++n) acc[a][b][m][n] = (f32x4){0.f, 0.f, 0.f, 0.f};
    bf16x8 At[4][2], B0[2][2], B1[2][2];
    const char* cA = (const char*)g.A + (size_t)cur.pm * tstep; const char* cB = (const char*)g.Bt + (size_t)cur.pn * tstep;
    S.a_ready(cur);
    if constexpr (SP2) {
        PG8_STAGE(PG8_SB(0, 0), cB, voffB); PG8_STAGE(PG8_SB(0, 1), cB + hstep, voffB); PG8_STAGE(PG8_SA(0, 0), cA, voffA); PG8_STAGE(PG8_SA(0, 1), cA + hstep, voffA);
        if (wr == 1) PG8_BAR;
        PG8_WAIT_V(2); PG8_BAR;
        PG8_STAGE(PG8_SB(1, 0), cB + kstep, voffB); PG8_STAGE(PG8_SA(1, 0), cA + kstep, voffA); PG8_STAGE(PG8_SB(1, 1), cB + hstep + kstep, voffB);
        PG8_WAIT_V(6); PG8_BAR;
    } else {
        PG8_STAGE(PG8_SB(0, 0), cB, voffB); PG8_STAGE(PG8_SA(0, 0), cA, voffA); PG8_STAGE(PG8_SB(0, 1), cB + hstep, voffB); PG8_STAGE(PG8_SA(0, 1), cA + hstep, voffA);
        if (wr == 1) PG8_BAR;
        PG8_WAIT_V(4); PG8_BAR;
        PG8_STAGE(PG8_SB(1, 0), cB + kstep, voffB); PG8_STAGE(PG8_SA(1, 0), cA + kstep, voffA); PG8_STAGE(PG8_SB(1, 1), cB + hstep + kstep, voffB);
        PG8_WAIT_V(6); PG8_BAR;
    }
    for (;;) {
        const bool has_next = S.next(ui + 1, nxt);
        const char* nA = has_next ? (const char*)g.A + (size_t)nxt.pm * tstep : cA; const char* nB = has_next ? (const char*)g.Bt + (size_t)nxt.pn * tstep : cB;
        for (int t = 0; t < nt; t += 2) {
            const bool last = (t == nt - 2);
            const char* a1 = cA + (size_t)(t + 1) * kstep;
            const char* a2 = last ? nA : cA + (size_t)(t + 2) * kstep; const char* b2 = last ? nB : cB + (size_t)(t + 2) * kstep;
            const char* a3 = a2 + kstep; const char* b3 = b2 + kstep;
            if (last && has_next) S.a_ready(nxt);
            if constexpr (SP2) {
            PG8_LDB(B0, 0, 0); PG8_LDB(B1, 0, 1); PG8_SCHED; PG8_LDA(At, 0, 0); PG8_STAGE(PG8_SA(1, 1), a1 + hstep, voffA);
            PG8_WAIT_V(8); PG8_WAIT_L(0); PG8_BAR; PG8_MMA(0, 0, At, B0); PG8_MMA(0, 1, At, B1); PG8_BAR; PG8_SCHED;
            PG8_LDA(At, 0, 1); PG8_STAGE(PG8_SB(0, 0), b2, voffB); PG8_STAGE(PG8_SB(0, 1), b2 + hstep, voffB); PG8_STAGE(PG8_SA(0, 0), a2, voffA);
            PG8_WAIT_V(8); PG8_WAIT_L(0); PG8_BAR; PG8_MMA(1, 0, At, B0); PG8_MMA(1, 1, At, B1); PG8_BAR; PG8_SCHED;
            PG8_LDB(B0, 1, 0); PG8_LDB(B1, 1, 1); PG8_SCHED; PG8_LDA(At, 1, 0); PG8_STAGE(PG8_SA(0, 1), a2 + hstep, voffA);
            PG8_WAIT_V(8); PG8_WAIT_L(0); PG8_BAR; PG8_MMA(0, 0, At, B0); PG8_MMA(0, 1, At, B1); PG8_BAR; PG8_SCHED;
            PG8_LDA(At, 1, 1); PG8_STAGE(PG8_SB(1, 0), b3, voffB); PG8_STAGE(PG8_SB(1, 1), b3 + hstep, voffB); PG8_STAGE(PG8_SA(1, 0), a3, voffA);
            PG8_WAIT_V(8); PG8_WAIT_L(0); PG8_BAR; PG8_MMA(1, 0, At, B0); PG8_MMA(1, 1, At, B1); PG8_BAR; PG8_SCHED;
            } else {
            PG8_LDB(B0, 0, 0); PG8_SCHED; PG8_LDA(At, 0, 0); PG8_STAGE(PG8_SA(1, 1), a1 + hstep, voffA);
            PG8_WAIT_L(8); PG8_BAR; PG8_WAIT_L(0); PG8_MMA(0, 0, At, B0); PG8_BAR; PG8_SCHED;
            PG8_LDB(B1, 0, 1); PG8_STAGE(PG8_SB(0, 0), b2, voffB);
            PG8_BAR; PG8_WAIT_L(0); PG8_MMA(0, 1, At, B1); PG8_BAR;
            PG8_LDA(At, 0, 1); PG8_STAGE(PG8_SA(0, 0), a2, voffA);
            PG8_BAR; PG8_WAIT_L(0); PG8_MMA(1, 0, At, B0); PG8_BAR; PG8_SCHED;
            PG8_STAGE(PG8_SB(0, 1), b2 + hstep, voffB);
            PG8_WAIT_V(6); PG8_BAR; PG8_MMA(1, 1, At, B1); PG8_BAR;
            PG8_LDB(B0, 1, 0); PG8_SCHED; PG8_LDA(At, 1, 0); PG8_STAGE(PG8_SA(0, 1), a2 + hstep, voffA);
            PG8_WAIT_L(8); PG8_BAR; PG8_WAIT_L(0); PG8_MMA(0, 0, At, B0); PG8_BAR; PG8_SCHED;
            PG8_LDB(B1, 1, 1); PG8_STAGE(PG8_SB(1, 0), b3, voffB);
            PG8_BAR; PG8_WAIT_L(0); PG8_MMA(0, 1, At, B1); PG8_BAR;
            PG8_LDA(At, 1, 1); PG8_STAGE(PG8_SA(1, 0), a3, voffA);
            PG8_BAR; PG8_WAIT_L(0); PG8_MMA(1, 0, At, B0); PG8_BAR; PG8_SCHED;
            PG8_STAGE(PG8_SB(1, 1), b3 + hstep, voffB);
            PG8_WAIT_V(6); PG8_BAR; PG8_MMA(1, 1, At, B1); PG8_BAR;
            }
        }
        if constexpr (ALIGN_EPI) { if (wr == 0) PG8_BAR; }
        if constexpr (!Epi::AFTER_DRAIN) { E(acc, cur, wr, wc, fr, fq); S.done(cur); }
        if (!has_next) break;
#pragma unroll
        for (int a = 0; a < 2; ++a)
#pragma unroll
            for (int b = 0; b < 2; ++b)
#pragma unroll
                for (int m = 0; m < 4; ++m)
#pragma unroll
                    for (int n = 0; n < 2; ++n) acc[a][b][m][n] = (f32x4){0.f, 0.f, 0.f, 0.f};
        cur = nxt; cA = nA; cB = nB; ++ui;
        if constexpr (ALIGN_EPI) { if (wr == 1) PG8_BAR; }
    }
    PG8_WAIT_V(0);
    if constexpr (!ALIGN_EPI) { if (wr == 0) PG8_BAR; }
    PG8_BAR;
    if constexpr (Epi::AFTER_DRAIN) { E.fused(acc, cur, wr, wc, fr, fq, lds, wid, lane); S.done(cur); }
#undef PG8_SA
#undef PG8_SB
#undef PG8_STAGE
#undef PG8_LDA
#undef PG8_LDB
#undef PG8_MMA
#undef PG8_WAIT_V
#undef PG8_WAIT_L
#undef PG8_BAR
#undef PG8_SCHED
}
}

constexpr int NWAVES = 8;
constexpr int DM = 1024, NB = 8, T = 2048, M = NB * T;
constexpr int SB = 32;
constexpr int PAST = 16384;
constexpr int HD = 64, AHEADS = 8, AWID = 512, BHEADS = 16, BWID = 1024;
constexpr int ACOLS = 4608, SCOLS = 3360, SCP = 3584, INCOLS = 10016, INP = 10240;
constexpr int DFF = 2816, GU = 2 * DFF;
constexpr float NORM_EPS = 1e-6f, GN_EPS = 64e-5f;
constexpr float LOG2E = 1.4426950408889634f, LN2 = 0.6931471805599453f;
constexpr float QSCALE = 0.125f * LOG2E;
constexpr size_t O_YP = 0, O_YS = O_YP + (size_t)M * DM, O_KV1P = O_YS + (size_t)SB * DM, O_KV2P = O_KV1P + (size_t)NB * 128 * 1024,
                 O_KV3P = O_KV2P + (size_t)NB * 512 * 1024, O_SHP = O_KV3P + (size_t)NB * 2048 * 1024, O_WKVP = O_SHP + (size_t)NB * SCOLS,
                 O_KV1S = O_WKVP + (size_t)NB * 16 * 4096, O_KV2S = O_KV1S + (size_t)SB * 1024, O_KV3S = O_KV2S + (size_t)SB * 1024,
                 O_SHS = O_KV3S + (size_t)SB * 1024, O_WKVS = O_SHS + (size_t)SB * SCOLS, O_END = O_WKVS + (size_t)SB * 16 * 4096;
static_assert(O_END == 41684224, "output size");
constexpr size_t MiB = 1u << 20;
constexpr size_t WS_CTL = 0, CTL_ZERO_BYTES = 1 * MiB;
constexpr size_t WS_TAB = 1 * MiB;
constexpr size_t WS_SS = 2 * MiB;
constexpr size_t WS_SS2 = WS_SS + 128 * 1024;
constexpr size_t WS_SMP = 3 * MiB;
constexpr size_t WS_WIN = 8 * MiB, WS_WA = 28 * MiB, WS_WB = 29 * MiB, WS_WO = 31 * MiB, WS_WGU = 33 * MiB, WS_WD = 44 * MiB, WS_WWA = 50 * MiB, WS_WG = 51 * MiB;
constexpr size_t WS_XN = 52 * MiB, WS_Q = 84 * MiB, WS_K = 132 * MiB, WS_VT = 180 * MiB, WS_SC = 228 * MiB, WS_GT = 340 * MiB;
constexpr size_t WS_OG = 404 * MiB, WS_LSE = 452 * MiB, WS_OA = 454 * MiB, WS_A1 = 470 * MiB, WS_A2 = 474 * MiB;
constexpr size_t WS_E = 482 * MiB, WS_AV = 514 * MiB, WS_GATE = 546 * MiB, WS_Y = 578 * MiB, WS_CB = 642 * MiB, WS_OB = 643 * MiB;
constexpr size_t WS_Y1 = 675 * MiB, WS_MG = 739 * MiB, WS_X1 = 771 * MiB, WS_X1B = 835 * MiB, WS_END = 867 * MiB;
constexpr size_t WS_ACT = WS_Q;
static_assert((size_t)M * DFF * 2 <= WS_VT - WS_Q, "ACT overlay");
constexpr size_t SM_HSN = 0;
constexpr size_t SM_PROJ = 64 * 1024;
constexpr size_t SM_OA = SM_PROJ + (size_t)SB * INP * 4;
constexpr size_t SM_OB = SM_OA + 32 * 1024;
constexpr size_t SM_YA = SM_OB + 64 * 1024;
constexpr size_t SM_YB = SM_YA + 128 * 1024;
constexpr size_t SM_X1 = SM_YB + 128 * 1024;
constexpr size_t SM_X1B = SM_X1 + 128 * 1024;
constexpr size_t SM_ACT = SM_X1B + 64 * 1024;
constexpr size_t SM_X2 = SM_ACT + 192 * 1024;
constexpr size_t SM_OG = SM_X2 + 128 * 1024;
constexpr size_t SM_LSE = SM_OG + 192 * 1024;
constexpr size_t SM_END = SM_LSE + 4096;
static_assert(SM_END <= 5 * MiB, "sample scratch");
constexpr int CW_BAR = 4096;
constexpr int RING_OFF = 0, RING_BYTES = 131072, LDSCTL_OFF = RING_BYTES, MISC_OFF = LDSCTL_OFF + 320, LDS_BYTES = 147456;

#define GAS __attribute__((address_space(1)))
#define LAS __attribute__((address_space(3)))
typedef unsigned short bf16;
typedef unsigned v4u __attribute__((ext_vector_type(4)));
typedef float f32x4 __attribute__((ext_vector_type(4)));
typedef short bf16x8 __attribute__((ext_vector_type(8)));
typedef GAS unsigned gu32;
typedef GAS unsigned long long gu64;
#define RLX_AGENT __ATOMIC_RELAXED, __HIP_MEMORY_SCOPE_AGENT
#define LDS_WAIT() asm volatile("s_waitcnt lgkmcnt(0)" ::: "memory")
#define VM_WAIT() asm volatile("s_waitcnt vmcnt(0)" ::: "memory")
__device__ __forceinline__ unsigned long long rt() { return __builtin_amdgcn_s_memrealtime(); }
__device__ __forceinline__ unsigned f2bf(float f) { unsigned u = __builtin_bit_cast(unsigned, f); return (u + 0x7fffu + ((u >> 16) & 1u)) >> 16; }
__device__ __forceinline__ unsigned pk2(float lo, float hi) { return f2bf(lo) | (f2bf(hi) << 16); }

#define XB_TMO      128
#define XB_XCNT(j)  (256  + 64 * (j))
#define XB_XSUB(j)  (1280 + 64 * (j))
#define XB_XGEN(j)  (2304 + 64 * (j))
#define XB_TOP      3328
#define XB_TOPGEN   3392
#define XCD_BAR_WORDS 3456
#define XB_SPIN_CAP (1u << 18)

__device__ __forceinline__ unsigned xb_ld(unsigned* p)              { return __hip_atomic_load(p, __ATOMIC_RELAXED, __HIP_MEMORY_SCOPE_AGENT); }
__device__ __forceinline__ unsigned xb_add(unsigned* p, unsigned v) { return __hip_atomic_fetch_add(p, v, __ATOMIC_RELAXED, __HIP_MEMORY_SCOPE_AGENT); }
__device__ __forceinline__ unsigned xb_xcc_id() { return (unsigned)__builtin_amdgcn_s_getreg((3 << 11) | 20) & 0xFu; }
#define XB_SPIN(cond, bar) do { unsigned _sp = 0; while (cond) { __builtin_amdgcn_s_sleep(1); \
    if ((++_sp & 255u) == 0u) { if (xb_ld(&(bar)[XB_TMO])) break; if (_sp > XB_SPIN_CAP) { atomicAdd(&(bar)[XB_TMO], 1u); break; } } } } while (0)

struct XcdBarrier {
    unsigned* bar; unsigned x;
    volatile LAS unsigned* st;
};

__device__ __forceinline__ XcdBarrier xcd_barrier_post(unsigned* bar, volatile LAS unsigned* st) {
    XcdBarrier b; b.bar = bar; b.x = xb_xcc_id(); b.st = st;
    if (threadIdx.x == 0) (void)xb_add(&bar[XB_XCNT(b.x)], 1u);
    return b;
}
__device__ __forceinline__ void xcd_barrier_complete(unsigned* bar, unsigned x, unsigned& nloc, unsigned& nx) {
    const unsigned G = gridDim.x * gridDim.y * gridDim.z;
    unsigned sum, cnt, mine, sp = 0u;
    for (;;) {
        sum = 0u; cnt = 0u; mine = 0u;
#pragma unroll
        for (unsigned j = 0; j < 16; ++j) { const unsigned c = xb_ld(&bar[XB_XCNT(j)]); sum += c; cnt += (c > 0u) ? 1u : 0u; mine = (j == x) ? c : mine; }
        if (sum == G) break;
        __builtin_amdgcn_s_sleep(1);
        if ((++sp & 255u) == 0u) { if (xb_ld(&bar[XB_TMO])) break; if (sp > XB_SPIN_CAP) { atomicAdd(&bar[XB_TMO], 1u); break; } }
    }
    nloc = mine > 0u ? mine : 1u; nx = cnt > 0u ? cnt : 1u;
}

__device__ __forceinline__ void xcd_barrier(const XcdBarrier& b) {
    asm volatile("s_waitcnt vmcnt(0)" ::: "memory");
    __syncthreads();
    if (threadIdx.x == 0) {
        unsigned* bar = b.bar;
        __builtin_amdgcn_s_waitcnt(0);
        unsigned nloc = b.st[0], nx = b.st[1];
        if (nloc == 0u) { xcd_barrier_complete(bar, b.x, nloc, nx); b.st[0] = nloc; b.st[1] = nx; }
        const unsigned old = xb_add(&bar[XB_XSUB(b.x)], 1u);
        const unsigned gen = old / nloc;
        if (old + 1u == (gen + 1u) * nloc) {
            __builtin_amdgcn_fence(__ATOMIC_RELEASE, "agent");
            asm volatile("s_waitcnt vmcnt(0)" ::: "memory");
            const unsigned og = xb_add(&bar[XB_TOP], 1u);
            const unsigned tg = og / nx;
            if (og + 1u == (tg + 1u) * nx) xb_add(&bar[XB_TOPGEN], 1u);
            else XB_SPIN(xb_ld(&bar[XB_TOPGEN]) == tg, bar);
            __builtin_amdgcn_fence(__ATOMIC_ACQUIRE, "agent");
            xb_add(&bar[XB_XGEN(b.x)], 1u);
            asm volatile("s_waitcnt vmcnt(0)" ::: "memory");
        } else {
            XB_SPIN(xb_ld(&bar[XB_XGEN(b.x)]) == gen, bar);
            __builtin_amdgcn_fence(__ATOMIC_ACQUIRE, "agent");
            asm volatile("s_waitcnt vmcnt(0)" ::: "memory");
        }
    }
    __syncthreads();
}

struct Args { const float* in[28]; float* out; unsigned char* ws; };
enum { I_XP = 0, I_XS, I_C1, I_C2, I_C3, I_SSH, I_SWKV, I_NMIX, I_WIN, I_MU, I_W0, I_W2, I_A0, I_A2, I_G2, I_KK, I_KA, I_RK, I_GNW, I_GNB,
       I_WPA, I_WPB, I_WOUT, I_NFFN, I_WGATE, I_WUP, I_WDOWN, I_NFIN };
typedef float f32x2 __attribute__((ext_vector_type(2)));
typedef unsigned u32x2 __attribute__((ext_vector_type(2)));

__device__ __forceinline__ float wave_sum(float v) {
#pragma unroll
    for (int o = 1; o < 64; o <<= 1) v += __shfl_xor(v, o);
    return v;
}
__device__ __forceinline__ float bf2f(unsigned short h) { return __builtin_bit_cast(float, (unsigned)h << 16); }
__device__ __forceinline__ float bflo(unsigned w) { return __builtin_bit_cast(float, w << 16); }
__device__ __forceinline__ float bfhi(unsigned w) { return __builtin_bit_cast(float, w & 0xffff0000u); }
__device__ __forceinline__ float sigmoidf_(float x) { return 1.0f / (1.0f + __expf(-x)); }

__device__ const float ROPE_FREQ[32] = {
    1.000000000e+00f, 7.498942614e-01f, 5.623413324e-01f, 4.216965139e-01f, 3.162277639e-01f, 2.371373773e-01f, 1.778279394e-01f, 1.333521307e-01f,
    1.000000015e-01f, 7.498941571e-02f, 5.623413250e-02f, 4.216965288e-02f, 3.162277490e-02f, 2.371373773e-02f, 1.778279431e-02f, 1.333521493e-02f,
    9.999999776e-03f, 7.498941850e-03f, 5.623413250e-03f, 4.216964822e-03f, 3.162277630e-03f, 2.371373586e-03f, 1.778279431e-03f, 1.333521446e-03f,
    1.000000047e-03f, 7.498942432e-04f, 5.623413017e-04f, 4.216965172e-04f, 3.162277571e-04f, 2.371373703e-04f, 1.778279402e-04f, 1.333521504e-04f};
__device__ __forceinline__ void sincos_acc(float xf, float& s, float& c) {
    const double x = (double)xf;
    const double q = __builtin_rint(x * 0.63661977236758134308);
    double r = __builtin_fma(-q, 1.57079632679489655800e+00, x); r = __builtin_fma(-q, 6.12323399573676603587e-17, r);
    const double r2 = r * r;
    double sp = -1.0 / 1307674368000.0; sp = sp * r2 + 1.0 / 6227020800.0; sp = sp * r2 - 1.0 / 39916800.0; sp = sp * r2 + 1.0 / 362880.0; sp = sp * r2 - 1.0 / 5040.0; sp = sp * r2 + 1.0 / 120.0; sp = sp * r2 - 1.0 / 6.0; sp = sp * r2 + 1.0; sp *= r;
    double cp = 1.0 / 20922789888000.0; cp = cp * r2 - 1.0 / 87178291200.0; cp = cp * r2 + 1.0 / 479001600.0; cp = cp * r2 - 1.0 / 3628800.0; cp = cp * r2 + 1.0 / 40320.0; cp = cp * r2 - 1.0 / 720.0; cp = cp * r2 + 1.0 / 24.0; cp = cp * r2 - 0.5; cp = cp * r2 + 1.0;
    const int qi = (int)((long long)q & 3);
    const double ss = (qi & 1) ? cp : sp, cc = (qi & 1) ? sp : cp;
    s = (float)((qi & 2) ? -ss : ss);
    c = (float)(((qi + 1) & 2) ? -cc : cc);
}

template <class Src> __device__ __forceinline__ void tr_item(const Src& src, bf16* WT, int Kd, LAS float* scr, int k0, int n0, int lane) {
#pragma unroll 8
    for (int i = 0; i < 32; ++i) { const int kk = 2 * i + (lane >> 5); scr[kk * 33 + (lane & 31)] = src(k0 + kk, n0 + (lane & 31)); }
    LDS_WAIT(); asm volatile("" ::: "memory");
    const int c = lane & 7;
#pragma unroll
    for (int j = 0; j < 4; ++j) { const int n = (lane >> 3) + 8 * j; const LAS float* s = scr + (8 * c) * 33 + n;
        v4u o; o.x = pk2(s[0 * 33], s[1 * 33]); o.y = pk2(s[2 * 33], s[3 * 33]); o.z = pk2(s[4 * 33], s[5 * 33]); o.w = pk2(s[6 * 33], s[7 * 33]);
        *(GAS v4u*)(WT + (size_t)(n0 + n) * Kd + k0 + 8 * c) = o; }
    LDS_WAIT(); asm volatile("" ::: "memory");
}
__device__ __forceinline__ int win_src_col(int np) {
    if (np < ACOLS) { const int part = np >> 9, kind = part % 3, within = np & 511, head = within >> 6, pos = within & 63;
        const int d = (kind < 2) ? ((pos & 1) * 32 + (pos >> 1)) : pos; return part * 512 + head * 64 + d; }
    if (np < ACOLS + SCP) { const int j = np - ACOLS; return j < SCOLS ? ACOLS + j : -1; }
    return ACOLS + SCOLS + (np - (ACOLS + SCP));
}

struct EpiIn {
    static constexpr bool PERM = true, AFTER_DRAIN = false;
    bf16* Q; bf16* Kb; bf16* VT; bf16* SC; bf16* GT; float* out; const float* rope;
    __device__ __forceinline__ void operator()(const pg8::f32x4 (&acc)[2][2][4][2], const pg8::Unit& u, int wr, int wc, int fr, int fq) const {
        const int tn = u.pn;
        const int rowb = u.pm * 256 + wr * 64 + fr;
        if (tn < 18) {
            const int part = tn >> 1, g = part / 3, kind = part - 3 * g, hf = tn & 1;
            const int lgd = 2 * g, dil = 1 << lgd, L = T >> lgd, keep = (g == 0) ? 128 : (g == 1) ? 512 : 2048;
            const size_t okv = (g == 0) ? O_KV1P : (g == 1) ? O_KV2P : O_KV3P;
            const int pos0 = 32 * (wc & 1) + 8 * fq;
#pragma unroll
            for (int ai = 0; ai < 2; ++ai)
#pragma unroll
                for (int m = 0; m < 4; ++m) {
                    const int row = rowb + ai * 128 + m * 16, b = row >> 11, t = row & (T - 1);
                    const int p = (t & (dil - 1)) * L + (t >> lgd);
                    const size_t prow = (size_t)g * M + (size_t)b * T + p;
                    const int tk = t - (T - keep);
                    if (kind < 2) {
                        const int i0 = pos0 >> 1;
                        const pg8::f32x4 cs0 = *(const pg8::f32x4*)(rope + ((size_t)t * 32 + i0) * 2), cs1 = *(const pg8::f32x4*)(rope + ((size_t)t * 32 + i0 + 2) * 2);
#pragma unroll
                        for (int bj = 0; bj < 2; ++bj) {
                            const int head = 4 * hf + 2 * bj + (wc >> 1);
                            const pg8::f32x4 v0 = acc[ai][bj][m][0], v1 = acc[ai][bj][m][1];
                            float o[8];
                            o[0] = v0[0] * cs0[0] - v0[1] * cs0[1]; o[1] = v0[0] * cs0[1] + v0[1] * cs0[0];
                            o[2] = v0[2] * cs0[2] - v0[3] * cs0[3]; o[3] = v0[2] * cs0[3] + v0[3] * cs0[2];
                            o[4] = v1[0] * cs1[0] - v1[1] * cs1[1]; o[5] = v1[0] * cs1[1] + v1[1] * cs1[0];
                            o[6] = v1[2] * cs1[2] - v1[3] * cs1[3]; o[7] = v1[2] * cs1[3] + v1[3] * cs1[2];
                            if (kind == 0) {
                                pg8::u32x4 w; w.x = pg8::cvt_pk_bf16(o[0] * QSCALE, o[1] * QSCALE); w.y = pg8::cvt_pk_bf16(o[2] * QSCALE, o[3] * QSCALE);
                                w.z = pg8::cvt_pk_bf16(o[4] * QSCALE, o[5] * QSCALE); w.w = pg8::cvt_pk_bf16(o[6] * QSCALE, o[7] * QSCALE);
                                *(pg8::u32x4*)(Q + prow * 512 + head * 64 + pos0) = w;
                            } else {
                                pg8::u32x4 w; w.x = pg8::cvt_pk_bf16(o[0], o[1]); w.y = pg8::cvt_pk_bf16(o[2], o[3]); w.z = pg8::cvt_pk_bf16(o[4], o[5]); w.w = pg8::cvt_pk_bf16(o[6], o[7]);
                                *(pg8::u32x4*)(Kb + prow * 512 + head * 64 + pos0) = w;
                                if (tk >= 0) { float* ob = out + okv + (((size_t)b * keep + tk) * 2 + 0) * 512 + head * 64;
                                    *(pg8::f32x4*)(ob + i0) = (pg8::f32x4){o[0], o[2], o[4], o[6]}; *(pg8::f32x4*)(ob + 32 + i0) = (pg8::f32x4){o[1], o[3], o[5], o[7]}; }
                            }
                        }
                    } else {
#pragma unroll
                        for (int bj = 0; bj < 2; ++bj) {
                            const int head = 4 * hf + 2 * bj + (wc >> 1);
                            const pg8::f32x4 v0 = acc[ai][bj][m][0], v1 = acc[ai][bj][m][1];
                            bf16* vt = VT + (((size_t)g * NB + b) * 8 + head) * 64 * T + (size_t)pos0 * T + p;
                            const unsigned w0 = pg8::cvt_pk_bf16(v0[0], v0[1]), w1 = pg8::cvt_pk_bf16(v0[2], v0[3]), w2 = pg8::cvt_pk_bf16(v1[0], v1[1]), w3 = pg8::cvt_pk_bf16(v1[2], v1[3]);
                            vt[0 * T] = (bf16)(w0 & 0xffff); vt[1 * T] = (bf16)(w0 >> 16); vt[2 * T] = (bf16)(w1 & 0xffff); vt[3 * T] = (bf16)(w1 >> 16);
                            vt[4 * T] = (bf16)(w2 & 0xffff); vt[5 * T] = (bf16)(w2 >> 16); vt[6 * T] = (bf16)(w3 & 0xffff); vt[7 * T] = (bf16)(w3 >> 16);
                            if (tk >= 0) { float* ob = out + okv + (((size_t)b * keep + tk) * 2 + 1) * 512 + head * 64 + pos0;
                                *(pg8::f32x4*)(ob) = v0; *(pg8::f32x4*)(ob + 4) = v1; }
                        }
                    }
                }
        } else if (tn < 32) {
            const int cb = (tn - 18) * 256 + wc * 32 + 8 * fq;
#pragma unroll
            for (int ai = 0; ai < 2; ++ai)
#pragma unroll
                for (int m = 0; m < 4; ++m) {
                    const int row = rowb + ai * 128 + m * 16, b = row >> 11, t = row & (T - 1);
#pragma unroll
                    for (int bj = 0; bj < 2; ++bj) {
                        const int col = cb + bj * 128;
                        const pg8::f32x4 v0 = acc[ai][bj][m][0], v1 = acc[ai][bj][m][1];
                        pg8::u32x4 w; w.x = pg8::cvt_pk_bf16(v0[0], v0[1]); w.y = pg8::cvt_pk_bf16(v0[2], v0[3]); w.z = pg8::cvt_pk_bf16(v1[0], v1[1]); w.w = pg8::cvt_pk_bf16(v1[2], v1[3]);
                        *(pg8::u32x4*)(SC + (size_t)row * SCP + col) = w;
                        if (t == T - 1 && col < SCOLS) { float* ob = out + O_SHP + (size_t)b * SCOLS + col; *(pg8::f32x4*)(ob) = v0; *(pg8::f32x4*)(ob + 4) = v1; }
                    }
                }
        } else {
            const int cb = (tn - 32) * 256 + wc * 32 + 8 * fq;
#pragma unroll
            for (int ai = 0; ai < 2; ++ai)
#pragma unroll
                for (int m = 0; m < 4; ++m) {
                    const int row = rowb + ai * 128 + m * 16;
#pragma unroll
                    for (int bj = 0; bj < 2; ++bj) {
                        const int col = cb + bj * 128;
                        const pg8::f32x4 v0 = acc[ai][bj][m][0], v1 = acc[ai][bj][m][1];
                        pg8::u32x4 w; w.x = pg8::cvt_pk_bf16(sigmoidf_(v0[0]), sigmoidf_(v0[1])); w.y = pg8::cvt_pk_bf16(sigmoidf_(v0[2]), sigmoidf_(v0[3]));
                        w.z = pg8::cvt_pk_bf16(sigmoidf_(v1[0]), sigmoidf_(v1[1])); w.w = pg8::cvt_pk_bf16(sigmoidf_(v1[2]), sigmoidf_(v1[3]));
                        *(pg8::u32x4*)(GT + (size_t)row * 2048 + col) = w;
                    }
                }
        }
    }
};

__device__ __forceinline__ int opaque_int(int v) { asm volatile("" : "+s"(v)); return v; }
struct Frame {
    LAS unsigned char* lds; volatile LAS unsigned* MISC; gu32* ctl;
    int tid, lane, wave, vcu, G, gw, NGW;
};

__device__ __forceinline__ void p0_prologue(const Frame& F, const Args& a, unsigned char* ws) {
    LAS float* scr = (LAS float*)(F.lds + RING_OFF + F.wave * 16384);
    const int gw = F.gw, NGW = F.NGW, lane = F.lane;
    constexpr int IT_WIN = 16 * (INP / 32), IT_WA = 8 * 32, IT_WB = 16 * 32, IT_WO = 16 * 32, IT_WGU = 16 * (GU / 32), IT_WD = 44 * 32, IT_WWA = 2 * 64, IT_WG = 4 * 32;
    constexpr int NITEMS = IT_WIN + IT_WA + IT_WB + IT_WO + IT_WGU + IT_WD + IT_WWA + IT_WG;
    for (int it = gw; it < NITEMS; it += NGW) {
        int r = it;
        if (r < IT_WIN) { const int nb = r % (INP / 32), kb = r / (INP / 32); const float* W = a.in[I_WIN];
            tr_item([&](int k, int np) { const int sc = win_src_col(np); return sc >= 0 ? W[(size_t)k * INCOLS + sc] : 0.f; }, (bf16*)(ws + WS_WIN), DM, scr, 64 * kb, 32 * nb, lane); continue; }
        r -= IT_WIN;
        if (r < IT_WA) { const int nb = r % 32, kb = r / 32; const float* W = a.in[I_WPA];
            tr_item([&](int k, int n) { return W[(size_t)k * DM + n]; }, (bf16*)(ws + WS_WA), AWID, scr, 64 * kb, 32 * nb, lane); continue; }
        r -= IT_WA;
        if (r < IT_WB) { const int nb = r % 32, kb = r / 32; const float* W = a.in[I_WPB];
            tr_item([&](int k, int n) { return W[(size_t)k * DM + n]; }, (bf16*)(ws + WS_WB), BWID, scr, 64 * kb, 32 * nb, lane); continue; }
        r -= IT_WB;
        if (r < IT_WO) { const int nb = r % 32, kb = r / 32; const float* W = a.in[I_WOUT];
            tr_item([&](int k, int n) { return W[(size_t)k * DM + n]; }, (bf16*)(ws + WS_WO), DM, scr, 64 * kb, 32 * nb, lane); continue; }
        r -= IT_WO;
        if (r < IT_WGU) { const int nb = r % (GU / 32), kb = r / (GU / 32); const int n0 = 32 * nb, tile = n0 >> 8, w0 = n0 & 255;
            const float* W = (w0 < 128) ? a.in[I_WGATE] : a.in[I_WUP]; const float* gsc = a.in[I_NFFN]; const int cbase = tile * 128 + (w0 & 127) - n0;
            tr_item([&](int k, int np) { return W[(size_t)k * DFF + cbase + np] * gsc[k]; }, (bf16*)(ws + WS_WGU), DM, scr, 64 * kb, n0, lane); continue; }
        r -= IT_WGU;
        if (r < IT_WD) { const int nb = r % 32, kb = r / 32; const float* W = a.in[I_WDOWN];
            tr_item([&](int k, int n) { return W[(size_t)k * DM + n]; }, (bf16*)(ws + WS_WD), DFF, scr, 64 * kb, 32 * nb, lane); continue; }
        r -= IT_WD;
        if (r < IT_WWA) { const int nb = r % 64, kb = r / 64; const float* W2 = a.in[I_W2]; const float* A2 = a.in[I_A2];
            tr_item([&](int k, int n) { return (n < 1024) ? (k < 64 ? W2[(size_t)k * BWID + n] : 0.f) : (k >= 64 ? A2[(size_t)(k - 64) * BWID + (n - 1024)] : 0.f); }, (bf16*)(ws + WS_WWA), 128, scr, 64 * kb, 32 * nb, lane); continue; }
        r -= IT_WWA;
        { const int nb = r % 32, kb = r / 32; const float* G2 = a.in[I_G2];
            tr_item([&](int k, int n) { return k < 160 ? G2[(size_t)k * BWID + n] : 0.f; }, (bf16*)(ws + WS_WG), 256, scr, 64 * kb, 32 * nb, lane); }
    }
    {
        const float* gmix = a.in[I_NMIX];
        f32x4 gv[4];
#pragma unroll
        for (int j = 0; j < 4; ++j) gv[j] = *(const f32x4*)(gmix + 4 * lane + 256 * j);
        for (int m = gw; m < M + SB; m += NGW) {
            const float* xrow = (m < M) ? a.in[I_XP] + (size_t)m * DM : a.in[I_XS] + (size_t)(m - M) * DM;
            bf16* orow = (m < M) ? (bf16*)(ws + WS_XN) + (size_t)m * DM : (bf16*)(ws + WS_SMP + SM_HSN) + (size_t)(m - M) * DM;
            const GAS f32x4* xr = (const GAS f32x4*)xrow + lane;
            f32x4 v[4]; float s = 0.f;
#pragma unroll
            for (int j = 0; j < 4; ++j) { v[j] = xr[64 * j]; s += (v[j].x * v[j].x + v[j].y * v[j].y) + (v[j].z * v[j].z + v[j].w * v[j].w); }
            const float rstd = 1.0f / sqrtf(wave_sum(s) * (1.f / DM) + NORM_EPS);
            GAS unsigned long long* o8 = (GAS unsigned long long*)orow + lane;
#pragma unroll
            for (int j = 0; j < 4; ++j) { const f32x4 y = v[j] * rstd * gv[j]; o8[64 * j] = (unsigned long long)pk2(y.x, y.y) | ((unsigned long long)pk2(y.z, y.w) << 32); }
        }
    }
    {
        float* tab = (float*)(ws + WS_TAB);
        for (int e = F.vcu * 512 + F.tid; e < 2049 * 32; e += F.G * 512) {
            const int pi = e >> 5, i = e & 31; const float pos = (pi < 2048) ? (float)pi : (float)PAST;
            const float ang = pos * ROPE_FREQ[i]; float s, c; sincos_acc(ang, s, c);
            *(f32x2*)(tab + 2 * (size_t)e) = (f32x2){c, s};
        }
    }
    {
        float* ss = (float*)(ws + WS_SS);
        for (int e = F.vcu * 512 + F.tid; e < 65536; e += F.G * 512) ss[e] = 0.f;
    }
}


typedef float f32x16 __attribute__((ext_vector_type(16)));
__device__ __forceinline__ float dpp_f(float v, const int ctrl_sel) {
    const int x = __builtin_bit_cast(int, v); int r;
    if (ctrl_sel == 0) r = __builtin_amdgcn_update_dpp(0, x, 0xB1, 0xF, 0xF, true);
    else if (ctrl_sel == 1) r = __builtin_amdgcn_update_dpp(0, x, 0x4E, 0xF, 0xF, true);
    else if (ctrl_sel == 2) r = __builtin_amdgcn_update_dpp(0, x, 0x141, 0xF, 0xF, true);
    else r = __builtin_amdgcn_update_dpp(0, x, 0x140, 0xF, 0xF, true);
    return __builtin_bit_cast(float, r);
}
__device__ __forceinline__ float red4(float v) { v += dpp_f(v, 0); v += dpp_f(v, 1); return v; }
__device__ __forceinline__ float red8(float v) { v = red4(v); v += dpp_f(v, 2); return v; }
__device__ __forceinline__ float red16(float v) { v = red8(v); v += dpp_f(v, 3); return v; }
__device__ __forceinline__ float tanh_(float x) { return 1.0f - 2.0f / (1.0f + __expf(2.0f * x)); }
__device__ __forceinline__ bf16x8 pack8(const float* p) {
    v4u w; w.x = pg8::cvt_pk_bf16(p[0], p[1]); w.y = pg8::cvt_pk_bf16(p[2], p[3]); w.z = pg8::cvt_pk_bf16(p[4], p[5]); w.w = pg8::cvt_pk_bf16(p[6], p[7]);
    return __builtin_bit_cast(bf16x8, w);
}

__device__ __forceinline__ void attn_unit(int wu, const bf16* Qb, const bf16* Kb, const bf16* VT, bf16* OG, float* LSE, int lane) {
    const int g = wu >> 12; int rem = wu & 4095; const int b = rem >> 9; rem &= 511; const int head = rem >> 6, qt = rem & 63;
    const int lgd = 2 * g, dil = 1 << lgd, L = T >> lgd;
    const int p0 = qt * 32, r = p0 >> (11 - lgd), u0 = p0 & (L - 1);
    const int q = lane & 31, h = lane >> 5;
    const size_t rb = ((size_t)g * M + (size_t)b * T) * 512 + head * 64;
    const bf16* Qg = Qb + rb; const bf16* Kg = Kb + rb;
    const bf16* Vg = VT + (((size_t)g * NB + b) * 8 + head) * 64 * T;
    bf16x8 qf[4];
#pragma unroll
    for (int ks = 0; ks < 4; ++ks) qf[ks] = *(const bf16x8*)(Qg + (size_t)(p0 + q) * 512 + 16 * ks + 8 * h);
    const int kt0 = (u0 >= 128) ? 0 : 4 - (u0 >> 5);
    const int kbase = r * L + u0 - 128;
    f32x16 s[5];
#pragma unroll
    for (int kt = 0; kt < 5; ++kt) {
        if (kt >= kt0) {
            f32x16 acc = {};
            const bf16* kp = Kg + (size_t)(kbase + 32 * kt + q) * 512 + 8 * h;
#pragma unroll
            for (int ks = 0; ks < 4; ++ks) { const bf16x8 kf = *(const bf16x8*)(kp + 16 * ks); acc = __builtin_amdgcn_mfma_f32_32x32x16_bf16(kf, qf[ks], acc, 0, 0, 0); }
            if (kt == 0) {
#pragma unroll
                for (int rg = 0; rg < 16; ++rg) { const int krow = (rg & 3) + 8 * (rg >> 2) + 4 * h; if (krow < q) acc[rg] = -INFINITY; }
            }
            if (kt == 4) {
#pragma unroll
                for (int rg = 0; rg < 16; ++rg) { const int krow = (rg & 3) + 8 * (rg >> 2) + 4 * h; if (krow > q) acc[rg] = -INFINITY; }
            }
            s[kt] = acc;
        } else {
#pragma unroll
            for (int rg = 0; rg < 16; ++rg) s[kt][rg] = -INFINITY;
        }
    }
    float mx = -INFINITY;
#pragma unroll
    for (int kt = 0; kt < 5; ++kt)
#pragma unroll
        for (int rg = 0; rg < 16; ++rg) mx = fmaxf(mx, s[kt][rg]);
    mx = fmaxf(mx, __shfl_xor(mx, 32));
    float l = 0.f;
#pragma unroll
    for (int kt = 0; kt < 5; ++kt)
#pragma unroll
        for (int rg = 0; rg < 16; ++rg) { const float p = __builtin_amdgcn_exp2f(s[kt][rg] - mx); s[kt][rg] = p; l += p; }
    l += __shfl_xor(l, 32);
    f32x16 o0 = {}, o1 = {};
#pragma unroll
    for (int kt = 0; kt < 5; ++kt) {
        if (kt >= kt0) {
#pragma unroll
            for (int si = 0; si < 2; ++si) {
                float pp[8];
#pragma unroll
                for (int j = 0; j < 8; ++j) pp[j] = s[kt][8 * si + j];
                const bf16x8 pb = pack8(pp);
                const int kp = kbase + 32 * kt + 16 * si + 4 * h;
                const bf16* v0 = Vg + (size_t)(lane & 31) * T + kp;
                const bf16* v1 = v0 + (size_t)32 * T;
                u32x2 a0 = *(const u32x2*)(v0), a1 = *(const u32x2*)(v0 + 8), c0 = *(const u32x2*)(v1), c1 = *(const u32x2*)(v1 + 8);
                const bf16x8 va = __builtin_bit_cast(bf16x8, (v4u){a0.x, a0.y, a1.x, a1.y}), vc = __builtin_bit_cast(bf16x8, (v4u){c0.x, c0.y, c1.x, c1.y});
                o0 = __builtin_amdgcn_mfma_f32_32x32x16_bf16(va, pb, o0, 0, 0, 0);
                o1 = __builtin_amdgcn_mfma_f32_32x32x16_bf16(vc, pb, o1, 0, 0, 0);
            }
        }
    }
    const float inv = 1.0f / l;
    const int t = r + dil * (u0 + q);
    bf16* op = OG + ((size_t)g * M + (size_t)b * T + t) * 512 + head * 64 + 4 * h;
#pragma unroll
    for (int rg = 0; rg < 4; ++rg) {
        u32x2 w; w.x = pg8::cvt_pk_bf16(o0[4 * rg] * inv, o0[4 * rg + 1] * inv); w.y = pg8::cvt_pk_bf16(o0[4 * rg + 2] * inv, o0[4 * rg + 3] * inv);
        *(u32x2*)(op + 8 * rg) = w;
        u32x2 w2; w2.x = pg8::cvt_pk_bf16(o1[4 * rg] * inv, o1[4 * rg + 1] * inv); w2.y = pg8::cvt_pk_bf16(o1[4 * rg + 2] * inv, o1[4 * rg + 3] * inv);
        *(u32x2*)(op + 32 + 8 * rg) = w2;
    }
    if (h == 0) LSE[((size_t)g * M + (size_t)b * T + t) * 8 + head] = (mx + __builtin_amdgcn_logf(l)) * LN2;
}

__device__ __forceinline__ void r1_rows(const Frame& F, const bf16* SC, const float* mu, bf16* A1, bf16* A2) {
    float mul[6];
#pragma unroll
    for (int i = 0; i < 6; ++i) { const int e = F.lane + 64 * i; mul[i] = (e < 288) ? mu[3072 + e] : 0.f; }
    for (int m = F.gw; m < M; m += F.NGW) {
        const int t = m & (T - 1);
        const bf16* p = SC + (size_t)m * SCP + 3072;
#pragma unroll
        for (int i = 0; i < 6; ++i) {
            const int e = F.lane + 64 * i;
            if (e < 288) {
                const float x = bf2f(p[e]); const float xp = (t > 0) ? bf2f(p[e - SCP]) : 0.f;
                const float xm = x + (xp - x) * mul[i];
                if (e < 64) A1[(size_t)m * 128 + e] = (bf16)f2bf(tanh_(xm));
                else if (e < 128) A1[(size_t)m * 128 + e] = (bf16)f2bf(xm);
                else A2[(size_t)m * 256 + (e - 128)] = (bf16)f2bf(sigmoidf_(xm));
            } else A2[(size_t)m * 256 + (e - 128)] = 0;
        }
    }
}

__device__ __forceinline__ void combine_groups(const Frame& F, const bf16* OG, const float* LSE, bf16* OA) {
    for (int it = F.vcu * 512 + F.tid; it < M * 64; it += F.G * 512) {
        const int m = it >> 6, cg = it & 63, head = cg >> 3;
        const float l0 = LSE[(size_t)m * 8 + head], l1 = LSE[((size_t)M + m) * 8 + head], l2 = LSE[((size_t)2 * M + m) * 8 + head];
        const float mx = fmaxf(l0, fmaxf(l1, l2));
        float e0 = __expf(l0 - mx), e1 = __expf(l1 - mx), e2 = __expf(l2 - mx); const float inv = 1.0f / (e0 + e1 + e2); e0 *= inv; e1 *= inv; e2 *= inv;
        const v4u a = *(const v4u*)(OG + (size_t)m * 512 + cg * 8), b = *(const v4u*)(OG + ((size_t)M + m) * 512 + cg * 8), c = *(const v4u*)(OG + ((size_t)2 * M + m) * 512 + cg * 8);
        v4u o;
        o.x = pg8::cvt_pk_bf16(e0 * bflo(a.x) + e1 * bflo(b.x) + e2 * bflo(c.x), e0 * bfhi(a.x) + e1 * bfhi(b.x) + e2 * bfhi(c.x));
        o.y = pg8::cvt_pk_bf16(e0 * bflo(a.y) + e1 * bflo(b.y) + e2 * bflo(c.y), e0 * bfhi(a.y) + e1 * bfhi(b.y) + e2 * bfhi(c.y));
        o.z = pg8::cvt_pk_bf16(e0 * bflo(a.z) + e1 * bflo(b.z) + e2 * bflo(c.z), e0 * bfhi(a.z) + e1 * bfhi(b.z) + e2 * bfhi(c.z));
        o.w = pg8::cvt_pk_bf16(e0 * bflo(a.w) + e1 * bflo(b.w) + e2 * bflo(c.w), e0 * bfhi(a.w) + e1 * bfhi(b.w) + e2 * bfhi(c.w));
        *(v4u*)(OA + (size_t)m * 512 + cg * 8) = o;
    }
}

struct EpiWA {
    static constexpr bool PERM = true, AFTER_DRAIN = false;
    bf16* E; bf16* AV; const float* w0; const float* a0;
    __device__ __forceinline__ void operator()(const pg8::f32x4 (&acc)[2][2][4][2], const pg8::Unit& u, int wr, int wc, int fr, int fq) const {
        const bool isw = u.pn < 4; const int cb = (u.pn & 3) * 256 + wc * 32 + 8 * fq; const float* bias = isw ? w0 : a0; bf16* O = isw ? E : AV; const float sc = isw ? 0.60653065971263342f : 1.0f;
#pragma unroll
        for (int bj = 0; bj < 2; ++bj) {
            const int col = cb + bj * 128; const f32x4 b0 = *(const f32x4*)(bias + col), b1 = *(const f32x4*)(bias + col + 4);
#pragma unroll
            for (int ai = 0; ai < 2; ++ai)
#pragma unroll
                for (int m = 0; m < 4; ++m) {
                    const int row = u.pm * 256 + wr * 64 + fr + ai * 128 + m * 16;
                    const pg8::f32x4 v0 = acc[ai][bj][m][0], v1 = acc[ai][bj][m][1];
                    pg8::u32x4 w; w.x = pg8::cvt_pk_bf16(sc * sigmoidf_(v0[0] + b0[0]), sc * sigmoidf_(v0[1] + b0[1])); w.y = pg8::cvt_pk_bf16(sc * sigmoidf_(v0[2] + b0[2]), sc * sigmoidf_(v0[3] + b0[3]));
                    w.z = pg8::cvt_pk_bf16(sc * sigmoidf_(v1[0] + b1[0]), sc * sigmoidf_(v1[1] + b1[1])); w.w = pg8::cvt_pk_bf16(sc * sigmoidf_(v1[2] + b1[2]), sc * sigmoidf_(v1[3] + b1[3]));
                    *(pg8::u32x4*)(O + (size_t)row * 1024 + col) = w;
                }
        }
    }
};
struct EpiPlain {
    static constexpr bool PERM = true, AFTER_DRAIN = false;
    bf16* O; int ldc;
    __device__ __forceinline__ void operator()(const pg8::f32x4 (&acc)[2][2][4][2], const pg8::Unit& u, int wr, int wc, int fr, int fq) const {
        const int cb = u.pn * 256 + wc * 32 + 8 * fq;
#pragma unroll
        for (int ai = 0; ai < 2; ++ai)
#pragma unroll
            for (int m = 0; m < 4; ++m) {
                const int row = u.pm * 256 + wr * 64 + fr + ai * 128 + m * 16;
#pragma unroll
                for (int bj = 0; bj < 2; ++bj) {
                    const pg8::f32x4 v0 = acc[ai][bj][m][0], v1 = acc[ai][bj][m][1];
                    pg8::u32x4 w; w.x = pg8::cvt_pk_bf16(v0[0], v0[1]); w.y = pg8::cvt_pk_bf16(v0[2], v0[3]); w.z = pg8::cvt_pk_bf16(v1[0], v1[1]); w.w = pg8::cvt_pk_bf16(v1[2], v1[3]);
                    *(pg8::u32x4*)(O + (size_t)row * ldc + cb + bj * 128) = w;
                }
            }
    }
};

struct ScanRegs { u32x2 pr, pk, pv, qr, qk, qv, e4, a4; };
__device__ __forceinline__ void scan_load(ScanRegs& R, const bf16* SC, const bf16* E, const bf16* AV, int b, int t, int cr) {
    const size_t m = (size_t)b * T + t; const bf16* p = SC + m * SCP + cr;
    R.pr = *(const u32x2*)(p); R.pk = *(const u32x2*)(p + 1024); R.pv = *(const u32x2*)(p + 2048);
    if (t > 0) { R.qr = *(const u32x2*)(p - SCP); R.qk = *(const u32x2*)(p - SCP + 1024); R.qv = *(const u32x2*)(p - SCP + 2048); }
    else { R.qr = (u32x2){0u, 0u}; R.qk = (u32x2){0u, 0u}; R.qv = (u32x2){0u, 0u}; }
    R.e4 = *(const u32x2*)(E + m * 1024 + cr); R.a4 = *(const u32x2*)(AV + m * 1024 + cr);
}
__device__ __forceinline__ f32x4 bf4(u32x2 w) { return (f32x4){bflo(w.x), bfhi(w.x), bflo(w.y), bfhi(w.y)}; }
__device__ __forceinline__ void scan_phase(const Frame& F, const Args& a, unsigned char* ws) {
    const bf16* SC = (const bf16*)(ws + WS_SC); const bf16* E = (const bf16*)(ws + WS_E); const bf16* AV = (const bf16*)(ws + WS_AV);
    float* Y = (float*)(ws + WS_Y); float* CB = (float*)(ws + WS_CB);
    LAS float* L = (LAS float*)(F.lds + RING_OFF); LAS float* YB = (LAS float*)(F.lds + RING_OFF + 49152);
    const int tid = F.tid, lane = F.lane, wave = F.wave;
    for (int item = F.vcu; item < NB * BHEADS * 2; item += F.G) {
        const int chain = item >> 1, half = item & 1, b = chain >> 4, head = chain & 15;
        const int ss = tid >> 4, j4 = (tid & 15) * 4, cr = head * 64 + j4;
        const f32x4 mur = *(const f32x4*)(a.in[I_MU] + cr), muk = *(const f32x4*)(a.in[I_MU] + 1024 + cr), muv = *(const f32x4*)(a.in[I_MU] + 2048 + cr);
        const f32x4 kkw = *(const f32x4*)(a.in[I_KK] + cr), kaw = *(const f32x4*)(a.in[I_KA] + cr), rkw = *(const f32x4*)(a.in[I_RK] + cr);
        const int rloc = 4 * wave + (lane >> 4), c4 = (lane & 15) * 4;
        f32x4 S = {0.f, 0.f, 0.f, 0.f};
        ScanRegs cur, nxt; scan_load(cur, SC, E, AV, b, ss, cr);
        for (int ch = 0; ch < T / 32; ++ch) {
            const int t0 = ch * 32;
            if (ch + 1 < T / 32) scan_load(nxt, SC, E, AV, b, t0 + 32 + ss, cr); else nxt = cur;
            {
                const f32x4 pr = bf4(cur.pr), pk = bf4(cur.pk), pv = bf4(cur.pv), qr = bf4(cur.qr), qk = bf4(cur.qk), qv = bf4(cur.qv);
                const f32x4 r = pr + (qr - pr) * mur, k = pk + (qk - pk) * muk, v = pv + (qv - pv) * muv;
                const f32x4 ev = bf4(cur.e4), av = bf4(cur.a4);
                f32x4 w; w[0] = __expf(-ev[0]); w[1] = __expf(-ev[1]); w[2] = __expf(-ev[2]); w[3] = __expf(-ev[3]);
                const f32x4 kr = k * kkw;
                const float n2 = red16((kr[0] * kr[0] + kr[1] * kr[1]) + (kr[2] * kr[2] + kr[3] * kr[3]));
                const float rn = 1.0f / fmaxf(sqrtf(n2), 1e-12f);
                const f32x4 kk = kr * rn;
                const f32x4 kp = k * (1.0f + (av - 1.0f) * kaw);
                const f32x4 bb = kk * av;
                const f32x4 rkk = r * kp * rkw;
                const float cb = red16((rkk[0] + rkk[1]) + (rkk[2] + rkk[3]));
                LAS float* d = L + ss * 384 + j4;
                *(LAS f32x4*)(d) = w; *(LAS f32x4*)(d + 64) = kk; *(LAS f32x4*)(d + 128) = bb; *(LAS f32x4*)(d + 192) = kp; *(LAS f32x4*)(d + 256) = r; *(LAS f32x4*)(d + 320) = v;
                if (half == 0 && (tid & 15) == 0) CB[((size_t)b * T + t0 + ss) * 16 + head] = cb;
            }
            __syncthreads();
#pragma unroll 4
            for (int s = 0; s < 32; ++s) {
                const LAS float* d = L + s * 384 + c4;
                const f32x4 w = *(const LAS f32x4*)(d), kk = *(const LAS f32x4*)(d + 64), bb = *(const LAS f32x4*)(d + 128), kp = *(const LAS f32x4*)(d + 192), r = *(const LAS f32x4*)(d + 256);
                const float vi = L[s * 384 + 320 + 32 * half + rloc];
                const float sa = -red16((S[0] * kk[0] + S[1] * kk[1]) + (S[2] * kk[2] + S[3] * kk[3]));
                S = S * w + sa * bb + vi * kp;
                const float y = red16((S[0] * r[0] + S[1] * r[1]) + (S[2] * r[2] + S[3] * r[3]));
                if ((lane & 15) == 0) YB[s * 32 + rloc] = y;
            }
            __syncthreads();
            {
                const int c2 = (tid & 15) * 2;
                const f32x2 yv = *(const LAS f32x2*)(YB + ss * 32 + c2);
                *(f32x2*)(Y + ((size_t)b * T + t0 + ss) * 1024 + head * 64 + 32 * half + c2) = yv;
            }
            cur = nxt;
        }
        *(f32x4*)(a.out + O_WKVP + (((size_t)b * 16 + head) * 64 + 32 * half + rloc) * 64 + c4) = S;
        __syncthreads();
    }
}

__device__ __forceinline__ void r3_rows(const Frame& F, const Args& a, unsigned char* ws) {
    const bf16* SC = (const bf16*)(ws + WS_SC); const bf16* GATE = (const bf16*)(ws + WS_GATE); const float* Y = (const float*)(ws + WS_Y); const float* CB = (const float*)(ws + WS_CB);
    bf16* OB = (bf16*)(ws + WS_OB);
    const int lane = F.lane, c0 = 16 * lane, head = lane >> 2;
    f32x4 gw[4], gb[4], mv[4];
#pragma unroll
    for (int j = 0; j < 4; ++j) { gw[j] = *(const f32x4*)(a.in[I_GNW] + c0 + 4 * j); gb[j] = *(const f32x4*)(a.in[I_GNB] + c0 + 4 * j); mv[j] = *(const f32x4*)(a.in[I_MU] + 2048 + c0 + 4 * j); }
    for (int m = F.gw; m < M; m += F.NGW) {
        const int t = m & (T - 1);
        f32x4 y[4]; float s = 0.f;
#pragma unroll
        for (int j = 0; j < 4; ++j) { y[j] = *(const f32x4*)(Y + (size_t)m * 1024 + c0 + 4 * j); s += (y[j][0] + y[j][1]) + (y[j][2] + y[j][3]); }
        const float mean = red4(s) * (1.0f / 64.0f); float q = 0.f;
#pragma unroll
        for (int j = 0; j < 4; ++j) { y[j] = y[j] - mean; q += (y[j][0] * y[j][0] + y[j][1] * y[j][1]) + (y[j][2] * y[j][2] + y[j][3] * y[j][3]); }
        const float rs = 1.0f / sqrtf(red4(q) * (1.0f / 64.0f) + GN_EPS);
        const float cb = CB[(size_t)m * 16 + head];
        const bf16* p = SC + (size_t)m * SCP + 2048 + c0;
        const v4u p0 = *(const v4u*)(p), p1 = *(const v4u*)(p + 8);
        v4u q0 = {0u, 0u, 0u, 0u}, q1 = {0u, 0u, 0u, 0u};
        if (t > 0) { q0 = *(const v4u*)(p - SCP); q1 = *(const v4u*)(p - SCP + 8); }
        const v4u g0 = *(const v4u*)(GATE + (size_t)m * 1024 + c0), g1 = *(const v4u*)(GATE + (size_t)m * 1024 + c0 + 8);
        const unsigned pw[8] = {p0.x, p0.y, p0.z, p0.w, p1.x, p1.y, p1.z, p1.w}, qw[8] = {q0.x, q0.y, q0.z, q0.w, q1.x, q1.y, q1.z, q1.w}, gw8[8] = {g0.x, g0.y, g0.z, g0.w, g1.x, g1.y, g1.z, g1.w};
        unsigned ow[8];
#pragma unroll
        for (int e = 0; e < 8; ++e) {
            const int j = e >> 1, i0 = (e & 1) * 2;
            const float pa = bflo(pw[e]), pb = bfhi(pw[e]), qa = bflo(qw[e]), qb = bfhi(qw[e]);
            const float va = pa + (qa - pa) * mv[j][i0], vb = pb + (qb - pb) * mv[j][i0 + 1];
            const float oa = (y[j][i0] * rs * gw[j][i0] + gb[j][i0] + cb * va) * bflo(gw8[e]);
            const float ob = (y[j][i0 + 1] * rs * gw[j][i0 + 1] + gb[j][i0 + 1] + cb * vb) * bfhi(gw8[e]);
            ow[e] = pg8::cvt_pk_bf16(oa, ob);
        }
        *(v4u*)(OB + (size_t)m * 1024 + c0) = (v4u){ow[0], ow[1], ow[2], ow[3]};
        *(v4u*)(OB + (size_t)m * 1024 + c0 + 8) = (v4u){ow[4], ow[5], ow[6], ow[7]};
    }
}

struct EpiPA {
    static constexpr bool PERM = true, AFTER_DRAIN = false;
    const bf16* GT; float* Y1;
    __device__ __forceinline__ void operator()(const pg8::f32x4 (&acc)[2][2][4][2], const pg8::Unit& u, int wr, int wc, int fr, int fq) const {
        const int cb = u.pn * 256 + wc * 32 + 8 * fq;
#pragma unroll
        for (int ai = 0; ai < 2; ++ai)
#pragma unroll
            for (int m = 0; m < 4; ++m) {
                const int row = u.pm * 256 + wr * 64 + fr + ai * 128 + m * 16;
#pragma unroll
                for (int bj = 0; bj < 2; ++bj) {
                    const int col = cb + bj * 128; const v4u gq = *(const v4u*)(GT + (size_t)row * 2048 + col);
                    const pg8::f32x4 v0 = acc[ai][bj][m][0], v1 = acc[ai][bj][m][1];
                    *(f32x4*)(Y1 + (size_t)row * 1024 + col) = (f32x4){v0[0] * bflo(gq.x), v0[1] * bfhi(gq.x), v0[2] * bflo(gq.y), v0[3] * bfhi(gq.y)};
                    *(f32x4*)(Y1 + (size_t)row * 1024 + col + 4) = (f32x4){v1[0] * bflo(gq.z), v1[1] * bfhi(gq.z), v1[2] * bflo(gq.w), v1[3] * bfhi(gq.w)};
                }
            }
    }
};
struct EpiPB {
    static constexpr bool PERM = true, AFTER_DRAIN = false;
    const bf16* GT; const float* Y1; bf16* MG;
    __device__ __forceinline__ void operator()(const pg8::f32x4 (&acc)[2][2][4][2], const pg8::Unit& u, int wr, int wc, int fr, int fq) const {
        const int cb = u.pn * 256 + wc * 32 + 8 * fq;
#pragma unroll
        for (int ai = 0; ai < 2; ++ai)
#pragma unroll
            for (int m = 0; m < 4; ++m) {
                const int row = u.pm * 256 + wr * 64 + fr + ai * 128 + m * 16;
#pragma unroll
                for (int bj = 0; bj < 2; ++bj) {
                    const int col = cb + bj * 128; const v4u gq = *(const v4u*)(GT + (size_t)row * 2048 + 1024 + col);
                    const f32x4 y0 = *(const f32x4*)(Y1 + (size_t)row * 1024 + col), y1 = *(const f32x4*)(Y1 + (size_t)row * 1024 + col + 4);
                    const pg8::f32x4 v0 = acc[ai][bj][m][0], v1 = acc[ai][bj][m][1];
                    pg8::u32x4 w; w.x = pg8::cvt_pk_bf16(y0[0] + v0[0] * bflo(gq.x), y0[1] + v0[1] * bfhi(gq.x)); w.y = pg8::cvt_pk_bf16(y0[2] + v0[2] * bflo(gq.y), y0[3] + v0[3] * bfhi(gq.y));
                    w.z = pg8::cvt_pk_bf16(y1[0] + v1[0] * bflo(gq.z), y1[1] + v1[1] * bfhi(gq.z)); w.w = pg8::cvt_pk_bf16(y1[2] + v1[2] * bflo(gq.w), y1[3] + v1[3] * bfhi(gq.w));
                    *(pg8::u32x4*)(MG + (size_t)row * 1024 + col) = w;
                }
            }
    }
};
struct EpiRes {
    static constexpr bool PERM = true, AFTER_DRAIN = false;
    const float* base; float* Xo; bf16* Xb; float* ssq;
    __device__ __forceinline__ void operator()(const pg8::f32x4 (&acc)[2][2][4][2], const pg8::Unit& u, int wr, int wc, int fr, int fq) const {
        const int cb = u.pn * 256 + wc * 32 + 8 * fq;
#pragma unroll
        for (int ai = 0; ai < 2; ++ai)
#pragma unroll
            for (int m = 0; m < 4; ++m) {
                const int row = u.pm * 256 + wr * 64 + fr + ai * 128 + m * 16; float sq = 0.f;
#pragma unroll
                for (int bj = 0; bj < 2; ++bj) {
                    const int col = cb + bj * 128;
                    const f32x4 x0 = *(const f32x4*)(base + (size_t)row * 1024 + col), x1 = *(const f32x4*)(base + (size_t)row * 1024 + col + 4);
                    const pg8::f32x4 a0 = acc[ai][bj][m][0], a1 = acc[ai][bj][m][1];
                    const f32x4 o0 = {x0[0] + a0[0], x0[1] + a0[1], x0[2] + a0[2], x0[3] + a0[3]}, o1 = {x1[0] + a1[0], x1[1] + a1[1], x1[2] + a1[2], x1[3] + a1[3]};
                    *(f32x4*)(Xo + (size_t)row * 1024 + col) = o0; *(f32x4*)(Xo + (size_t)row * 1024 + col + 4) = o1;
                    sq += (o0[0] * o0[0] + o0[1] * o0[1]) + (o0[2] * o0[2] + o0[3] * o0[3]) + (o1[0] * o1[0] + o1[1] * o1[1]) + (o1[2] * o1[2] + o1[3] * o1[3]);
                    if (Xb) { pg8::u32x4 w; w.x = pg8::cvt_pk_bf16(o0[0], o0[1]); w.y = pg8::cvt_pk_bf16(o0[2], o0[3]); w.z = pg8::cvt_pk_bf16(o1[0], o1[1]); w.w = pg8::cvt_pk_bf16(o1[2], o1[3]);
                        *(pg8::u32x4*)(Xb + (size_t)row * 1024 + col) = w; }
                }
                sq += __shfl_xor(sq, 16); sq += __shfl_xor(sq, 32);
                if (fq == 0) atomicAdd(ssq + row, sq);
            }
    }
};
struct EpiGU {
    static constexpr bool PERM = true, AFTER_DRAIN = false;
    const float* ssq; bf16* ACT;
    __device__ __forceinline__ void operator()(const pg8::f32x4 (&acc)[2][2][4][2], const pg8::Unit& u, int wr, int wc, int fr, int fq) const {
        const int col = u.pn * 128 + wc * 32 + 8 * fq;
#pragma unroll
        for (int ai = 0; ai < 2; ++ai)
#pragma unroll
            for (int m = 0; m < 4; ++m) {
                const int row = u.pm * 256 + wr * 64 + fr + ai * 128 + m * 16;
                const float rstd = 1.0f / sqrtf(ssq[row] * (1.0f / DM) + NORM_EPS);
                float o[8];
#pragma unroll
                for (int n = 0; n < 2; ++n)
#pragma unroll
                    for (int j = 0; j < 4; ++j) { const float gv = acc[ai][0][m][n][j] * rstd, uv = acc[ai][1][m][n][j] * rstd; o[4 * n + j] = gv * sigmoidf_(gv) * uv; }
                pg8::u32x4 w; w.x = pg8::cvt_pk_bf16(o[0], o[1]); w.y = pg8::cvt_pk_bf16(o[2], o[3]); w.z = pg8::cvt_pk_bf16(o[4], o[5]); w.w = pg8::cvt_pk_bf16(o[6], o[7]);
                *(pg8::u32x4*)(ACT + (size_t)row * DFF + col) = w;
            }
    }
};

__device__ __forceinline__ f32x16 sgemm32_tile(const bf16* A, int lda, const bf16* Bt, int K, int n0, int lane) {
    const int r = lane & 31, h = lane >> 5;
    const bf16* ap = A + (size_t)r * lda + 8 * h; const bf16* bp = Bt + (size_t)(n0 + r) * K + 8 * h;
    f32x16 acc = {};
#pragma unroll 8
    for (int k = 0; k < K; k += 16) { const bf16x8 av = *(const bf16x8*)(ap + k), bv = *(const bf16x8*)(bp + k); acc = __builtin_amdgcn_mfma_f32_32x32x16_bf16(av, bv, acc, 0, 0, 0); }
    return acc;
}
#define SROW(rg, h) (((rg) & 3) + 8 * ((rg) >> 2) + 4 * (h))

__device__ __forceinline__ void s_inproj(const Frame& F, unsigned char* ws) {
    float* PROJ = (float*)(ws + WS_SMP + SM_PROJ);
    for (int tl = F.gw; tl < INP / 32; tl += F.NGW) {
        const f32x16 acc = sgemm32_tile((const bf16*)(ws + WS_SMP + SM_HSN), DM, (const bf16*)(ws + WS_WIN), DM, 32 * tl, F.lane);
#pragma unroll
        for (int rg = 0; rg < 16; ++rg) PROJ[(size_t)SROW(rg, F.lane >> 5) * INP + 32 * tl + (F.lane & 31)] = acc[rg];
    }
}

__device__ __forceinline__ float block_max(float v, LAS float* red, int tid) {
#pragma unroll
    for (int o = 1; o < 64; o <<= 1) v = fmaxf(v, __shfl_xor(v, o));
    __syncthreads(); if ((tid & 63) == 0) red[tid >> 6] = v; __syncthreads();
    float r = red[0];
#pragma unroll
    for (int i = 1; i < 8; ++i) r = fmaxf(r, red[i]);
    return r;
}
__device__ __forceinline__ float block_sum(float v, LAS float* red, int tid) {
    v = wave_sum(v);
    __syncthreads(); if ((tid & 63) == 0) red[tid >> 6] = v; __syncthreads();
    float r = 0.f;
#pragma unroll
    for (int i = 0; i < 8; ++i) r += red[i];
    return r;
}

__device__ __forceinline__ void s_attn_item(const Frame& F, const Args& a, unsigned char* ws, int b, int head) {
    const float* PROJ = (const float*)(ws + WS_SMP + SM_PROJ) + (size_t)b * INP; const float* tab = (const float*)(ws + WS_TAB) + (size_t)2048 * 64;
    LAS float* sm = (LAS float*)(F.lds + RING_OFF);
    LAS float* qn = sm;
    LAS float* kn = sm + 64;
    LAS float* vn = sm + 128;
    LAS float* pj = sm + 192;
    LAS float* red = sm + 336;
    LAS float* part = sm + 352;
    LAS float* og = sm + 864;
    LAS float* lse = sm + 1056;
    const int tid = F.tid;
    for (int g = 0; g < 3; ++g) {
        const int dil = 1 << (2 * g), buf = (g == 0) ? 128 : (g == 1) ? 512 : 2048;
        const float* cache = a.in[I_C1 + g]; const size_t okv = (g == 0) ? O_KV1S : (g == 1) ? O_KV2S : O_KV3S;
        __syncthreads();
        if (tid < 64) {
            const int i = tid & 31, isk = tid >> 5; const float* src = PROJ + (3 * g + isk) * 512 + head * 64;
            const float x1 = src[2 * i], x2 = src[2 * i + 1], c = tab[2 * i], s = tab[2 * i + 1];
            const float o1 = x1 * c - x2 * s, o2 = x1 * s + x2 * c;
            if (isk == 0) { qn[i] = o1 * 0.125f; qn[32 + i] = o2 * 0.125f; }
            else { kn[i] = o1; kn[32 + i] = o2; float* ob = a.out + okv + ((size_t)b * 2 + 0) * 512 + head * 64; ob[i] = o1; ob[32 + i] = o2; }
        } else if (tid < 128) {
            const int d = tid - 64; const float v = PROJ[(3 * g + 2) * 512 + head * 64 + d]; vn[d] = v; a.out[okv + ((size_t)b * 2 + 1) * 512 + head * 64 + d] = v;
        }
        __syncthreads();
        const int j = tid >> 2, pt = tid & 3;
        const size_t crow = ((size_t)b * buf + (buf - dil * (j + 1))) * 2;
        const float* kc = cache + ((crow + 0) * 8 + head) * 64 + 16 * pt;
        float sc = 0.f;
#pragma unroll
        for (int d4 = 0; d4 < 4; ++d4) { const f32x4 kv = *(const f32x4*)(kc + 4 * d4); sc += kv[0] * qn[16 * pt + 4 * d4] + kv[1] * qn[16 * pt + 4 * d4 + 1] + kv[2] * qn[16 * pt + 4 * d4 + 2] + kv[3] * qn[16 * pt + 4 * d4 + 3]; }
        sc = red4(sc);
        float snew = 0.f;
        if (tid < 64) snew = qn[tid] * kn[tid];
        snew = block_sum(snew, red, tid);
        const float mx = fmaxf(block_max(sc, red, tid), snew);
        const float pe = __expf(sc - mx), pn = __expf(snew - mx);
        if (pt == 0) pj[j] = pe;
        if (tid == 0) pj[128] = pn;
        const float den = block_sum(pt == 0 ? pe : 0.f, red, tid) + pn;
        const int d = tid & 63, kg = tid >> 6; float acc = 0.f;
#pragma unroll 4
        for (int jj = 0; jj < 16; ++jj) { const int j2 = kg * 16 + jj; const size_t cr2 = ((size_t)b * buf + (buf - dil * (j2 + 1))) * 2; acc += pj[j2] * cache[((cr2 + 1) * 8 + head) * 64 + d]; }
        if (kg == 0) acc += pj[128] * vn[d];
        part[kg * 64 + d] = acc;
        __syncthreads();
        if (tid < 64) { float o = 0.f;
#pragma unroll
            for (int k2 = 0; k2 < 8; ++k2) o += part[k2 * 64 + tid];
            og[g * 64 + tid] = o / den; }
        if (tid == 0) lse[g] = mx + __logf(den);
    }
    __syncthreads();
    if (tid < 64) {
        const float l0 = lse[0], l1 = lse[1], l2 = lse[2], mx = fmaxf(l0, fmaxf(l1, l2));
        const float e0 = __expf(l0 - mx), e1 = __expf(l1 - mx), e2 = __expf(l2 - mx), inv = 1.0f / (e0 + e1 + e2);
        const float o = (e0 * og[tid] + e1 * og[64 + tid] + e2 * og[128 + tid]) * inv;
        ((bf16*)(ws + WS_SMP + SM_OA))[(size_t)b * 512 + head * 64 + tid] = (bf16)f2bf(o);
    }
    __syncthreads();
}

__device__ __forceinline__ void s_rwkv_item(const Frame& F, const Args& a, unsigned char* ws, int b, int head) {
    const float* P = (const float*)(ws + WS_SMP + SM_PROJ) + (size_t)b * INP + ACOLS;
    const float* prev = a.in[I_SSH] + (size_t)b * SCOLS; const float* mu = a.in[I_MU];
    LAS float* sm = (LAS float*)(F.lds + RING_OFF);
    LAS float* xl = sm;
    LAS float* rr = sm + 288;
    LAS float* kr = sm + 352;
    LAS float* vv = sm + 416;
    LAS float* part = sm + 480;
    LAS float* wv = sm + 2016;
    LAS float* av = sm + 2080;
    LAS float* gv = sm + 2144;
    LAS float* kkv = sm + 2208;
    LAS float* kpv = sm + 2272;
    LAS float* bbv = sm + 2336;
    LAS float* yv = sm + 2400;
    LAS float* red = sm + 2464;
    const int tid = F.tid, hc0 = head * 64;
    __syncthreads();
    if (tid < 288) { const int c = 3072 + tid; const float x = P[c], xm = x + (prev[c] - x) * mu[c];
        xl[tid] = (tid < 64) ? tanh_(xm) : (tid < 128) ? xm : sigmoidf_(xm); }
    else if (tid < 288 + 192) { const int e = tid - 288, which = e >> 6, d = e & 63, c = which * 1024 + hc0 + d; const float x = P[c], xm = x + (prev[c] - x) * mu[c];
        if (which == 0) rr[d] = xm; else if (which == 1) kr[d] = xm; else vv[d] = xm; }
    __syncthreads();
    {
        const int c = tid & 63, sl = tid >> 6; const float* W2 = a.in[I_W2] + hc0 + c; const float* A2 = a.in[I_A2] + hc0 + c; const float* G2 = a.in[I_G2] + hc0 + c;
        float sw = 0.f, sa = 0.f, sg = 0.f;
#pragma unroll
        for (int e = 0; e < 8; ++e) { const int k = sl * 8 + e; sw += xl[k] * W2[(size_t)k * BWID]; sa += xl[64 + k] * A2[(size_t)k * BWID]; }
#pragma unroll 4
        for (int e = 0; e < 20; ++e) { const int k = sl * 20 + e; sg += xl[128 + k] * G2[(size_t)k * BWID]; }
        part[sl * 64 + c] = sw; part[512 + sl * 64 + c] = sa; part[1024 + sl * 64 + c] = sg;
    }
    __syncthreads();
    float n2p = 0.f;
    if (tid < 64) {
        float sw = 0.f, sa = 0.f, sg = 0.f;
#pragma unroll
        for (int s2 = 0; s2 < 8; ++s2) { sw += part[s2 * 64 + tid]; sa += part[512 + s2 * 64 + tid]; sg += part[1024 + s2 * 64 + tid]; }
        const float e = 0.60653065971263342f * sigmoidf_(a.in[I_W0][hc0 + tid] + sw);
        wv[tid] = __expf(-e); const float aa = sigmoidf_(a.in[I_A0][hc0 + tid] + sa); av[tid] = aa; gv[tid] = sg;
        const float kraw = kr[tid] * a.in[I_KK][hc0 + tid]; n2p = kraw * kraw; kkv[tid] = kraw;
        kpv[tid] = kr[tid] * (1.0f + (aa - 1.0f) * a.in[I_KA][hc0 + tid]);
    }
    const float n2 = block_sum(n2p, red, tid);
    const float rn = 1.0f / fmaxf(sqrtf(n2), 1e-12f);
    float cbp = 0.f;
    if (tid < 64) { const float kk = kkv[tid] * rn; kkv[tid] = kk; bbv[tid] = kk * av[tid]; cbp = rr[tid] * kpv[tid] * a.in[I_RK][hc0 + tid]; }
    const float cb = block_sum(cbp, red, tid);
    {
        const int i = tid >> 3, j0 = (tid & 7) * 8;
        const float* Sp = a.in[I_SWKV] + (((size_t)b * 16 + head) * 64 + i) * 64 + j0;
        float* So = a.out + O_WKVS + (((size_t)b * 16 + head) * 64 + i) * 64 + j0;
        const f32x4 s0 = *(const f32x4*)(Sp), s1 = *(const f32x4*)(Sp + 4);
        float S[8] = {s0[0], s0[1], s0[2], s0[3], s1[0], s1[1], s1[2], s1[3]};
        float dot = 0.f;
#pragma unroll
        for (int j = 0; j < 8; ++j) dot += S[j] * kkv[j0 + j];
        const float sa = -red8(dot), vi = vv[i];
        float yd = 0.f;
#pragma unroll
        for (int j = 0; j < 8; ++j) { S[j] = S[j] * wv[j0 + j] + sa * bbv[j0 + j] + vi * kpv[j0 + j]; yd += S[j] * rr[j0 + j]; }
        *(f32x4*)(So) = (f32x4){S[0], S[1], S[2], S[3]}; *(f32x4*)(So + 4) = (f32x4){S[4], S[5], S[6], S[7]};
        yd = red8(yd);
        if ((tid & 7) == 0) yv[i] = yd;
    }
    __syncthreads();
    const float yi = (tid < 64) ? yv[tid] : 0.f;
    const float mean = block_sum(yi, red, tid) * (1.0f / 64.0f);
    const float dv = (tid < 64) ? (yi - mean) : 0.f;
    const float var = block_sum(dv * dv, red, tid) * (1.0f / 64.0f);
    if (tid < 64) {
        const float yn = dv * (1.0f / sqrtf(var + GN_EPS)) * a.in[I_GNW][hc0 + tid] + a.in[I_GNB][hc0 + tid];
        const float o = (yn + cb * vv[tid]) * gv[tid];
        ((bf16*)(ws + WS_SMP + SM_OB))[(size_t)b * 1024 + hc0 + tid] = (bf16)f2bf(o);
    }
    __syncthreads();
}

__device__ __forceinline__ void s_proj(const Frame& F, unsigned char* ws) {
    for (int tl = F.gw; tl < 64; tl += F.NGW) {
        const int which = tl >> 5, n0 = 32 * (tl & 31);
        const f32x16 acc = which == 0 ? sgemm32_tile((const bf16*)(ws + WS_SMP + SM_OA), AWID, (const bf16*)(ws + WS_WA), AWID, n0, F.lane)
                                      : sgemm32_tile((const bf16*)(ws + WS_SMP + SM_OB), BWID, (const bf16*)(ws + WS_WB), BWID, n0, F.lane);
        float* O = (float*)(ws + WS_SMP + (which == 0 ? SM_YA : SM_YB));
#pragma unroll
        for (int rg = 0; rg < 16; ++rg) O[(size_t)SROW(rg, F.lane >> 5) * 1024 + n0 + (F.lane & 31)] = acc[rg];
    }
}
__device__ __forceinline__ void s_out(const Frame& F, const Args& a, unsigned char* ws) {
    const float* PROJ = (const float*)(ws + WS_SMP + SM_PROJ); const float* YA = (const float*)(ws + WS_SMP + SM_YA); const float* YBv = (const float*)(ws + WS_SMP + SM_YB);
    const bf16* Bt = (const bf16*)(ws + WS_WO);
    for (int tl = F.gw; tl < 32; tl += F.NGW) {
        const int n0 = 32 * tl, r = F.lane & 31, h = F.lane >> 5;
        f32x16 acc = {};
        for (int k = 0; k < DM; k += 16) {
            float mg[8];
#pragma unroll
            for (int j = 0; j < 8; ++j) { const int c = k + 8 * h + j;
                mg[j] = sigmoidf_(PROJ[(size_t)r * INP + ACOLS + SCP + c]) * YA[(size_t)r * 1024 + c] + sigmoidf_(PROJ[(size_t)r * INP + ACOLS + SCP + 1024 + c]) * YBv[(size_t)r * 1024 + c]; }
            const bf16x8 av = pack8(mg), bv = *(const bf16x8*)(Bt + (size_t)(n0 + r) * DM + k + 8 * h);
            acc = __builtin_amdgcn_mfma_f32_32x32x16_bf16(av, bv, acc, 0, 0, 0);
        }
        float* X1 = (float*)(ws + WS_SMP + SM_X1); bf16* X1B = (bf16*)(ws + WS_SMP + SM_X1B); float* SS = (float*)(ws + WS_SS) + M;
#pragma unroll
        for (int rg = 0; rg < 16; ++rg) { const int row = SROW(rg, h), col = n0 + r; const float v = a.in[I_XS][(size_t)row * DM + col] + acc[rg];
            X1[(size_t)row * 1024 + col] = v; X1B[(size_t)row * 1024 + col] = (bf16)f2bf(v);
            float sq = v * v;
#pragma unroll
            for (int o = 1; o < 32; o <<= 1) sq += __shfl_xor(sq, o);
            if (r == 0) atomicAdd(SS + row, sq); }
    }
}
__device__ __forceinline__ void s_gu(const Frame& F, unsigned char* ws) {
    const float* SS = (const float*)(ws + WS_SS) + M; bf16* ACTS = (bf16*)(ws + WS_SMP + SM_ACT);
    for (int tl = F.gw; tl < 88; tl += F.NGW) {
        const int jt = tl >> 2, i = tl & 3, n0 = 256 * jt + 32 * i, h = F.lane >> 5;
        const f32x16 ag = sgemm32_tile((const bf16*)(ws + WS_SMP + SM_X1B), DM, (const bf16*)(ws + WS_WGU), DM, n0, F.lane);
        const f32x16 au = sgemm32_tile((const bf16*)(ws + WS_SMP + SM_X1B), DM, (const bf16*)(ws + WS_WGU), DM, n0 + 128, F.lane);
#pragma unroll
        for (int rg = 0; rg < 16; ++rg) { const int row = SROW(rg, h); const float rstd = 1.0f / sqrtf(SS[row] * (1.0f / DM) + NORM_EPS);
            const float gv = ag[rg] * rstd, uv = au[rg] * rstd;
            ACTS[(size_t)row * DFF + 128 * jt + 32 * i + (F.lane & 31)] = (bf16)f2bf(gv * sigmoidf_(gv) * uv); }
    }
}
__device__ __forceinline__ void s_down(const Frame& F, unsigned char* ws) {
    const float* X1 = (const float*)(ws + WS_SMP + SM_X1); float* X2 = (float*)(ws + WS_SMP + SM_X2); float* SS2 = (float*)(ws + WS_SS2) + M;
    for (int tl = F.gw; tl < 32; tl += F.NGW) {
        const int n0 = 32 * tl, r = F.lane & 31, h = F.lane >> 5;
        const f32x16 acc = sgemm32_tile((const bf16*)(ws + WS_SMP + SM_ACT), DFF, (const bf16*)(ws + WS_WD), DFF, n0, F.lane);
#pragma unroll
        for (int rg = 0; rg < 16; ++rg) { const int row = SROW(rg, h), col = n0 + r; const float v = X1[(size_t)row * 1024 + col] + acc[rg];
            X2[(size_t)row * 1024 + col] = v; float sq = v * v;
#pragma unroll
            for (int o = 1; o < 32; o <<= 1) sq += __shfl_xor(sq, o);
            if (r == 0) atomicAdd(SS2 + row, sq); }
    }
}
__device__ __forceinline__ void final_norm(const Frame& F, const Args& a, unsigned char* ws) {
    const float* gfin = a.in[I_NFIN]; const float* SS2 = (const float*)(ws + WS_SS2);
    f32x4 gv[4];
#pragma unroll
    for (int j = 0; j < 4; ++j) gv[j] = *(const f32x4*)(gfin + 4 * F.lane + 256 * j);
    for (int m = F.gw; m < M + SB; m += F.NGW) {
        const float* src = (m < M) ? a.out + O_YP + (size_t)m * DM : (const float*)(ws + WS_SMP + SM_X2) + (size_t)(m - M) * DM;
        float* dst = (m < M) ? a.out + O_YP + (size_t)m * DM : a.out + O_YS + (size_t)(m - M) * DM;
        const float rstd = 1.0f / sqrtf(SS2[m] * (1.0f / DM) + NORM_EPS);
#pragma unroll
        for (int j = 0; j < 4; ++j) { const f32x4 v = *(const f32x4*)(src + 4 * F.lane + 256 * j); *(f32x4*)(dst + 4 * F.lane + 256 * j) = v * rstd * gv[j]; }
    }
}
__global__ void __launch_bounds__(NWAVES * 64, 2) fwd_kernel(Args args) {
    extern __shared__ __attribute__((aligned(16))) unsigned char lds[];
    Frame F;
    F.lds = (LAS unsigned char*)lds;
    F.MISC = (volatile LAS unsigned*)(F.lds + MISC_OFF);
    F.tid = threadIdx.x; F.lane = F.tid & 63; F.wave = __builtin_amdgcn_readfirstlane(F.tid >> 6);
    F.G = gridDim.x; { const int bx = blockIdx.x; F.vcu = (F.G % 8 == 0) ? (bx % 8) * (F.G / 8) + bx / 8 : bx; }
    F.gw = F.vcu * NWAVES + F.wave; F.NGW = F.G * NWAVES;
    unsigned char* ws = args.ws;
    F.ctl = (gu32*)(ws + WS_CTL);
    for (int u = F.tid; u < (LDS_BYTES - LDSCTL_OFF) / 4; u += NWAVES * 64) ((LAS unsigned*)(F.lds + LDSCTL_OFF))[u] = 0u;
    __syncthreads();
    XcdBarrier bar = xcd_barrier_post((unsigned*)(F.ctl + CW_BAR), F.MISC + 8);
#define GRID_BAR() xcd_barrier(bar)

#ifndef NO_P0
    p0_prologue(F, args, ws);
#endif
    GRID_BAR();

#ifndef NO_P1
    {
        s_inproj(F, ws);
        pg8::Gemm g{(const pg8::bf16_t*)(ws + WS_XN), (const pg8::bf16_t*)(ws + WS_WIN), M, INP, opaque_int(DM)};
        pg8::StaticOrder S; S.init(M, INP, F.G, (int)blockIdx.x);
        EpiIn E{(bf16*)(ws + WS_Q), (bf16*)(ws + WS_K), (bf16*)(ws + WS_VT), (bf16*)(ws + WS_SC), (bf16*)(ws + WS_GT), args.out, (const float*)(ws + WS_TAB)};
        pg8::gemm_phase<EpiIn, pg8::StaticOrder, true, true>(F.lds + RING_OFF, g, S, E);
    }
#endif
    GRID_BAR();

#ifndef NO_P2
    {
        const bf16* Qb = (const bf16*)(ws + WS_Q); const bf16* Kb = (const bf16*)(ws + WS_K); const bf16* VT = (const bf16*)(ws + WS_VT);
        for (int i = 0; i < 6; ++i) { const int wu = F.vcu * 48 + i * 8 + F.wave; if (wu < 12288 && F.G == 256) attn_unit(wu, Qb, Kb, VT, (bf16*)(ws + WS_OG), (float*)(ws + WS_LSE), F.lane); }
        if (F.G != 256) for (int wu = F.gw; wu < 12288; wu += F.NGW) attn_unit(wu, Qb, Kb, VT, (bf16*)(ws + WS_OG), (float*)(ws + WS_LSE), F.lane);
        r1_rows(F, (const bf16*)(ws + WS_SC), args.in[I_MU], (bf16*)(ws + WS_A1), (bf16*)(ws + WS_A2));
        __syncthreads();
        for (int it = F.vcu; it < SB * AHEADS; it += F.G) s_attn_item(F, args, ws, it >> 3, it & 7);
        for (int it = F.vcu; it < SB * BHEADS; it += F.G) s_rwkv_item(F, args, ws, it >> 4, it & 15);
        { const float* PROJ = (const float*)(ws + WS_SMP + SM_PROJ);
          for (int e = F.vcu * 512 + F.tid; e < SB * SCOLS; e += F.G * 512) { const int b = e / SCOLS, c = e - b * SCOLS; args.out[O_SHS + e] = PROJ[(size_t)b * INP + ACOLS + c]; } }
    }
#endif
    GRID_BAR();

#ifndef NO_P3
    {
        { pg8::Gemm g{(const pg8::bf16_t*)(ws + WS_A1), (const pg8::bf16_t*)(ws + WS_WWA), M, 2048, opaque_int(128)}; pg8::StaticOrder S; S.init(M, 2048, F.G, (int)blockIdx.x);
          EpiWA E{(bf16*)(ws + WS_E), (bf16*)(ws + WS_AV), args.in[I_W0], args.in[I_A0]};
          pg8::gemm_phase<EpiWA, pg8::StaticOrder, true, true>(F.lds + RING_OFF, g, S, E); }
        { pg8::Gemm g{(const pg8::bf16_t*)(ws + WS_A2), (const pg8::bf16_t*)(ws + WS_WG), M, 1024, opaque_int(256)}; pg8::StaticOrder S; S.init(M, 1024, F.G, (int)blockIdx.x);
          EpiPlain E{(bf16*)(ws + WS_GATE), 1024};
          pg8::gemm_phase<EpiPlain, pg8::StaticOrder, true, true>(F.lds + RING_OFF, g, S, E); }
        combine_groups(F, (const bf16*)(ws + WS_OG), (const float*)(ws + WS_LSE), (bf16*)(ws + WS_OA));
    }
#endif
    GRID_BAR();

#ifndef NO_P4
    scan_phase(F, args, ws);
#endif
    GRID_BAR();

#ifndef NO_P5
    r3_rows(F, args, ws);
#endif
    GRID_BAR();

#ifndef NO_P6
    {
        s_proj(F, ws);
        { pg8::Gemm g{(const pg8::bf16_t*)(ws + WS_OA), (const pg8::bf16_t*)(ws + WS_WA), M, DM, opaque_int(AWID)}; pg8::StaticOrder S; S.init(M, DM, F.G, (int)blockIdx.x);
          EpiPA E{(const bf16*)(ws + WS_GT), (float*)(ws + WS_Y1)};
          pg8::gemm_phase<EpiPA, pg8::StaticOrder, true, true>(F.lds + RING_OFF, g, S, E); }
        VM_WAIT(); __syncthreads();
        { pg8::Gemm g{(const pg8::bf16_t*)(ws + WS_OB), (const pg8::bf16_t*)(ws + WS_WB), M, DM, opaque_int(BWID)}; pg8::StaticOrder S; S.init(M, DM, F.G, (int)blockIdx.x);
          EpiPB E{(const bf16*)(ws + WS_GT), (const float*)(ws + WS_Y1), (bf16*)(ws + WS_MG)};
          pg8::gemm_phase<EpiPB, pg8::StaticOrder, true, true>(F.lds + RING_OFF, g, S, E); }
    }
#endif
    GRID_BAR();

#ifndef NO_P7
    {
        s_out(F, args, ws);
        pg8::Gemm g{(const pg8::bf16_t*)(ws + WS_MG), (const pg8::bf16_t*)(ws + WS_WO), M, DM, opaque_int(DM)}; pg8::StaticOrder S; S.init(M, DM, F.G, (int)blockIdx.x);
        EpiRes E{args.in[I_XP], (float*)(ws + WS_X1), (bf16*)(ws + WS_X1B), (float*)(ws + WS_SS)};
        pg8::gemm_phase<EpiRes, pg8::StaticOrder, true, true>(F.lds + RING_OFF, g, S, E);
    }
#endif
    GRID_BAR();

#ifndef NO_P8
    {
        s_gu(F, ws);
        pg8::Gemm g{(const pg8::bf16_t*)(ws + WS_X1B), (const pg8::bf16_t*)(ws + WS_WGU), M, GU, opaque_int(DM)}; pg8::StaticOrder S; S.init(M, GU, F.G, (int)blockIdx.x);
        EpiGU E{(const float*)(ws + WS_SS), (bf16*)(ws + WS_ACT)};
        pg8::gemm_phase<EpiGU, pg8::StaticOrder, true, true>(F.lds + RING_OFF, g, S, E);
    }
#endif
    GRID_BAR();

#ifndef NO_P9
    {
        s_down(F, ws);
        pg8::Gemm g{(const pg8::bf16_t*)(ws + WS_ACT), (const pg8::bf16_t*)(ws + WS_WD), M, DM, opaque_int(DFF)}; pg8::StaticOrder S; S.init(M, DM, F.G, (int)blockIdx.x);
        EpiRes E{(const float*)(ws + WS_X1), args.out + O_YP, nullptr, (float*)(ws + WS_SS2)};
        pg8::gemm_phase<EpiRes, pg8::StaticOrder, true, true>(F.lds + RING_OFF, g, S, E);
    }
#endif
    GRID_BAR();

#ifndef NO_P10
    final_norm(F, args, ws);
#endif
}

extern "C" void kernel_launch(void* const* d_in, const int* in_sizes, int n_in, void* d_out, int out_size, void* d_ws, size_t ws_size, hipStream_t stream) {
    static int grid = 0;
    if (grid == 0) {
        if (n_in != 28 || in_sizes[0] != M * DM || (size_t)out_size != O_END || ws_size < WS_END) {
            fprintf(stderr, "kernel_launch: unexpected shapes: n_in %d in0 %d out %d ws %zu (need %zu)\n", n_in, n_in > 0 ? in_sizes[0] : -1, out_size, ws_size, (size_t)WS_END); grid = -1; return; }
        int dev = 0, cus = 0, per_cu = 0;
        if (hipGetDevice(&dev) != hipSuccess || hipDeviceGetAttribute(&cus, hipDeviceAttributeMultiprocessorCount, dev) != hipSuccess) { grid = -1; return; }
        if (hipFuncSetAttribute((const void*)fwd_kernel, hipFuncAttributeMaxDynamicSharedMemorySize, LDS_BYTES) != hipSuccess) { fprintf(stderr, "kernel_launch: hipFuncSetAttribute failed\n"); grid = -1; return; }
        if (hipOccupancyMaxActiveBlocksPerMultiprocessor(&per_cu, (const void*)fwd_kernel, NWAVES * 64, LDS_BYTES) != hipSuccess || per_cu < 1) {
            fprintf(stderr, "kernel_launch: occupancy query says %d blocks per CU\n", per_cu); (void)hipGetLastError(); grid = -1; return; }
        grid = cus;
    }
    if (grid < 0) return;
    if (hipMemsetAsync((char*)d_ws + WS_CTL, 0, CTL_ZERO_BYTES, stream) != hipSuccess) return;
    Args a{};
    for (int i = 0; i < 28; ++i) a.in[i] = (const float*)d_in[i];
    a.out = (float*)d_out; a.ws = (unsigned char*)d_ws;
    hipLaunchKernelGGL(fwd_kernel, dim3(grid), dim3(NWAVES * 64), LDS_BYTES, stream, a);
}
```

```cpp
#include <hip/hip_runtime.h>
#include <cstdio>
#include <cstdint>
namespace pg8 {
#define PG8_LAS __attribute__((address_space(3)))
typedef unsigned short bf16_t;
typedef short bf16x8 __attribute__((ext_vector_type(8)));
typedef float f32x4 __attribute__((ext_vector_type(4)));
typedef unsigned u32x4 __attribute__((ext_vector_type(4)));
constexpr int BM = 256, BK = 64, HALF = 128, HTB = HALF * BK * 2  , STAGE_BYTES = 8 * HTB, NXCD = 8, WGM = 8;

__host__ __device__ __forceinline__ int lds_byte(int r, int c) { const int st = (r >> 4) * 2 + (c >> 5), rr = r & 15, cc = c & 31, ob = rr * 64 + cc * 2; return st * 1024 + (ob ^ (((ob >> 9) & 1) << 5)); }
__host__ __device__ __forceinline__ void stage_rc(int b, int& R, int& C) { const int st = b / 1024, sb = b % 1024, swz = sb ^ (((sb >> 9) & 1) << 5); R = (st >> 1) * 16 + swz / 64; C = (st & 1) * 32 + (swz % 64) / 2; }
__host__ __device__ __forceinline__ int perm32(int rho) { const int n = rho >> 4, i = rho & 15; return 8 * (i >> 2) + 4 * n + (i & 3); }

struct Unit { int pm, pn; };
struct Gemm { const bf16_t* A; const bf16_t* Bt; int M, N, K; };

struct StaticOrder {
    int nM, nN, nwg, G, c;
    __host__ __device__ void init(int M, int N, int G_, int c_) { nM = M / BM; nN = N / BM; nwg = nM * nN; G = G_; c = c_; }
    __host__ __device__ bool next(int i, Unit& u) const {
        const long L = (long)i * G + c; if (L >= nwg) return false;
        int wgid = (int)L; { const int q = nwg / NXCD, r = nwg % NXCD, xcd = wgid % NXCD, off = wgid / NXCD; wgid = (xcd < r ? xcd * (q + 1) : r * (q + 1) + (xcd - r) * q) + off; }
        const int nig = WGM * nN, gid = wgid / nig, fm = gid * WGM, gsz = (nM - fm) < WGM ? (nM - fm) : WGM;
        u.pm = fm + ((wgid % nig) % gsz); u.pn = (wgid % nig) / gsz; return true;
    }
    __device__ __forceinline__ void a_ready(const Unit&) const {}
    __device__ __forceinline__ void done(const Unit&) const {}
};

__device__ __forceinline__ unsigned cvt_pk_bf16(float lo, float hi) { unsigned r; asm volatile("v_cvt_pk_bf16_f32 %0, %1, %2" : "=v"(r) : "v"(lo), "v"(hi)); return r; }
template <class Epi, class Sched, bool ALIGN_EPI = false, bool SP2 = false>
__device__ __forceinline__ void gemm_phase(PG8_LAS unsigned char* lds, const Gemm g, const Sched& S, const Epi& E) {
    int tid_ = threadIdx.x; asm volatile("" : "+v"(tid_));
    const int tid = tid_, wid = __builtin_amdgcn_readfirstlane(tid >> 6), lane = tid & 63, wr = wid >> 2, wc = wid & 3, fr = lane & 15, fq = lane >> 4;
    const int K = g.K, nt = K / BK;
    unsigned voffA[2], voffB[2];
#pragma unroll
    for (int i = 0; i < 2; ++i) { int R, C; stage_rc(tid * 16 + i * 8192, R, C); const int Rb = Epi::PERM ? ((R & ~31) + perm32(R & 31)) : R;
        voffA[i] = (unsigned)(R * K + C) * 2u; voffB[i] = (unsigned)(Rb * K + C) * 2u; }
    const size_t kstep = (size_t)(BK * 2);
    const size_t hstep = (size_t)HALF * K * 2;
    const size_t tstep = 2 * hstep;
    const unsigned ldsw = (unsigned)wid * 1024u;
    const int aoff = lds_byte(wr * 64 + fr, fq * 8), boff = lds_byte(wc * 32 + fr, fq * 8);
#define PG8_SA(b, h) (((b) * 2 + (h)) * HTB)
#define PG8_SB(b, h) ((4 + (b) * 2 + (h)) * HTB)
#define PG8_STAGE(bufoff, gbase, voff) do { _Pragma("unroll") for (int _i = 0; _i < 2; ++_i) \
        __builtin_amdgcn_global_load_lds((const unsigned*)((const char*)(gbase) + (voff)[_i]), (PG8_LAS unsigned*)(lds + (bufoff) + ldsw + _i * 8192), 16, 0, 0); } while (0)
#define PG8_LDA(dst, b, h) do { _Pragma("unroll") for (int m = 0; m < 4; ++m) _Pragma("unroll") for (int k = 0; k < 2; ++k) dst[m][k] = *(const PG8_LAS bf16x8*)(lds + PG8_SA(b, h) + aoff + m * 2048 + k * 1024); } while (0)
#define PG8_LDB(dst, b, h) do { _Pragma("unroll") for (int n = 0; n < 2; ++n) _Pragma("unroll") for (int k = 0; k < 2; ++k) dst[n][k] = *(const PG8_LAS bf16x8*)(lds + PG8_SB(b, h) + boff + n * 2048 + k * 1024); } while (0)
#define PG8_MMA(ai, bj, At, Bt) do { __builtin_amdgcn_s_setprio(1); _Pragma("unroll") for (int m = 0; m < 4; ++m) _Pragma("unroll") for (int n = 0; n < 2; ++n) _Pragma("unroll") for (int k = 0; k < 2; ++k) \
        acc[ai][bj][m][n] = __builtin_amdgcn_mfma_f32_16x16x32_bf16(Bt[n][k], At[m][k], acc[ai][bj][m][n], 0, 0, 0); __builtin_amdgcn_s_setprio(0); } while (0)
#define PG8_WAIT_V(n) asm volatile("s_waitcnt vmcnt(" #n ")" ::: "memory")
#define PG8_WAIT_L(n) asm volatile("s_waitcnt lgkmcnt(" #n ")" ::: "memory")
#define PG8_BAR __builtin_amdgcn_s_barrier()
#define PG8_SCHED __builtin_amdgcn_sched_barrier(0)
    Unit cur, nxt; int ui = 0;
    if (!S.next(0, cur)) return;
    f32x4 acc[2][2][4][2];
#pragma unroll
    for (int a = 0; a < 2; ++a)
#pragma unroll
        for (int b = 0; b < 2; ++b)
#pragma unroll
            for (int m = 0; m < 4; ++m)
#pragma unroll
                for (int n = 0; n < 2; ++n) acc[a][b][m][n] = (f32x4){0.f, 0.f, 0.f, 0.f};
    bf16x8 At[4][2], B0[2][2], B1[2][2];
    const char* cA = (const char*)g.A + (size_t)cur.pm * tstep; const char* cB = (const char*)g.Bt + (size_t)cur.pn * tstep;
    S.a_ready(cur);
    if constexpr (SP2) {
        PG8_STAGE(PG8_SB(0, 0), cB, voffB); PG8_STAGE(PG8_SB(0, 1), cB + hstep, voffB); PG8_STAGE(PG8_SA(0, 0), cA, voffA); PG8_STAGE(PG8_SA(0, 1), cA + hstep, voffA);
        if (wr == 1) PG8_BAR;
        PG8_WAIT_V(2); PG8_BAR;
        PG8_STAGE(PG8_SB(1, 0), cB + kstep, voffB); PG8_STAGE(PG8_SA(1, 0), cA + kstep, voffA); PG8_STAGE(PG8_SB(1, 1), cB + hstep + kstep, voffB);
        PG8_WAIT_V(6); PG8_BAR;
    } else {
        PG8_STAGE(PG8_SB(0, 0), cB, voffB); PG8_STAGE(PG8_SA(0, 0), cA, voffA); PG8_STAGE(PG8_SB(0, 1), cB + hstep, voffB); PG8_STAGE(PG8_SA(0, 1), cA + hstep, voffA);
        if (wr == 1) PG8_BAR;
        PG8_WAIT_V(4); PG8_BAR;
        PG8_STAGE(PG8_SB(1, 0), cB + kstep, voffB); PG8_STAGE(PG8_SA(1, 0), cA + kstep, voffA); PG8_STAGE(PG8_SB(1, 1), cB + hstep + kstep, voffB);
        PG8_WAIT_V(6); PG8_BAR;
    }
    for (;;) {
        const bool has_next = S.next(ui + 1, nxt);
        const char* nA = has_next ? (const char*)g.A + (size_t)nxt.pm * tstep : cA; const char* nB = has_next ? (const char*)g.Bt + (size_t)nxt.pn * tstep : cB;
        for (int t = 0; t < nt; t += 2) {
            const bool last = (t == nt - 2);
            const char* a1 = cA + (size_t)(t + 1) * kstep;
            const char* a2 = last ? nA : cA + (size_t)(t + 2) * kstep; const char* b2 = last ? nB : cB + (size_t)(t + 2) * kstep;
            const char* a3 = a2 + kstep; const char* b3 = b2 + kstep;
            if (last && has_next) S.a_ready(nxt);
            if constexpr (SP2) {
            PG8_LDB(B0, 0, 0); PG8_LDB(B1, 0, 1); PG8_SCHED; PG8_LDA(At, 0, 0); PG8_STAGE(PG8_SA(1, 1), a1 + hstep, voffA);
            PG8_WAIT_V(8); PG8_WAIT_L(0); PG8_BAR; PG8_MMA(0, 0, At, B0); PG8_MMA(0, 1, At, B1); PG8_BAR; PG8_SCHED;
            PG8_LDA(At, 0, 1); PG8_STAGE(PG8_SB(0, 0), b2, voffB); PG8_STAGE(PG8_SB(0, 1), b2 + hstep, voffB); PG8_STAGE(PG8_SA(0, 0), a2, voffA);
            PG8_WAIT_V(8); PG8_WAIT_L(0); PG8_BAR; PG8_MMA(1, 0, At, B0); PG8_MMA(1, 1, At, B1); PG8_BAR; PG8_SCHED;
            PG8_LDB(B0, 1, 0); PG8_LDB(B1, 1, 1); PG8_SCHED; PG8_LDA(At, 1, 0); PG8_STAGE(PG8_SA(0, 1), a2 + hstep, voffA);
            PG8_WAIT_V(8); PG8_WAIT_L(0); PG8_BAR; PG8_MMA(0, 0, At, B0); PG8_MMA(0, 1, At, B1); PG8_BAR; PG8_SCHED;
            PG8_LDA(At, 1, 1); PG8_STAGE(PG8_SB(1, 0), b3, voffB); PG8_STAGE(PG8_SB(1, 1), b3 + hstep, voffB); PG8_STAGE(PG8_SA(1, 0), a3, voffA);
            PG8_WAIT_V(8); PG8_WAIT_L(0); PG8_BAR; PG8_MMA(1, 0, At, B0); PG8_MMA(1, 1, At, B1); PG8_BAR; PG8_SCHED;
            } else {
            PG8_LDB(B0, 0, 0); PG8_SCHED; PG8_LDA(At, 0, 0); PG8_STAGE(PG8_SA(1, 1), a1 + hstep, voffA);
            PG8_WAIT_L(8); PG8_BAR; PG8_WAIT_L(0); PG8_MMA(0, 0, At, B0); PG8_BAR; PG8_SCHED;
            PG8_LDB(B1, 0, 1); PG8_STAGE(PG8_SB(0, 0), b2, voffB);
            PG8_BAR; PG8_WAIT_L(0); PG8_MMA(0, 1, At, B1); PG8_BAR;
            PG8_LDA(At, 0, 1); PG8_STAGE(PG8_SA(0, 0), a2, voffA);
            PG8_BAR; PG8_WAIT_L(0); PG8_MMA(1, 0, At, B0); PG8_BAR; PG8_SCHED;
            PG8_STAGE(PG8_SB(0, 1), b2 + hstep, voffB);
            PG8_WAIT_V(6); PG8_BAR; PG8_MMA(1, 1, At, B1); PG8_BAR;
            PG8_LDB(B0, 1, 0); PG8_SCHED; PG8_LDA(At, 1, 0); PG8_STAGE(PG8_SA(0, 1), a2 + hstep, voffA);
            PG8_WAIT_L(8); PG8_BAR; PG8_WAIT_L(0); PG8_MMA(0, 0, At, B0); PG8_BAR; PG8_SCHED;
            PG8_LDB(B1, 1, 1); PG8_STAGE(PG8_SB(1, 0), b3, voffB);
            PG8_BAR; PG8_WAIT_L(0); PG8_MMA(0, 1, At, B1); PG8_BAR;
            PG8_LDA(At, 1, 1); PG8_STAGE(PG8_SA(1, 0), a3, voffA);
            PG8_BAR; PG8_WAIT_L(0); PG8_MMA(1, 0, At, B0); PG8_BAR; PG8_SCHED;
            PG8_STAGE(PG8_SB(1, 1), b3 + hstep, voffB);
            PG8_WAIT_V(6); PG8_BAR; PG8_MMA(1, 1, At, B1); PG8_BAR;
            }
        }
        if constexpr (ALIGN_EPI) { if (wr == 0) PG8_BAR; }
        if constexpr (!Epi::AFTER_DRAIN) { E(acc, cur, wr, wc, fr, fq); S.done(cur); }
        if (!has_next) break;
#pragma unroll
        for (int a = 0; a < 2; ++a)
#pragma unroll
            for (int b = 0; b < 2; ++b)
#pragma unroll
                for (int m = 0; m < 4; ++m)
#pragma unroll
                    for (int n = 0; n < 2; ++n) acc[a][b][m][n] = (f32x4){0.f, 0.f, 0.f, 0.f};
        cur = nxt; cA = nA; cB = nB; ++ui;
        if constexpr (ALIGN_EPI) { if (wr == 1) PG8_BAR; }
    }
    PG8_WAIT_V(0);
    if constexpr (!ALIGN_EPI) { if (wr == 0) PG8_BAR; }
    PG8_BAR;
    if constexpr (Epi::AFTER_DRAIN) { E.fused(acc, cur, wr, wc, fr, fq, lds, wid, lane); S.done(cur); }
#undef PG8_SA
#undef PG8_SB
#undef PG8_STAGE
#undef PG8_LDA
#undef PG8_LDB
#undef PG8_MMA
#undef PG8_WAIT_V
#undef PG8_WAIT_L
#undef PG8_BAR
#undef PG8_SCHED
}
}
#ifndef REP_P0
#define REP_P0 1
#endif
#ifndef REP_P1
#define REP_P1 1
#endif
#ifndef REP_P2
#define REP_P2 1
#endif
#ifndef REP_P3
#define REP_P3 1
#endif
#ifndef REP_P4
#define REP_P4 1
#endif
#ifndef REP_P5
#define REP_P5 1
#endif
#ifndef REP_P6
#define REP_P6 1
#endif
#ifndef REP_P8
#define REP_P8 1
#endif

constexpr int NWAVES = 8;
constexpr int DM = 1024, NB = 8, T = 2048, M = NB * T;
constexpr int SB = 32;
constexpr int PAST = 16384;
constexpr int HD = 64, AHEADS = 8, AWID = 512, BHEADS = 16, BWID = 1024;
constexpr int ACOLS = 4608, SCOLS = 3360, SCP = 3584, INCOLS = 10016, INP = 10240;
constexpr int DFF = 2816, GU = 2 * DFF;
constexpr float NORM_EPS = 1e-6f, GN_EPS = 64e-5f;
constexpr float LOG2E = 1.4426950408889634f, LN2 = 0.6931471805599453f;
constexpr float QSCALE = 0.125f * LOG2E;
constexpr size_t O_YP = 0, O_YS = O_YP + (size_t)M * DM, O_KV1P = O_YS + (size_t)SB * DM, O_KV2P = O_KV1P + (size_t)NB * 128 * 1024,
                 O_KV3P = O_KV2P + (size_t)NB * 512 * 1024, O_SHP = O_KV3P + (size_t)NB * 2048 * 1024, O_WKVP = O_SHP + (size_t)NB * SCOLS,
                 O_KV1S = O_WKVP + (size_t)NB * 16 * 4096, O_KV2S = O_KV1S + (size_t)SB * 1024, O_KV3S = O_KV2S + (size_t)SB * 1024,
                 O_SHS = O_KV3S + (size_t)SB * 1024, O_WKVS = O_SHS + (size_t)SB * SCOLS, O_END = O_WKVS + (size_t)SB * 16 * 4096;
static_assert(O_END == 41684224, "output size");
constexpr size_t MiB = 1u << 20;
constexpr size_t WS_CTL = 0, CTL_ZERO_BYTES = 1 * MiB;
constexpr size_t WS_TAB = 1 * MiB;
constexpr size_t WS_SS = 2 * MiB;
constexpr size_t WS_SS2 = WS_SS + 128 * 1024;
constexpr size_t WS_SMP = 3 * MiB;
constexpr size_t WS_WIN = 8 * MiB, WS_WA = 28 * MiB, WS_WB = 29 * MiB, WS_WO = 31 * MiB, WS_WGU = 33 * MiB, WS_WD = 44 * MiB, WS_WWA = 50 * MiB, WS_WG = 51 * MiB;
constexpr size_t WS_XN = 52 * MiB, WS_Q = 84 * MiB, WS_K = 132 * MiB, WS_VT = 180 * MiB, WS_SC = 228 * MiB, WS_GT = 340 * MiB;
constexpr size_t WS_OG = 404 * MiB, WS_LSE = 452 * MiB, WS_OA = 454 * MiB, WS_A1 = 470 * MiB, WS_A2 = 474 * MiB;
constexpr size_t WS_E = 482 * MiB, WS_AV = 514 * MiB, WS_GATE = 546 * MiB, WS_Y = 578 * MiB, WS_CB = 642 * MiB, WS_OB = 643 * MiB;
constexpr size_t WS_Y1 = 675 * MiB, WS_MG = 739 * MiB, WS_X1 = 771 * MiB, WS_X1B = 835 * MiB, WS_END = 867 * MiB;
constexpr size_t WS_ACT = WS_Q;
static_assert((size_t)M * DFF * 2 <= WS_VT - WS_Q, "ACT overlay");
constexpr size_t SM_HSN = 0;
constexpr size_t SM_PROJ = 64 * 1024;
constexpr size_t SM_OA = SM_PROJ + (size_t)SB * INP * 4;
constexpr size_t SM_OB = SM_OA + 32 * 1024;
constexpr size_t SM_YA = SM_OB + 64 * 1024;
constexpr size_t SM_YB = SM_YA + 128 * 1024;
constexpr size_t SM_X1 = SM_YB + 128 * 1024;
constexpr size_t SM_X1B = SM_X1 + 128 * 1024;
constexpr size_t SM_ACT = SM_X1B + 64 * 1024;
constexpr size_t SM_X2 = SM_ACT + 192 * 1024;
constexpr size_t SM_OG = SM_X2 + 128 * 1024;
constexpr size_t SM_LSE = SM_OG + 192 * 1024;
constexpr size_t SM_END = SM_LSE + 4096;
static_assert(SM_END <= 5 * MiB, "sample scratch");
constexpr int CW_BAR = 4096;
constexpr int RING_OFF = 0, RING_BYTES = 131072, LDSCTL_OFF = RING_BYTES, MISC_OFF = LDSCTL_OFF + 320, LDS_BYTES = 147456;

#define GAS __attribute__((address_space(1)))
#define LAS __attribute__((address_space(3)))
typedef unsigned short bf16;
typedef unsigned v4u __attribute__((ext_vector_type(4)));
typedef float f32x4 __attribute__((ext_vector_type(4)));
typedef short bf16x8 __attribute__((ext_vector_type(8)));
typedef GAS unsigned gu32;
typedef GAS unsigned long long gu64;
#define RLX_AGENT __ATOMIC_RELAXED, __HIP_MEMORY_SCOPE_AGENT
#define LDS_WAIT() asm volatile("s_waitcnt lgkmcnt(0)" ::: "memory")
#define VM_WAIT() asm volatile("s_waitcnt vmcnt(0)" ::: "memory")
__device__ __forceinline__ unsigned long long rt() { return __builtin_amdgcn_s_memrealtime(); }
__device__ __forceinline__ unsigned f2bf(float f) { unsigned u = __builtin_bit_cast(unsigned, f); return (u + 0x7fffu + ((u >> 16) & 1u)) >> 16; }
__device__ __forceinline__ unsigned pk2(float lo, float hi) { return f2bf(lo) | (f2bf(hi) << 16); }

#define XB_TMO      128
#define XB_XCNT(j)  (256  + 64 * (j))
#define XB_XSUB(j)  (1280 + 64 * (j))
#define XB_XGEN(j)  (2304 + 64 * (j))
#define XB_TOP      3328
#define XB_TOPGEN   3392
#define XCD_BAR_WORDS 3456
#define XB_SPIN_CAP (1u << 18)

__device__ __forceinline__ unsigned xb_ld(unsigned* p)              { return __hip_atomic_load(p, __ATOMIC_RELAXED, __HIP_MEMORY_SCOPE_AGENT); }
__device__ __forceinline__ unsigned xb_add(unsigned* p, unsigned v) { return __hip_atomic_fetch_add(p, v, __ATOMIC_RELAXED, __HIP_MEMORY_SCOPE_AGENT); }
__device__ __forceinline__ unsigned xb_xcc_id() { return (unsigned)__builtin_amdgcn_s_getreg((3 << 11) | 20) & 0xFu; }
#define XB_SPIN(cond, bar) do { unsigned _sp = 0; while (cond) { __builtin_amdgcn_s_sleep(1); \
    if ((++_sp & 255u) == 0u) { if (xb_ld(&(bar)[XB_TMO])) break; if (_sp > XB_SPIN_CAP) { atomicAdd(&(bar)[XB_TMO], 1u); break; } } } } while (0)

struct XcdBarrier {
    unsigned* bar; unsigned x;
    volatile LAS unsigned* st;
};

__device__ __forceinline__ XcdBarrier xcd_barrier_post(unsigned* bar, volatile LAS unsigned* st) {
    XcdBarrier b; b.bar = bar; b.x = xb_xcc_id(); b.st = st;
    if (threadIdx.x == 0) (void)xb_add(&bar[XB_XCNT(b.x)], 1u);
    return b;
}
__device__ __forceinline__ void xcd_barrier_complete(unsigned* bar, unsigned x, unsigned& nloc, unsigned& nx) {
    const unsigned G = gridDim.x * gridDim.y * gridDim.z;
    unsigned sum, cnt, mine, sp = 0u;
    for (;;) {
        sum = 0u; cnt = 0u; mine = 0u;
#pragma unroll
        for (unsigned j = 0; j < 16; ++j) { const unsigned c = xb_ld(&bar[XB_XCNT(j)]); sum += c; cnt += (c > 0u) ? 1u : 0u; mine = (j == x) ? c : mine; }
        if (sum == G) break;
        __builtin_amdgcn_s_sleep(1);
        if ((++sp & 255u) == 0u) { if (xb_ld(&bar[XB_TMO])) break; if (sp > XB_SPIN_CAP) { atomicAdd(&bar[XB_TMO], 1u); break; } }
    }
    nloc = mine > 0u ? mine : 1u; nx = cnt > 0u ? cnt : 1u;
}

__device__ __forceinline__ void xcd_barrier(const XcdBarrier& b) {
    asm volatile("s_waitcnt vmcnt(0)" ::: "memory");
    __syncthreads();
    if (threadIdx.x == 0) {
        unsigned* bar = b.bar;
        __builtin_amdgcn_s_waitcnt(0);
        unsigned nloc = b.st[0], nx = b.st[1];
        if (nloc == 0u) { xcd_barrier_complete(bar, b.x, nloc, nx); b.st[0] = nloc; b.st[1] = nx; }
        const unsigned old = xb_add(&bar[XB_XSUB(b.x)], 1u);
        const unsigned gen = old / nloc;
        if (old + 1u == (gen + 1u) * nloc) {
            __builtin_amdgcn_fence(__ATOMIC_RELEASE, "agent");
            asm volatile("s_waitcnt vmcnt(0)" ::: "memory");
            const unsigned og = xb_add(&bar[XB_TOP], 1u);
            const unsigned tg = og / nx;
            if (og + 1u == (tg + 1u) * nx) xb_add(&bar[XB_TOPGEN], 1u);
            else XB_SPIN(xb_ld(&bar[XB_TOPGEN]) == tg, bar);
            __builtin_amdgcn_fence(__ATOMIC_ACQUIRE, "agent");
            xb_add(&bar[XB_XGEN(b.x)], 1u);
            asm volatile("s_waitcnt vmcnt(0)" ::: "memory");
        } else {
            XB_SPIN(xb_ld(&bar[XB_XGEN(b.x)]) == gen, bar);
            __builtin_amdgcn_fence(__ATOMIC_ACQUIRE, "agent");
            asm volatile("s_waitcnt vmcnt(0)" ::: "memory");
        }
    }
    __syncthreads();
}

struct Args { const float* in[28]; float* out; unsigned char* ws; };
enum { I_XP = 0, I_XS, I_C1, I_C2, I_C3, I_SSH, I_SWKV, I_NMIX, I_WIN, I_MU, I_W0, I_W2, I_A0, I_A2, I_G2, I_KK, I_KA, I_RK, I_GNW, I_GNB,
       I_WPA, I_WPB, I_WOUT, I_NFFN, I_WGATE, I_WUP, I_WDOWN, I_NFIN };
typedef float f32x2 __attribute__((ext_vector_type(2)));
typedef unsigned u32x2 __attribute__((ext_vector_type(2)));

__device__ __forceinline__ float wave_sum(float v) {
#pragma unroll
    for (int o = 1; o < 64; o <<= 1) v += __shfl_xor(v, o);
    return v;
}
__device__ __forceinline__ float bf2f(unsigned short h) { return __builtin_bit_cast(float, (unsigned)h << 16); }
__device__ __forceinline__ float bflo(unsigned w) { return __builtin_bit_cast(float, w << 16); }
__device__ __forceinline__ float bfhi(unsigned w) { return __builtin_bit_cast(float, w & 0xffff0000u); }
__device__ __forceinline__ float sigmoidf_(float x) { return 1.0f / (1.0f + __expf(-x)); }

__device__ const float ROPE_FREQ[32] = {
    1.000000000e+00f, 7.498942614e-01f, 5.623413324e-01f, 4.216965139e-01f, 3.162277639e-01f, 2.371373773e-01f, 1.778279394e-01f, 1.333521307e-01f,
    1.000000015e-01f, 7.498941571e-02f, 5.623413250e-02f, 4.216965288e-02f, 3.162277490e-02f, 2.371373773e-02f, 1.778279431e-02f, 1.333521493e-02f,
    9.999999776e-03f, 7.498941850e-03f, 5.623413250e-03f, 4.216964822e-03f, 3.162277630e-03f, 2.371373586e-03f, 1.778279431e-03f, 1.333521446e-03f,
    1.000000047e-03f, 7.498942432e-04f, 5.623413017e-04f, 4.216965172e-04f, 3.162277571e-04f, 2.371373703e-04f, 1.778279402e-04f, 1.333521504e-04f};
__device__ __forceinline__ void sincos_acc(float xf, float& s, float& c) {
    const double x = (double)xf;
    const double q = __builtin_rint(x * 0.63661977236758134308);
    double r = __builtin_fma(-q, 1.57079632679489655800e+00, x); r = __builtin_fma(-q, 6.12323399573676603587e-17, r);
    const double r2 = r * r;
    double sp = -1.0 / 1307674368000.0; sp = sp * r2 + 1.0 / 6227020800.0; sp = sp * r2 - 1.0 / 39916800.0; sp = sp * r2 + 1.0 / 362880.0; sp = sp * r2 - 1.0 / 5040.0; sp = sp * r2 + 1.0 / 120.0; sp = sp * r2 - 1.0 / 6.0; sp = sp * r2 + 1.0; sp *= r;
    double cp = 1.0 / 20922789888000.0; cp = cp * r2 - 1.0 / 87178291200.0; cp = cp * r2 + 1.0 / 479001600.0; cp = cp * r2 - 1.0 / 3628800.0; cp = cp * r2 + 1.0 / 40320.0; cp = cp * r2 - 1.0 / 720.0; cp = cp * r2 + 1.0 / 24.0; cp = cp * r2 - 0.5; cp = cp * r2 + 1.0;
    const int qi = (int)((long long)q & 3);
    const double ss = (qi & 1) ? cp : sp, cc = (qi & 1) ? sp : cp;
    s = (float)((qi & 2) ? -ss : ss);
    c = (float)(((qi + 1) & 2) ? -cc : cc);
}

template <class Src> __device__ __forceinline__ void tr_item(const Src& src, bf16* WT, int Kd, LAS float* scr, int k0, int n0, int lane) {
#pragma unroll 8
    for (int i = 0; i < 32; ++i) { const int kk = 2 * i + (lane >> 5); scr[kk * 33 + (lane & 31)] = src(k0 + kk, n0 + (lane & 31)); }
    LDS_WAIT(); asm volatile("" ::: "memory");
    const int c = lane & 7;
#pragma unroll
    for (int j = 0; j < 4; ++j) { const int n = (lane >> 3) + 8 * j; const LAS float* s = scr + (8 * c) * 33 + n;
        v4u o; o.x = pk2(s[0 * 33], s[1 * 33]); o.y = pk2(s[2 * 33], s[3 * 33]); o.z = pk2(s[4 * 33], s[5 * 33]); o.w = pk2(s[6 * 33], s[7 * 33]);
        *(GAS v4u*)(WT + (size_t)(n0 + n) * Kd + k0 + 8 * c) = o; }
    LDS_WAIT(); asm volatile("" ::: "memory");
}
__device__ __forceinline__ int win_src_col(int np) {
    if (np < ACOLS) { const int part = np >> 9, kind = part % 3, within = np & 511, head = within >> 6, pos = within & 63;
        const int d = (kind < 2) ? ((pos & 1) * 32 + (pos >> 1)) : pos; return part * 512 + head * 64 + d; }
    if (np < ACOLS + SCP) { const int j = np - ACOLS; return j < SCOLS ? ACOLS + j : -1; }
    return ACOLS + SCOLS + (np - (ACOLS + SCP));
}

struct EpiIn {
    static constexpr bool PERM = true, AFTER_DRAIN = false;
    bf16* Q; bf16* Kb; bf16* VT; bf16* SC; bf16* GT; float* out; const float* rope;
    __device__ __forceinline__ void operator()(const pg8::f32x4 (&acc)[2][2][4][2], const pg8::Unit& u, int wr, int wc, int fr, int fq) const {
        const int tn = u.pn;
        const int rowb = u.pm * 256 + wr * 64 + fr;
        if (tn < 18) {
            const int part = tn >> 1, g = part / 3, kind = part - 3 * g, hf = tn & 1;
            const int lgd = 2 * g, dil = 1 << lgd, L = T >> lgd, keep = (g == 0) ? 128 : (g == 1) ? 512 : 2048;
            const size_t okv = (g == 0) ? O_KV1P : (g == 1) ? O_KV2P : O_KV3P;
            const int pos0 = 32 * (wc & 1) + 8 * fq;
#pragma unroll
            for (int ai = 0; ai < 2; ++ai)
#pragma unroll
                for (int m = 0; m < 4; ++m) {
                    const int row = rowb + ai * 128 + m * 16, b = row >> 11, t = row & (T - 1);
                    const int p = (t & (dil - 1)) * L + (t >> lgd);
                    const size_t prow = (size_t)g * M + (size_t)b * T + p;
                    const int tk = t - (T - keep);
                    if (kind < 2) {
                        const int i0 = pos0 >> 1;
                        const pg8::f32x4 cs0 = *(const pg8::f32x4*)(rope + ((size_t)t * 32 + i0) * 2), cs1 = *(const pg8::f32x4*)(rope + ((size_t)t * 32 + i0 + 2) * 2);
#pragma unroll
                        for (int bj = 0; bj < 2; ++bj) {
                            const int head = 4 * hf + 2 * bj + (wc >> 1);
                            const pg8::f32x4 v0 = acc[ai][bj][m][0], v1 = acc[ai][bj][m][1];
                            float o[8];
                            o[0] = v0[0] * cs0[0] - v0[1] * cs0[1]; o[1] = v0[0] * cs0[1] + v0[1] * cs0[0];
                            o[2] = v0[2] * cs0[2] - v0[3] * cs0[3]; o[3] = v0[2] * cs0[3] + v0[3] * cs0[2];
                            o[4] = v1[0] * cs1[0] - v1[1] * cs1[1]; o[5] = v1[0] * cs1[1] + v1[1] * cs1[0];
                            o[6] = v1[2] * cs1[2] - v1[3] * cs1[3]; o[7] = v1[2] * cs1[3] + v1[3] * cs1[2];
                            if (kind == 0) {
                                pg8::u32x4 w; w.x = pg8::cvt_pk_bf16(o[0] * QSCALE, o[1] * QSCALE); w.y = pg8::cvt_pk_bf16(o[2] * QSCALE, o[3] * QSCALE);
                                w.z = pg8::cvt_pk_bf16(o[4] * QSCALE, o[5] * QSCALE); w.w = pg8::cvt_pk_bf16(o[6] * QSCALE, o[7] * QSCALE);
                                *(pg8::u32x4*)(Q + prow * 512 + head * 64 + pos0) = w;
                            } else {
                                pg8::u32x4 w; w.x = pg8::cvt_pk_bf16(o[0], o[1]); w.y = pg8::cvt_pk_bf16(o[2], o[3]); w.z = pg8::cvt_pk_bf16(o[4], o[5]); w.w = pg8::cvt_pk_bf16(o[6], o[7]);
                                *(pg8::u32x4*)(Kb + prow * 512 + head * 64 + pos0) = w;
                                if (tk >= 0) { float* ob = out + okv + (((size_t)b * keep + tk) * 2 + 0) * 512 + head * 64;
                                    *(pg8::f32x4*)(ob + i0) = (pg8::f32x4){o[0], o[2], o[4], o[6]}; *(pg8::f32x4*)(ob + 32 + i0) = (pg8::f32x4){o[1], o[3], o[5], o[7]}; }
                            }
                        }
                    } else {
#pragma unroll
                        for (int bj = 0; bj < 2; ++bj) {
                            const int head = 4 * hf + 2 * bj + (wc >> 1);
                            const pg8::f32x4 v0 = acc[ai][bj][m][0], v1 = acc[ai][bj][m][1];
                            pg8::u32x4 w; w.x = pg8::cvt_pk_bf16(v0[0], v0[1]); w.y = pg8::cvt_pk_bf16(v0[2], v0[3]); w.z = pg8::cvt_pk_bf16(v1[0], v1[1]); w.w = pg8::cvt_pk_bf16(v1[2], v1[3]);
                            *(pg8::u32x4*)(VT + prow * 512 + head * 64 + pos0) = w;
                            if (tk >= 0) { float* ob = out + okv + (((size_t)b * keep + tk) * 2 + 1) * 512 + head * 64 + pos0;
                                *(pg8::f32x4*)(ob) = v0; *(pg8::f32x4*)(ob + 4) = v1; }
                        }
                    }
                }
        } else if (tn < 32) {
            const int cb = (tn - 18) * 256 + wc * 32 + 8 * fq;
#pragma unroll
            for (int ai = 0; ai < 2; ++ai)
#pragma unroll
                for (int m = 0; m < 4; ++m) {
                    const int row = rowb + ai * 128 + m * 16, b = row >> 11, t = row & (T - 1);
#pragma unroll
                    for (int bj = 0; bj < 2; ++bj) {
                        const int col = cb + bj * 128;
                        const pg8::f32x4 v0 = acc[ai][bj][m][0], v1 = acc[ai][bj][m][1];
                        pg8::u32x4 w; w.x = pg8::cvt_pk_bf16(v0[0], v0[1]); w.y = pg8::cvt_pk_bf16(v0[2], v0[3]); w.z = pg8::cvt_pk_bf16(v1[0], v1[1]); w.w = pg8::cvt_pk_bf16(v1[2], v1[3]);
                        *(pg8::u32x4*)(SC + (size_t)row * SCP + col) = w;
                        if (t == T - 1 && col < SCOLS) { float* ob = out + O_SHP + (size_t)b * SCOLS + col; *(pg8::f32x4*)(ob) = v0; *(pg8::f32x4*)(ob + 4) = v1; }
                    }
                }
        } else {
            const int cb = (tn - 32) * 256 + wc * 32 + 8 * fq;
#pragma unroll
            for (int ai = 0; ai < 2; ++ai)
#pragma unroll
                for (int m = 0; m < 4; ++m) {
                    const int row = rowb + ai * 128 + m * 16;
#pragma unroll
                    for (int bj = 0; bj < 2; ++bj) {
                        const int col = cb + bj * 128;
                        const pg8::f32x4 v0 = acc[ai][bj][m][0], v1 = acc[ai][bj][m][1];
                        pg8::u32x4 w; w.x = pg8::cvt_pk_bf16(sigmoidf_(v0[0]), sigmoidf_(v0[1])); w.y = pg8::cvt_pk_bf16(sigmoidf_(v0[2]), sigmoidf_(v0[3]));
                        w.z = pg8::cvt_pk_bf16(sigmoidf_(v1[0]), sigmoidf_(v1[1])); w.w = pg8::cvt_pk_bf16(sigmoidf_(v1[2]), sigmoidf_(v1[3]));
                        *(pg8::u32x4*)(GT + (size_t)row * 2048 + col) = w;
                    }
                }
        }
    }
};

__device__ __forceinline__ int opaque_int(int v) { asm volatile("" : "+s"(v)); return v; }
struct Frame {
    LAS unsigned char* lds; volatile LAS unsigned* MISC; gu32* ctl;
    int tid, lane, wave, vcu, G, gw, NGW;
};

__device__ __forceinline__ void p0_prologue(const Frame& F, const Args& a, unsigned char* ws) {
    LAS float* scr = (LAS float*)(F.lds + RING_OFF + F.wave * 16384);
    const int gw = F.gw, NGW = F.NGW, lane = F.lane;
    constexpr int IT_WIN = 16 * (INP / 32), IT_WA = 8 * 32, IT_WB = 16 * 32, IT_WO = 16 * 32, IT_WGU = 16 * (GU / 32), IT_WD = 44 * 32, IT_WWA = 2 * 64, IT_WG = 4 * 32;
    constexpr int NITEMS = IT_WIN + IT_WA + IT_WB + IT_WO + IT_WGU + IT_WD + IT_WWA + IT_WG;
    for (int it = gw; it < NITEMS; it += NGW) {
        int r = it;
        if (r < IT_WIN) { const int nb = r % (INP / 32), kb = r / (INP / 32); const float* W = a.in[I_WIN];
            tr_item([&](int k, int np) { const int sc = win_src_col(np); return sc >= 0 ? W[(size_t)k * INCOLS + sc] : 0.f; }, (bf16*)(ws + WS_WIN), DM, scr, 64 * kb, 32 * nb, lane); continue; }
        r -= IT_WIN;
        if (r < IT_WA) { const int nb = r % 32, kb = r / 32; const float* W = a.in[I_WPA];
            tr_item([&](int k, int n) { return W[(size_t)k * DM + n]; }, (bf16*)(ws + WS_WA), AWID, scr, 64 * kb, 32 * nb, lane); continue; }
        r -= IT_WA;
        if (r < IT_WB) { const int nb = r % 32, kb = r / 32; const float* W = a.in[I_WPB];
            tr_item([&](int k, int n) { return W[(size_t)k * DM + n]; }, (bf16*)(ws + WS_WB), BWID, scr, 64 * kb, 32 * nb, lane); continue; }
        r -= IT_WB;
        if (r < IT_WO) { const int nb = r % 32, kb = r / 32; const float* W = a.in[I_WOUT];
            tr_item([&](int k, int n) { return W[(size_t)k * DM + n]; }, (bf16*)(ws + WS_WO), DM, scr, 64 * kb, 32 * nb, lane); continue; }
        r -= IT_WO;
        if (r < IT_WGU) { const int nb = r % (GU / 32), kb = r / (GU / 32); const int n0 = 32 * nb, tile = n0 >> 8, w0 = n0 & 255;
            const float* W = (w0 < 128) ? a.in[I_WGATE] : a.in[I_WUP]; const float* gsc = a.in[I_NFFN]; const int cbase = tile * 128 + (w0 & 127) - n0;
            tr_item([&](int k, int np) { return W[(size_t)k * DFF + cbase + np] * gsc[k]; }, (bf16*)(ws + WS_WGU), DM, scr, 64 * kb, n0, lane); continue; }
        r -= IT_WGU;
        if (r < IT_WD) { const int nb = r % 32, kb = r / 32; const float* W = a.in[I_WDOWN];
            tr_item([&](int k, int n) { return W[(size_t)k * DM + n]; }, (bf16*)(ws + WS_WD), DFF, scr, 64 * kb, 32 * nb, lane); continue; }
        r -= IT_WD;
        if (r < IT_WWA) { const int nb = r % 64, kb = r / 64; const float* W2 = a.in[I_W2]; const float* A2 = a.in[I_A2];
            tr_item([&](int k, int n) { return (n < 1024) ? (k < 64 ? W2[(size_t)k * BWID + n] : 0.f) : (k >= 64 ? A2[(size_t)(k - 64) * BWID + (n - 1024)] : 0.f); }, (bf16*)(ws + WS_WWA), 128, scr, 64 * kb, 32 * nb, lane); continue; }
        r -= IT_WWA;
        { const int nb = r % 32, kb = r / 32; const float* G2 = a.in[I_G2];
            tr_item([&](int k, int n) { return k < 160 ? G2[(size_t)k * BWID + n] : 0.f; }, (bf16*)(ws + WS_WG), 256, scr, 64 * kb, 32 * nb, lane); }
    }
    {
        const float* gmix = a.in[I_NMIX];
        f32x4 gv[4];
#pragma unroll
        for (int j = 0; j < 4; ++j) gv[j] = *(const f32x4*)(gmix + 4 * lane + 256 * j);
        for (int m = gw; m < M + SB; m += NGW) {
            const float* xrow = (m < M) ? a.in[I_XP] + (size_t)m * DM : a.in[I_XS] + (size_t)(m - M) * DM;
            bf16* orow = (m < M) ? (bf16*)(ws + WS_XN) + (size_t)m * DM : (bf16*)(ws + WS_SMP + SM_HSN) + (size_t)(m - M) * DM;
            const GAS f32x4* xr = (const GAS f32x4*)xrow + lane;
            f32x4 v[4]; float s = 0.f;
#pragma unroll
            for (int j = 0; j < 4; ++j) { v[j] = xr[64 * j]; s += (v[j].x * v[j].x + v[j].y * v[j].y) + (v[j].z * v[j].z + v[j].w * v[j].w); }
            const float rstd = 1.0f / sqrtf(wave_sum(s) * (1.f / DM) + NORM_EPS);
            GAS unsigned long long* o8 = (GAS unsigned long long*)orow + lane;
#pragma unroll
            for (int j = 0; j < 4; ++j) { const f32x4 y = v[j] * rstd * gv[j]; o8[64 * j] = (unsigned long long)pk2(y.x, y.y) | ((unsigned long long)pk2(y.z, y.w) << 32); }
        }
    }
    {
        float* tab = (float*)(ws + WS_TAB);
        for (int e = F.vcu * 512 + F.tid; e < 2049 * 32; e += F.G * 512) {
            const int pi = e >> 5, i = e & 31; const float pos = (pi < 2048) ? (float)pi : (float)PAST;
            const float ang = pos * ROPE_FREQ[i]; float s, c; sincos_acc(ang, s, c);
            *(f32x2*)(tab + 2 * (size_t)e) = (f32x2){c, s};
        }
    }
    {
        float* ss = (float*)(ws + WS_SS);
        for (int e = F.vcu * 512 + F.tid; e < 65536; e += F.G * 512) ss[e] = 0.f;
    }
}


typedef float f32x16 __attribute__((ext_vector_type(16)));
__device__ __forceinline__ float dpp_f(float v, const int ctrl_sel) {
    const int x = __builtin_bit_cast(int, v); int r;
    if (ctrl_sel == 0) r = __builtin_amdgcn_update_dpp(0, x, 0xB1, 0xF, 0xF, true);
    else if (ctrl_sel == 1) r = __builtin_amdgcn_update_dpp(0, x, 0x4E, 0xF, 0xF, true);
    else if (ctrl_sel == 2) r = __builtin_amdgcn_update_dpp(0, x, 0x141, 0xF, 0xF, true);
    else r = __builtin_amdgcn_update_dpp(0, x, 0x140, 0xF, 0xF, true);
    return __builtin_bit_cast(float, r);
}
__device__ __forceinline__ float red4(float v) { v += dpp_f(v, 0); v += dpp_f(v, 1); return v; }
__device__ __forceinline__ float red8(float v) { v = red4(v); v += dpp_f(v, 2); return v; }
__device__ __forceinline__ float red16(float v) { v = red8(v); v += dpp_f(v, 3); return v; }
__device__ __forceinline__ float fma_s(float a, float b, float c) { float r; asm("v_fma_f32 %0, %1, %2, %3" : "=v"(r) : "v"(a), "v"(b), "v"(c)); return r; }
__device__ __forceinline__ float mul_s(float a, float b) { float r; asm("v_mul_f32 %0, %1, %2" : "=v"(r) : "v"(a), "v"(b)); return r; }
__device__ __forceinline__ void red16x2(float& a, float& b) {
    a += dpp_f(a, 0); b += dpp_f(b, 0); a += dpp_f(a, 1); b += dpp_f(b, 1); a += dpp_f(a, 2); b += dpp_f(b, 2); a += dpp_f(a, 3); b += dpp_f(b, 3);
}
__device__ __forceinline__ void red8x2(float& a, float& b) {
    a += dpp_f(a, 0); b += dpp_f(b, 0); a += dpp_f(a, 1); b += dpp_f(b, 1); a += dpp_f(a, 2); b += dpp_f(b, 2);
}
__device__ __forceinline__ float tanh_(float x) { return 1.0f - 2.0f / (1.0f + __expf(2.0f * x)); }
__device__ __forceinline__ bf16x8 pack8(const float* p) {
    v4u w; w.x = pg8::cvt_pk_bf16(p[0], p[1]); w.y = pg8::cvt_pk_bf16(p[2], p[3]); w.z = pg8::cvt_pk_bf16(p[4], p[5]); w.w = pg8::cvt_pk_bf16(p[6], p[7]);
    return __builtin_bit_cast(bf16x8, w);
}

typedef short v4i16_t __attribute__((ext_vector_type(4)));
__device__ __forceinline__ void attn_unit(int wu, const bf16* Qb, const bf16* Kb, const bf16* VT, bf16* OG, float* LSE, int lane, LAS unsigned char* vl) {
    const int g = wu >> 12; int rem = wu & 4095; const int b = rem >> 9; rem &= 511; const int head = rem >> 6, qt = rem & 63;
    const int lgd = 2 * g, dil = 1 << lgd, L = T >> lgd;
    const int p0 = qt * 32, r = p0 >> (11 - lgd), u0 = p0 & (L - 1);
    const int q = lane & 31, h = lane >> 5;
    const size_t rb = ((size_t)g * M + (size_t)b * T) * 512 + head * 64;
    const bf16* Qg = Qb + rb; const bf16* Kg = Kb + rb;
    const bf16* Vg = VT + rb;
    bf16x8 qf[4];
#pragma unroll
    for (int ks = 0; ks < 4; ++ks) qf[ks] = *(const bf16x8*)(Qg + (size_t)(p0 + q) * 512 + 16 * ks + 8 * h);
    const int kt0 = (u0 >= 128) ? 0 : 4 - (u0 >> 5);
    const int kbase = r * L + u0 - 128;
    f32x16 s[5];
#pragma unroll
    for (int kt = 0; kt < 5; ++kt) {
        if (kt >= kt0) {
            f32x16 acc = {};
            const bf16* kp = Kg + (size_t)(kbase + 32 * kt + q) * 512 + 8 * h;
#pragma unroll
            for (int ks = 0; ks < 4; ++ks) { const bf16x8 kf = *(const bf16x8*)(kp + 16 * ks); acc = __builtin_amdgcn_mfma_f32_32x32x16_bf16(kf, qf[ks], acc, 0, 0, 0); }
            if (kt == 0) {
#pragma unroll
                for (int rg = 0; rg < 16; ++rg) { const int krow = (rg & 3) + 8 * (rg >> 2) + 4 * h; if (krow < q) acc[rg] = -INFINITY; }
            }
            if (kt == 4) {
#pragma unroll
                for (int rg = 0; rg < 16; ++rg) { const int krow = (rg & 3) + 8 * (rg >> 2) + 4 * h; if (krow > q) acc[rg] = -INFINITY; }
            }
            s[kt] = acc;
        } else {
#pragma unroll
            for (int rg = 0; rg < 16; ++rg) s[kt][rg] = -INFINITY;
        }
    }
    float mx = -INFINITY;
#pragma unroll
    for (int kt = 0; kt < 5; ++kt)
#pragma unroll
        for (int rg = 0; rg < 16; ++rg) mx = fmaxf(mx, s[kt][rg]);
    mx = fmaxf(mx, __shfl_xor(mx, 32));
    float l = 0.f;
#pragma unroll
    for (int kt = 0; kt < 5; ++kt)
#pragma unroll
        for (int rg = 0; rg < 16; ++rg) { const float p = __builtin_amdgcn_exp2f(s[kt][rg] - mx); s[kt][rg] = p; l += p; }
    l += __shfl_xor(l, 32);
    f32x16 o0 = {}, o1 = {};
#pragma unroll
    for (int kt = 0; kt < 5; ++kt) {
        if (kt >= kt0) {
            {
                const bf16* vsrc = Vg + (size_t)(kbase + 32 * kt + (lane >> 3)) * 512 + (lane & 7) * 8;
#pragma unroll
                for (int i = 0; i < 4; ++i) { const v4u t = *(const v4u*)(vsrc + (size_t)(8 * i) * 512); *(LAS v4u*)(vl + ((lane >> 3) + 8 * i) * 192 + (lane & 7) * 16) = t; }
            }
#pragma unroll
            for (int si = 0; si < 2; ++si) {
                float pp[8];
#pragma unroll
                for (int j = 0; j < 8; ++j) pp[j] = s[kt][8 * si + j];
                const bf16x8 pb = pack8(pp);
                const int gi = lane >> 4, i16 = lane & 15;
                LAS unsigned char* tb = vl + (16 * si + 4 * (gi >> 1) + (i16 >> 2)) * 192 + (16 * (gi & 1) + 4 * (i16 & 3)) * 2;
                const v4i16_t a0 = __builtin_amdgcn_ds_read_tr16_b64_v4i16((LAS v4i16_t*)(tb));
                const v4i16_t a1 = __builtin_amdgcn_ds_read_tr16_b64_v4i16((LAS v4i16_t*)(tb + 8 * 192));
                const v4i16_t c0 = __builtin_amdgcn_ds_read_tr16_b64_v4i16((LAS v4i16_t*)(tb + 64));
                const v4i16_t c1 = __builtin_amdgcn_ds_read_tr16_b64_v4i16((LAS v4i16_t*)(tb + 8 * 192 + 64));
                const bf16x8 va = {a0[0], a0[1], a0[2], a0[3], a1[0], a1[1], a1[2], a1[3]}, vc = {c0[0], c0[1], c0[2], c0[3], c1[0], c1[1], c1[2], c1[3]};
                o0 = __builtin_amdgcn_mfma_f32_32x32x16_bf16(va, pb, o0, 0, 0, 0);
                o1 = __builtin_amdgcn_mfma_f32_32x32x16_bf16(vc, pb, o1, 0, 0, 0);
            }
        }
    }
    const float inv = 1.0f / l;
    const int t = r + dil * (u0 + q);
    bf16* op = OG + ((size_t)g * M + (size_t)b * T + t) * 512 + head * 64 + 4 * h;
#pragma unroll
    for (int rg = 0; rg < 4; ++rg) {
        u32x2 w; w.x = pg8::cvt_pk_bf16(o0[4 * rg] * inv, o0[4 * rg + 1] * inv); w.y = pg8::cvt_pk_bf16(o0[4 * rg + 2] * inv, o0[4 * rg + 3] * inv);
        *(u32x2*)(op + 8 * rg) = w;
        u32x2 w2; w2.x = pg8::cvt_pk_bf16(o1[4 * rg] * inv, o1[4 * rg + 1] * inv); w2.y = pg8::cvt_pk_bf16(o1[4 * rg + 2] * inv, o1[4 * rg + 3] * inv);
        *(u32x2*)(op + 32 + 8 * rg) = w2;
    }
    if (h == 0) LSE[((size_t)g * M + (size_t)b * T + t) * 8 + head] = (mx + __builtin_amdgcn_logf(l)) * LN2;
}

__device__ __forceinline__ void r1_rows(const Frame& F, const bf16* SC, const float* mu, bf16* A1, bf16* A2) {
    float mul[6];
#pragma unroll
    for (int i = 0; i < 6; ++i) { const int e = F.lane + 64 * i; mul[i] = (e < 288) ? mu[3072 + e] : 0.f; }
    for (int m = F.gw; m < M; m += F.NGW) {
        const int t = m & (T - 1);
        const bf16* p = SC + (size_t)m * SCP + 3072;
#pragma unroll
        for (int i = 0; i < 6; ++i) {
            const int e = F.lane + 64 * i;
            if (e < 288) {
                const float x = bf2f(p[e]); const float xp = (t > 0) ? bf2f(p[e - SCP]) : 0.f;
                const float xm = x + (xp - x) * mul[i];
                if (e < 64) A1[(size_t)m * 128 + e] = (bf16)f2bf(tanh_(xm));
                else if (e < 128) A1[(size_t)m * 128 + e] = (bf16)f2bf(xm);
                else A2[(size_t)m * 256 + (e - 128)] = (bf16)f2bf(sigmoidf_(xm));
            } else A2[(size_t)m * 256 + (e - 128)] = 0;
        }
    }
}

__device__ __forceinline__ void combine_groups(const Frame& F, const bf16* OG, const float* LSE, bf16* OA) {
    for (int it = F.vcu * 512 + F.tid; it < M * 64; it += F.G * 512) {
        const int m = it >> 6, cg = it & 63, head = cg >> 3;
        const float l0 = LSE[(size_t)m * 8 + head], l1 = LSE[((size_t)M + m) * 8 + head], l2 = LSE[((size_t)2 * M + m) * 8 + head];
        const float mx = fmaxf(l0, fmaxf(l1, l2));
        float e0 = __expf(l0 - mx), e1 = __expf(l1 - mx), e2 = __expf(l2 - mx); const float inv = 1.0f / (e0 + e1 + e2); e0 *= inv; e1 *= inv; e2 *= inv;
        const v4u a = *(const v4u*)(OG + (size_t)m * 512 + cg * 8), b = *(const v4u*)(OG + ((size_t)M + m) * 512 + cg * 8), c = *(const v4u*)(OG + ((size_t)2 * M + m) * 512 + cg * 8);
        v4u o;
        o.x = pg8::cvt_pk_bf16(e0 * bflo(a.x) + e1 * bflo(b.x) + e2 * bflo(c.x), e0 * bfhi(a.x) + e1 * bfhi(b.x) + e2 * bfhi(c.x));
        o.y = pg8::cvt_pk_bf16(e0 * bflo(a.y) + e1 * bflo(b.y) + e2 * bflo(c.y), e0 * bfhi(a.y) + e1 * bfhi(b.y) + e2 * bfhi(c.y));
        o.z = pg8::cvt_pk_bf16(e0 * bflo(a.z) + e1 * bflo(b.z) + e2 * bflo(c.z), e0 * bfhi(a.z) + e1 * bfhi(b.z) + e2 * bfhi(c.z));
        o.w = pg8::cvt_pk_bf16(e0 * bflo(a.w) + e1 * bflo(b.w) + e2 * bflo(c.w), e0 * bfhi(a.w) + e1 * bfhi(b.w) + e2 * bfhi(c.w));
        *(v4u*)(OA + (size_t)m * 512 + cg * 8) = o;
    }
}

struct EpiWA {
    static constexpr bool PERM = true, AFTER_DRAIN = false;
    bf16* E; bf16* AV; const float* w0; const float* a0;
    __device__ __forceinline__ void operator()(const pg8::f32x4 (&acc)[2][2][4][2], const pg8::Unit& u, int wr, int wc, int fr, int fq) const {
        const bool isw = u.pn < 4; const int cb = (u.pn & 3) * 256 + wc * 32 + 8 * fq; const float* bias = isw ? w0 : a0; bf16* O = isw ? E : AV; const float sc = isw ? 0.60653065971263342f : 1.0f;
#pragma unroll
        for (int bj = 0; bj < 2; ++bj) {
            const int col = cb + bj * 128; const f32x4 b0 = *(const f32x4*)(bias + col), b1 = *(const f32x4*)(bias + col + 4);
#pragma unroll
            for (int ai = 0; ai < 2; ++ai)
#pragma unroll
                for (int m = 0; m < 4; ++m) {
                    const int row = u.pm * 256 + wr * 64 + fr + ai * 128 + m * 16;
                    const pg8::f32x4 v0 = acc[ai][bj][m][0], v1 = acc[ai][bj][m][1];
                    pg8::u32x4 w; w.x = pg8::cvt_pk_bf16(sc * sigmoidf_(v0[0] + b0[0]), sc * sigmoidf_(v0[1] + b0[1])); w.y = pg8::cvt_pk_bf16(sc * sigmoidf_(v0[2] + b0[2]), sc * sigmoidf_(v0[3] + b0[3]));
                    w.z = pg8::cvt_pk_bf16(sc * sigmoidf_(v1[0] + b1[0]), sc * sigmoidf_(v1[1] + b1[1])); w.w = pg8::cvt_pk_bf16(sc * sigmoidf_(v1[2] + b1[2]), sc * sigmoidf_(v1[3] + b1[3]));
                    *(pg8::u32x4*)(O + (size_t)row * 1024 + col) = w;
                }
        }
    }
};
struct EpiPlain {
    static constexpr bool PERM = true, AFTER_DRAIN = false;
    bf16* O; int ldc;
    __device__ __forceinline__ void operator()(const pg8::f32x4 (&acc)[2][2][4][2], const pg8::Unit& u, int wr, int wc, int fr, int fq) const {
        const int cb = u.pn * 256 + wc * 32 + 8 * fq;
#pragma unroll
        for (int ai = 0; ai < 2; ++ai)
#pragma unroll
            for (int m = 0; m < 4; ++m) {
                const int row = u.pm * 256 + wr * 64 + fr + ai * 128 + m * 16;
#pragma unroll
                for (int bj = 0; bj < 2; ++bj) {
                    const pg8::f32x4 v0 = acc[ai][bj][m][0], v1 = acc[ai][bj][m][1];
                    pg8::u32x4 w; w.x = pg8::cvt_pk_bf16(v0[0], v0[1]); w.y = pg8::cvt_pk_bf16(v0[2], v0[3]); w.z = pg8::cvt_pk_bf16(v1[0], v1[1]); w.w = pg8::cvt_pk_bf16(v1[2], v1[3]);
                    *(pg8::u32x4*)(O + (size_t)row * ldc + cb + bj * 128) = w;
                }
            }
    }
};

struct ScanRegs { u32x2 pr, pk, pv, qr, qk, qv, e4, a4; };
__device__ __forceinline__ void scan_load(ScanRegs& R, const bf16* SC, const bf16* E, const bf16* AV, int b, int t, int cr) {
    const size_t m = (size_t)b * T + t; const bf16* p = SC + m * SCP + cr;
    R.pr = *(const u32x2*)(p); R.pk = *(const u32x2*)(p + 1024); R.pv = *(const u32x2*)(p + 2048);
    if (t > 0) { R.qr = *(const u32x2*)(p - SCP); R.qk = *(const u32x2*)(p - SCP + 1024); R.qv = *(const u32x2*)(p - SCP + 2048); }
    else { R.qr = (u32x2){0u, 0u}; R.qk = (u32x2){0u, 0u}; R.qv = (u32x2){0u, 0u}; }
    R.e4 = *(const u32x2*)(E + m * 1024 + cr); R.a4 = *(const u32x2*)(AV + m * 1024 + cr);
}
__device__ __forceinline__ f32x4 bf4(u32x2 w) { return (f32x4){bflo(w.x), bfhi(w.x), bflo(w.y), bfhi(w.y)}; }
__device__ __forceinline__ void scan_phase(const Frame& F, const Args& a, unsigned char* ws) {
    const bf16* SC = (const bf16*)(ws + WS_SC); const bf16* E = (const bf16*)(ws + WS_E); const bf16* AV = (const bf16*)(ws + WS_AV);
    float* Y = (float*)(ws + WS_Y); float* CB = (float*)(ws + WS_CB);
    LAS float* L = (LAS float*)(F.lds + RING_OFF); LAS float* YB = (LAS float*)(F.lds + RING_OFF + 49152);
    const int tid = F.tid, lane = F.lane, wave = F.wave;
    for (int item = F.vcu; item < NB * BHEADS * 2; item += F.G) {
        const int chain = item >> 1, half = item & 1, b = chain >> 4, head = chain & 15;
        const int ss = tid >> 4, j4 = (tid & 15) * 4, cr = head * 64 + j4;
        const f32x4 mur = *(const f32x4*)(a.in[I_MU] + cr), muk = *(const f32x4*)(a.in[I_MU] + 1024 + cr), muv = *(const f32x4*)(a.in[I_MU] + 2048 + cr);
        const f32x4 kkw = *(const f32x4*)(a.in[I_KK] + cr), kaw = *(const f32x4*)(a.in[I_KA] + cr), rkw = *(const f32x4*)(a.in[I_RK] + cr);
        const int rloc8 = 8 * (wave & 3) + (lane >> 3), c8 = (lane & 7) * 8;
        f32x4 Sa = {0.f, 0.f, 0.f, 0.f}, Sb = {0.f, 0.f, 0.f, 0.f};
        ScanRegs cur, nxt; scan_load(cur, SC, E, AV, b, ss, cr);
        for (int ch = 0; ch < T / 32; ++ch) {
            const int t0 = ch * 32;
            if (ch + 1 < T / 32) scan_load(nxt, SC, E, AV, b, t0 + 32 + ss, cr); else nxt = cur;
            {
                const f32x4 pr = bf4(cur.pr), pk = bf4(cur.pk), pv = bf4(cur.pv), qr = bf4(cur.qr), qk = bf4(cur.qk), qv = bf4(cur.qv);
                const f32x4 r = pr + (qr - pr) * mur, k = pk + (qk - pk) * muk, v = pv + (qv - pv) * muv;
                const f32x4 ev = bf4(cur.e4), av = bf4(cur.a4);
                f32x4 w; w[0] = __expf(-ev[0]); w[1] = __expf(-ev[1]); w[2] = __expf(-ev[2]); w[3] = __expf(-ev[3]);
                const f32x4 kr = k * kkw;
                const float n2 = red16((kr[0] * kr[0] + kr[1] * kr[1]) + (kr[2] * kr[2] + kr[3] * kr[3]));
                const float rn = 1.0f / fmaxf(sqrtf(n2), 1e-12f);
                const f32x4 kk = kr * rn;
                const f32x4 kp = k * (1.0f + (av - 1.0f) * kaw);
                const f32x4 bb = kk * av;
                const f32x4 rkk = r * kp * rkw;
                const float cb = red16((rkk[0] + rkk[1]) + (rkk[2] + rkk[3]));
                LAS float* d = L + ss * 384 + j4;
                *(LAS f32x4*)(d) = w; *(LAS f32x4*)(d + 64) = kk; *(LAS f32x4*)(d + 128) = bb; *(LAS f32x4*)(d + 192) = kp; *(LAS f32x4*)(d + 256) = r; *(LAS f32x4*)(d + 320) = v;
                if (half == 0 && (tid & 15) == 0) CB[((size_t)b * T + t0 + ss) * 16 + head] = cb;
            }
            __syncthreads();
            if (wave < 4) {
                const int k8 = lane & 7;
                const LAS float* d0 = L + k8 * 8; const LAS float* dv = L + 320 + 32 * half + rloc8;
                f32x4 w0 = *(const LAS f32x4*)(d0), w1 = *(const LAS f32x4*)(d0 + 4), kka = *(const LAS f32x4*)(d0 + 64), kkb = *(const LAS f32x4*)(d0 + 68), bba = *(const LAS f32x4*)(d0 + 128), bbb = *(const LAS f32x4*)(d0 + 132),
                      kpa = *(const LAS f32x4*)(d0 + 192), kpb = *(const LAS f32x4*)(d0 + 196), ra = *(const LAS f32x4*)(d0 + 256), rb = *(const LAS f32x4*)(d0 + 260);
                float vi = dv[0];
                float py = 0.f, yk0 = 0.f, yk1 = 0.f, yk2 = 0.f, yk3 = 0.f;
#pragma unroll
                for (int si = 0; si < 32; ++si) {
                    const int sn = (si + 1 < 32) ? (si + 1) : 31;
                    const LAS float* d = d0 + sn * 384;
                    const f32x4 w0n = *(const LAS f32x4*)(d), w1n = *(const LAS f32x4*)(d + 4), kkan = *(const LAS f32x4*)(d + 64), kkbn = *(const LAS f32x4*)(d + 68), bban = *(const LAS f32x4*)(d + 128), bbbn = *(const LAS f32x4*)(d + 132),
                                kpan = *(const LAS f32x4*)(d + 192), kpbn = *(const LAS f32x4*)(d + 196), ran = *(const LAS f32x4*)(d + 256), rbn = *(const LAS f32x4*)(d + 260);
                    const float vin = dv[sn * 384];
                    const f32x4 pa = Sa * kka + Sb * kkb;
                    float ps = (pa[0] + pa[1]) + (pa[2] + pa[3]);
                    red8x2(ps, py);
                    if (si > 0) { const int q = si - 1; if (q < 8) yk0 = (k8 == q) ? py : yk0; else if (q < 16) yk1 = (k8 == q - 8) ? py : yk1; else if (q < 24) yk2 = (k8 == q - 16) ? py : yk2; else yk3 = (k8 == q - 24) ? py : yk3; }
                    const float sa = -ps;
                    Sa = Sa * w0 + (sa * bba + vi * kpa); Sb = Sb * w1 + (sa * bbb + vi * kpb);
                    const f32x4 pb = Sa * ra + Sb * rb;
                    py = (pb[0] + pb[1]) + (pb[2] + pb[3]);
                    w0 = w0n; w1 = w1n; kka = kkan; kkb = kkbn; bba = bban; bbb = bbbn; kpa = kpan; kpb = kpbn; ra = ran; rb = rbn; vi = vin;
                }
                py = red8(py); yk3 = (k8 == 7) ? py : yk3;
                YB[k8 * 32 + rloc8] = yk0; YB[(8 + k8) * 32 + rloc8] = yk1; YB[(16 + k8) * 32 + rloc8] = yk2; YB[(24 + k8) * 32 + rloc8] = yk3;
            }
            __syncthreads();
            {
                const int c2 = (tid & 15) * 2;
                const f32x2 yv = *(const LAS f32x2*)(YB + ss * 32 + c2);
                *(f32x2*)(Y + ((size_t)b * T + t0 + ss) * 1024 + head * 64 + 32 * half + c2) = yv;
            }
            cur = nxt;
        }
        if (wave < 4) { float* so = a.out + O_WKVP + (((size_t)b * 16 + head) * 64 + 32 * half + rloc8) * 64 + c8; *(f32x4*)(so) = Sa; *(f32x4*)(so + 4) = Sb; }
        __syncthreads();
    }
}

__device__ __forceinline__ void r3_rows(const Frame& F, const Args& a, unsigned char* ws) {
    const bf16* SC = (const bf16*)(ws + WS_SC); const bf16* GATE = (const bf16*)(ws + WS_GATE); const float* Y = (const float*)(ws + WS_Y); const float* CB = (const float*)(ws + WS_CB);
    bf16* OB = (bf16*)(ws + WS_OB);
    const int lane = F.lane, c0 = 16 * lane, head = lane >> 2;
    f32x4 gw[4], gb[4], mv[4];
#pragma unroll
    for (int j = 0; j < 4; ++j) { gw[j] = *(const f32x4*)(a.in[I_GNW] + c0 + 4 * j); gb[j] = *(const f32x4*)(a.in[I_GNB] + c0 + 4 * j); mv[j] = *(const f32x4*)(a.in[I_MU] + 2048 + c0 + 4 * j); }
    for (int m = F.gw; m < M; m += F.NGW) {
        const int t = m & (T - 1);
        f32x4 y[4]; float s = 0.f;
#pragma unroll
        for (int j = 0; j < 4; ++j) { y[j] = *(const f32x4*)(Y + (size_t)m * 1024 + c0 + 4 * j); s += (y[j][0] + y[j][1]) + (y[j][2] + y[j][3]); }
        const float mean = red4(s) * (1.0f / 64.0f); float q = 0.f;
#pragma unroll
        for (int j = 0; j < 4; ++j) { y[j] = y[j] - mean; q += (y[j][0] * y[j][0] + y[j][1] * y[j][1]) + (y[j][2] * y[j][2] + y[j][3] * y[j][3]); }
        const float rs = 1.0f / sqrtf(red4(q) * (1.0f / 64.0f) + GN_EPS);
        const float cb = CB[(size_t)m * 16 + head];
        const bf16* p = SC + (size_t)m * SCP + 2048 + c0;
        const v4u p0 = *(const v4u*)(p), p1 = *(const v4u*)(p + 8);
        v4u q0 = {0u, 0u, 0u, 0u}, q1 = {0u, 0u, 0u, 0u};
        if (t > 0) { q0 = *(const v4u*)(p - SCP); q1 = *(const v4u*)(p - SCP + 8); }
        const v4u g0 = *(const v4u*)(GATE + (size_t)m * 1024 + c0), g1 = *(const v4u*)(GATE + (size_t)m * 1024 + c0 + 8);
        const unsigned pw[8] = {p0.x, p0.y, p0.z, p0.w, p1.x, p1.y, p1.z, p1.w}, qw[8] = {q0.x, q0.y, q0.z, q0.w, q1.x, q1.y, q1.z, q1.w}, gw8[8] = {g0.x, g0.y, g0.z, g0.w, g1.x, g1.y, g1.z, g1.w};
        unsigned ow[8];
#pragma unroll
        for (int e = 0; e < 8; ++e) {
            const int j = e >> 1, i0 = (e & 1) * 2;
            const float pa = bflo(pw[e]), pb = bfhi(pw[e]), qa = bflo(qw[e]), qb = bfhi(qw[e]);
            const float va = pa + (qa - pa) * mv[j][i0], vb = pb + (qb - pb) * mv[j][i0 + 1];
            const float oa = (y[j][i0] * rs * gw[j][i0] + gb[j][i0] + cb * va) * bflo(gw8[e]);
            const float ob = (y[j][i0 + 1] * rs * gw[j][i0 + 1] + gb[j][i0 + 1] + cb * vb) * bfhi(gw8[e]);
            ow[e] = pg8::cvt_pk_bf16(oa, ob);
        }
        *(v4u*)(OB + (size_t)m * 1024 + c0) = (v4u){ow[0], ow[1], ow[2], ow[3]};
        *(v4u*)(OB + (size_t)m * 1024 + c0 + 8) = (v4u){ow[4], ow[5], ow[6], ow[7]};
    }
}

struct EpiPA {
    static constexpr bool PERM = true, AFTER_DRAIN = false;
    const bf16* GT; float* Y1;
    __device__ __forceinline__ void operator()(const pg8::f32x4 (&acc)[2][2][4][2], const pg8::Unit& u, int wr, int wc, int fr, int fq) const {
        const int cb = u.pn * 256 + wc * 32 + 8 * fq;
#pragma unroll
        for (int ai = 0; ai < 2; ++ai)
#pragma unroll
            for (int m = 0; m < 4; ++m) {
                const int row = u.pm * 256 + wr * 64 + fr + ai * 128 + m * 16;
#pragma unroll
                for (int bj = 0; bj < 2; ++bj) {
                    const int col = cb + bj * 128; const v4u gq = *(const v4u*)(GT + (size_t)row * 2048 + col);
                    const pg8::f32x4 v0 = acc[ai][bj][m][0], v1 = acc[ai][bj][m][1];
                    *(f32x4*)(Y1 + (size_t)row * 1024 + col) = (f32x4){v0[0] * bflo(gq.x), v0[1] * bfhi(gq.x), v0[2] * bflo(gq.y), v0[3] * bfhi(gq.y)};
                    *(f32x4*)(Y1 + (size_t)row * 1024 + col + 4) = (f32x4){v1[0] * bflo(gq.z), v1[1] * bfhi(gq.z), v1[2] * bflo(gq.w), v1[3] * bfhi(gq.w)};
                }
            }
    }
};
struct EpiPB {
    static constexpr bool PERM = true, AFTER_DRAIN = false;
    const bf16* GT; const float* Y1; bf16* MG;
    __device__ __forceinline__ void operator()(const pg8::f32x4 (&acc)[2][2][4][2], const pg8::Unit& u, int wr, int wc, int fr, int fq) const {
        const int cb = u.pn * 256 + wc * 32 + 8 * fq;
#pragma unroll
        for (int ai = 0; ai < 2; ++ai)
#pragma unroll
            for (int m = 0; m < 4; ++m) {
                const int row = u.pm * 256 + wr * 64 + fr + ai * 128 + m * 16;
#pragma unroll
                for (int bj = 0; bj < 2; ++bj) {
                    const int col = cb + bj * 128; const v4u gq = *(const v4u*)(GT + (size_t)row * 2048 + 1024 + col);
                    const f32x4 y0 = *(const f32x4*)(Y1 + (size_t)row * 1024 + col), y1 = *(const f32x4*)(Y1 + (size_t)row * 1024 + col + 4);
                    const pg8::f32x4 v0 = acc[ai][bj][m][0], v1 = acc[ai][bj][m][1];
                    pg8::u32x4 w; w.x = pg8::cvt_pk_bf16(y0[0] + v0[0] * bflo(gq.x), y0[1] + v0[1] * bfhi(gq.x)); w.y = pg8::cvt_pk_bf16(y0[2] + v0[2] * bflo(gq.y), y0[3] + v0[3] * bfhi(gq.y));
                    w.z = pg8::cvt_pk_bf16(y1[0] + v1[0] * bflo(gq.z), y1[1] + v1[1] * bfhi(gq.z)); w.w = pg8::cvt_pk_bf16(y1[2] + v1[2] * bflo(gq.w), y1[3] + v1[3] * bfhi(gq.w));
                    *(pg8::u32x4*)(MG + (size_t)row * 1024 + col) = w;
                }
            }
    }
};
struct EpiRes {
    static constexpr bool PERM = true, AFTER_DRAIN = false;
    const float* base; float* Xo; bf16* Xb; float* ssq;
    __device__ __forceinline__ void operator()(const pg8::f32x4 (&acc)[2][2][4][2], const pg8::Unit& u, int wr, int wc, int fr, int fq) const {
        const int cb = u.pn * 256 + wc * 32 + 8 * fq;
#pragma unroll
        for (int ai = 0; ai < 2; ++ai)
#pragma unroll
            for (int m = 0; m < 4; ++m) {
                const int row = u.pm * 256 + wr * 64 + fr + ai * 128 + m * 16; float sq = 0.f;
#pragma unroll
                for (int bj = 0; bj < 2; ++bj) {
                    const int col = cb + bj * 128;
                    const f32x4 x0 = *(const f32x4*)(base + (size_t)row * 1024 + col), x1 = *(const f32x4*)(base + (size_t)row * 1024 + col + 4);
                    const pg8::f32x4 a0 = acc[ai][bj][m][0], a1 = acc[ai][bj][m][1];
                    const f32x4 o0 = {x0[0] + a0[0], x0[1] + a0[1], x0[2] + a0[2], x0[3] + a0[3]}, o1 = {x1[0] + a1[0], x1[1] + a1[1], x1[2] + a1[2], x1[3] + a1[3]};
                    *(f32x4*)(Xo + (size_t)row * 1024 + col) = o0; *(f32x4*)(Xo + (size_t)row * 1024 + col + 4) = o1;
                    sq += (o0[0] * o0[0] + o0[1] * o0[1]) + (o0[2] * o0[2] + o0[3] * o0[3]) + (o1[0] * o1[0] + o1[1] * o1[1]) + (o1[2] * o1[2] + o1[3] * o1[3]);
                    if (Xb) { pg8::u32x4 w; w.x = pg8::cvt_pk_bf16(o0[0], o0[1]); w.y = pg8::cvt_pk_bf16(o0[2], o0[3]); w.z = pg8::cvt_pk_bf16(o1[0], o1[1]); w.w = pg8::cvt_pk_bf16(o1[2], o1[3]);
                        *(pg8::u32x4*)(Xb + (size_t)row * 1024 + col) = w; }
                }
                sq += __shfl_xor(sq, 16); sq += __shfl_xor(sq, 32);
                if (fq == 0) atomicAdd(ssq + row, sq);
            }
    }
};
struct EpiGU {
    static constexpr bool PERM = true, AFTER_DRAIN = false;
    const float* ssq; bf16* ACT;
    __device__ __forceinline__ void operator()(const pg8::f32x4 (&acc)[2][2][4][2], const pg8::Unit& u, int wr, int wc, int fr, int fq) const {
        const int col = u.pn * 128 + wc * 32 + 8 * fq;
#pragma unroll
        for (int ai = 0; ai < 2; ++ai)
#pragma unroll
            for (int m = 0; m < 4; ++m) {
                const int row = u.pm * 256 + wr * 64 + fr + ai * 128 + m * 16;
                const float rstd = 1.0f / sqrtf(ssq[row] * (1.0f / DM) + NORM_EPS);
                float o[8];
#pragma unroll
                for (int n = 0; n < 2; ++n)
#pragma unroll
                    for (int j = 0; j < 4; ++j) { const float gv = acc[ai][0][m][n][j] * rstd, uv = acc[ai][1][m][n][j] * rstd; o[4 * n + j] = gv * sigmoidf_(gv) * uv; }
                pg8::u32x4 w; w.x = pg8::cvt_pk_bf16(o[0], o[1]); w.y = pg8::cvt_pk_bf16(o[2], o[3]); w.z = pg8::cvt_pk_bf16(o[4], o[5]); w.w = pg8::cvt_pk_bf16(o[6], o[7]);
                *(pg8::u32x4*)(ACT + (size_t)row * DFF + col) = w;
            }
    }
};

__device__ __forceinline__ f32x16 sgemm32_tile(const bf16* A, int lda, const bf16* Bt, int K, int n0, int lane) {
    const int r = lane & 31, h = lane >> 5;
    const bf16* ap = A + (size_t)r * lda + 8 * h; const bf16* bp = Bt + (size_t)(n0 + r) * K + 8 * h;
    f32x16 acc = {};
#pragma unroll 8
    for (int k = 0; k < K; k += 16) { const bf16x8 av = *(const bf16x8*)(ap + k), bv = *(const bf16x8*)(bp + k); acc = __builtin_amdgcn_mfma_f32_32x32x16_bf16(av, bv, acc, 0, 0, 0); }
    return acc;
}
#define SROW(rg, h) (((rg) & 3) + 8 * ((rg) >> 2) + 4 * (h))

__device__ __forceinline__ void s_inproj(const Frame& F, unsigned char* ws) {
    float* PROJ = (float*)(ws + WS_SMP + SM_PROJ);
    for (int tl = F.gw; tl < INP / 32; tl += F.NGW) {
        const f32x16 acc = sgemm32_tile((const bf16*)(ws + WS_SMP + SM_HSN), DM, (const bf16*)(ws + WS_WIN), DM, 32 * tl, F.lane);
#pragma unroll
        for (int rg = 0; rg < 16; ++rg) PROJ[(size_t)SROW(rg, F.lane >> 5) * INP + 32 * tl + (F.lane & 31)] = acc[rg];
    }
}

__device__ __forceinline__ float block_max(float v, LAS float* red, int tid) {
#pragma unroll
    for (int o = 1; o < 64; o <<= 1) v = fmaxf(v, __shfl_xor(v, o));
    __syncthreads(); if ((tid & 63) == 0) red[tid >> 6] = v; __syncthreads();
    float r = red[0];
#pragma unroll
    for (int i = 1; i < 8; ++i) r = fmaxf(r, red[i]);
    return r;
}
__device__ __forceinline__ float block_sum(float v, LAS float* red, int tid) {
    v = wave_sum(v);
    __syncthreads(); if ((tid & 63) == 0) red[tid >> 6] = v; __syncthreads();
    float r = 0.f;
#pragma unroll
    for (int i = 0; i < 8; ++i) r += red[i];
    return r;
}

__device__ __forceinline__ void s_attn_item(const Frame& F, const Args& a, unsigned char* ws, int b, int head) {
    const float* PROJ = (const float*)(ws + WS_SMP + SM_PROJ) + (size_t)b * INP; const float* tab = (const float*)(ws + WS_TAB) + (size_t)2048 * 64;
    LAS float* sm = (LAS float*)(F.lds + RING_OFF);
    LAS float* qn = sm;
    LAS float* kn = sm + 64;
    LAS float* vn = sm + 128;
    LAS float* pj = sm + 192;
    LAS float* red = sm + 336;
    LAS float* part = sm + 352;
    LAS float* og = sm + 864;
    LAS float* lse = sm + 1056;
    const int tid = F.tid;
    for (int g = 0; g < 3; ++g) {
        const int dil = 1 << (2 * g), buf = (g == 0) ? 128 : (g == 1) ? 512 : 2048;
        const float* cache = a.in[I_C1 + g]; const size_t okv = (g == 0) ? O_KV1S : (g == 1) ? O_KV2S : O_KV3S;
        __syncthreads();
        if (tid < 64) {
            const int i = tid & 31, isk = tid >> 5; const float* src = PROJ + (3 * g + isk) * 512 + head * 64;
            const float x1 = src[2 * i], x2 = src[2 * i + 1], c = tab[2 * i], s = tab[2 * i + 1];
            const float o1 = x1 * c - x2 * s, o2 = x1 * s + x2 * c;
            if (isk == 0) { qn[i] = o1 * 0.125f; qn[32 + i] = o2 * 0.125f; }
            else { kn[i] = o1; kn[32 + i] = o2; float* ob = a.out + okv + ((size_t)b * 2 + 0) * 512 + head * 64; ob[i] = o1; ob[32 + i] = o2; }
        } else if (tid < 128) {
            const int d = tid - 64; const float v = PROJ[(3 * g + 2) * 512 + head * 64 + d]; vn[d] = v; a.out[okv + ((size_t)b * 2 + 1) * 512 + head * 64 + d] = v;
        }
        __syncthreads();
        const int j = tid >> 2, pt = tid & 3;
        const size_t crow = ((size_t)b * buf + (buf - dil * (j + 1))) * 2;
        const float* kc = cache + ((crow + 0) * 8 + head) * 64 + 16 * pt;
        float sc = 0.f;
#pragma unroll
        for (int d4 = 0; d4 < 4; ++d4) { const f32x4 kv = *(const f32x4*)(kc + 4 * d4); sc += kv[0] * qn[16 * pt + 4 * d4] + kv[1] * qn[16 * pt + 4 * d4 + 1] + kv[2] * qn[16 * pt + 4 * d4 + 2] + kv[3] * qn[16 * pt + 4 * d4 + 3]; }
        sc = red4(sc);
        float snew = 0.f;
        if (tid < 64) snew = qn[tid] * kn[tid];
        snew = block_sum(snew, red, tid);
        const float mx = fmaxf(block_max(sc, red, tid), snew);
        const float pe = __expf(sc - mx), pn = __expf(snew - mx);
        if (pt == 0) pj[j] = pe;
        if (tid == 0) pj[128] = pn;
        const float den = block_sum(pt == 0 ? pe : 0.f, red, tid) + pn;
        const int d = tid & 63, kg = tid >> 6; float acc = 0.f;
#pragma unroll 4
        for (int jj = 0; jj < 16; ++jj) { const int j2 = kg * 16 + jj; const size_t cr2 = ((size_t)b * buf + (buf - dil * (j2 + 1))) * 2; acc += pj[j2] * cache[((cr2 + 1) * 8 + head) * 64 + d]; }
        if (kg == 0) acc += pj[128] * vn[d];
        part[kg * 64 + d] = acc;
        __syncthreads();
        if (tid < 64) { float o = 0.f;
#pragma unroll
            for (int k2 = 0; k2 < 8; ++k2) o += part[k2 * 64 + tid];
            og[g * 64 + tid] = o / den; }
        if (tid == 0) lse[g] = mx + __logf(den);
    }
    __syncthreads();
    if (tid < 64) {
        const float l0 = lse[0], l1 = lse[1], l2 = lse[2], mx = fmaxf(l0, fmaxf(l1, l2));
        const float e0 = __expf(l0 - mx), e1 = __expf(l1 - mx), e2 = __expf(l2 - mx), inv = 1.0f / (e0 + e1 + e2);
        const float o = (e0 * og[tid] + e1 * og[64 + tid] + e2 * og[128 + tid]) * inv;
        ((bf16*)(ws + WS_SMP + SM_OA))[(size_t)b * 512 + head * 64 + tid] = (bf16)f2bf(o);
    }
    __syncthreads();
}

__device__ __forceinline__ void s_rwkv_item(const Frame& F, const Args& a, unsigned char* ws, int b, int head) {
    const float* P = (const float*)(ws + WS_SMP + SM_PROJ) + (size_t)b * INP + ACOLS;
    const float* prev = a.in[I_SSH] + (size_t)b * SCOLS; const float* mu = a.in[I_MU];
    LAS float* sm = (LAS float*)(F.lds + RING_OFF);
    LAS float* xl = sm;
    LAS float* rr = sm + 288;
    LAS float* kr = sm + 352;
    LAS float* vv = sm + 416;
    LAS float* part = sm + 480;
    LAS float* wv = sm + 2016;
    LAS float* av = sm + 2080;
    LAS float* gv = sm + 2144;
    LAS float* kkv = sm + 2208;
    LAS float* kpv = sm + 2272;
    LAS float* bbv = sm + 2336;
    LAS float* yv = sm + 2400;
    LAS float* red = sm + 2464;
    const int tid = F.tid, hc0 = head * 64;
    __syncthreads();
    if (tid < 288) { const int c = 3072 + tid; const float x = P[c], xm = x + (prev[c] - x) * mu[c];
        xl[tid] = (tid < 64) ? tanh_(xm) : (tid < 128) ? xm : sigmoidf_(xm); }
    else if (tid < 288 + 192) { const int e = tid - 288, which = e >> 6, d = e & 63, c = which * 1024 + hc0 + d; const float x = P[c], xm = x + (prev[c] - x) * mu[c];
        if (which == 0) rr[d] = xm; else if (which == 1) kr[d] = xm; else vv[d] = xm; }
    __syncthreads();
    {
        const int c = tid & 63, sl = tid >> 6; const float* W2 = a.in[I_W2] + hc0 + c; const float* A2 = a.in[I_A2] + hc0 + c; const float* G2 = a.in[I_G2] + hc0 + c;
        float sw = 0.f, sa = 0.f, sg = 0.f;
#pragma unroll
        for (int e = 0; e < 8; ++e) { const int k = sl * 8 + e; sw += xl[k] * W2[(size_t)k * BWID]; sa += xl[64 + k] * A2[(size_t)k * BWID]; }
#pragma unroll 4
        for (int e = 0; e < 20; ++e) { const int k = sl * 20 + e; sg += xl[128 + k] * G2[(size_t)k * BWID]; }
        part[sl * 64 + c] = sw; part[512 + sl * 64 + c] = sa; part[1024 + sl * 64 + c] = sg;
    }
    __syncthreads();
    float n2p = 0.f;
    if (tid < 64) {
        float sw = 0.f, sa = 0.f, sg = 0.f;
#pragma unroll
        for (int s2 = 0; s2 < 8; ++s2) { sw += part[s2 * 64 + tid]; sa += part[512 + s2 * 64 + tid]; sg += part[1024 + s2 * 64 + tid]; }
        const float e = 0.60653065971263342f * sigmoidf_(a.in[I_W0][hc0 + tid] + sw);
        wv[tid] = __expf(-e); const float aa = sigmoidf_(a.in[I_A0][hc0 + tid] + sa); av[tid] = aa; gv[tid] = sg;
        const float kraw = kr[tid] * a.in[I_KK][hc0 + tid]; n2p = kraw * kraw; kkv[tid] = kraw;
        kpv[tid] = kr[tid] * (1.0f + (aa - 1.0f) * a.in[I_KA][hc0 + tid]);
    }
    const float n2 = block_sum(n2p, red, tid);
    const float rn = 1.0f / fmaxf(sqrtf(n2), 1e-12f);
    float cbp = 0.f;
    if (tid < 64) { const float kk = kkv[tid] * rn; kkv[tid] = kk; bbv[tid] = kk * av[tid]; cbp = rr[tid] * kpv[tid] * a.in[I_RK][hc0 + tid]; }
    const float cb = block_sum(cbp, red, tid);
    {
        const int i = tid >> 3, j0 = (tid & 7) * 8;
        const float* Sp = a.in[I_SWKV] + (((size_t)b * 16 + head) * 64 + i) * 64 + j0;
        float* So = a.out + O_WKVS + (((size_t)b * 16 + head) * 64 + i) * 64 + j0;
        const f32x4 s0 = *(const f32x4*)(Sp), s1 = *(const f32x4*)(Sp + 4);
        float S[8] = {s0[0], s0[1], s0[2], s0[3], s1[0], s1[1], s1[2], s1[3]};
        float dot = 0.f;
#pragma unroll
        for (int j = 0; j < 8; ++j) dot += S[j] * kkv[j0 + j];
        const float sa = -red8(dot), vi = vv[i];
        float yd = 0.f;
#pragma unroll
        for (int j = 0; j < 8; ++j) { S[j] = S[j] * wv[j0 + j] + sa * bbv[j0 + j] + vi * kpv[j0 + j]; yd += S[j] * rr[j0 + j]; }
        *(f32x4*)(So) = (f32x4){S[0], S[1], S[2], S[3]}; *(f32x4*)(So + 4) = (f32x4){S[4], S[5], S[6], S[7]};
        yd = red8(yd);
        if ((tid & 7) == 0) yv[i] = yd;
    }
    __syncthreads();
    const float yi = (tid < 64) ? yv[tid] : 0.f;
    const float mean = block_sum(yi, red, tid) * (1.0f / 64.0f);
    const float dv = (tid < 64) ? (yi - mean) : 0.f;
    const float var = block_sum(dv * dv, red, tid) * (1.0f / 64.0f);
    if (tid < 64) {
        const float yn = dv * (1.0f / sqrtf(var + GN_EPS)) * a.in[I_GNW][hc0 + tid] + a.in[I_GNB][hc0 + tid];
        const float o = (yn + cb * vv[tid]) * gv[tid];
        ((bf16*)(ws + WS_SMP + SM_OB))[(size_t)b * 1024 + hc0 + tid] = (bf16)f2bf(o);
    }
    __syncthreads();
}

__device__ __forceinline__ void s_proj(const Frame& F, unsigned char* ws) {
    for (int tl = F.gw; tl < 64; tl += F.NGW) {
        const int which = tl >> 5, n0 = 32 * (tl & 31);
        const f32x16 acc = which == 0 ? sgemm32_tile((const bf16*)(ws + WS_SMP + SM_OA), AWID, (const bf16*)(ws + WS_WA), AWID, n0, F.lane)
                                      : sgemm32_tile((const bf16*)(ws + WS_SMP + SM_OB), BWID, (const bf16*)(ws + WS_WB), BWID, n0, F.lane);
        float* O = (float*)(ws + WS_SMP + (which == 0 ? SM_YA : SM_YB));
#pragma unroll
        for (int rg = 0; rg < 16; ++rg) O[(size_t)SROW(rg, F.lane >> 5) * 1024 + n0 + (F.lane & 31)] = acc[rg];
    }
}
__device__ __forceinline__ void s_out(const Frame& F, const Args& a, unsigned char* ws) {
    const float* PROJ = (const float*)(ws + WS_SMP + SM_PROJ); const float* YA = (const float*)(ws + WS_SMP + SM_YA); const float* YBv = (const float*)(ws + WS_SMP + SM_YB);
    const bf16* Bt = (const bf16*)(ws + WS_WO);
    for (int tl = F.gw; tl < 32; tl += F.NGW) {
        const int n0 = 32 * tl, r = F.lane & 31, h = F.lane >> 5;
        f32x16 acc = {};
        for (int k = 0; k < DM; k += 16) {
            float mg[8];
#pragma unroll
            for (int j = 0; j < 8; ++j) { const int c = k + 8 * h + j;
                mg[j] = sigmoidf_(PROJ[(size_t)r * INP + ACOLS + SCP + c]) * YA[(size_t)r * 1024 + c] + sigmoidf_(PROJ[(size_t)r * INP + ACOLS + SCP + 1024 + c]) * YBv[(size_t)r * 1024 + c]; }
            const bf16x8 av = pack8(mg), bv = *(const bf16x8*)(Bt + (size_t)(n0 + r) * DM + k + 8 * h);
            acc = __builtin_amdgcn_mfma_f32_32x32x16_bf16(av, bv, acc, 0, 0, 0);
        }
        float* X1 = (float*)(ws + WS_SMP + SM_X1); bf16* X1B = (bf16*)(ws + WS_SMP + SM_X1B); float* SS = (float*)(ws + WS_SS) + M;
#pragma unroll
        for (int rg = 0; rg < 16; ++rg) { const int row = SROW(rg, h), col = n0 + r; const float v = a.in[I_XS][(size_t)row * DM + col] + acc[rg];
            X1[(size_t)row * 1024 + col] = v; X1B[(size_t)row * 1024 + col] = (bf16)f2bf(v);
            float sq = v * v;
#pragma unroll
            for (int o = 1; o < 32; o <<= 1) sq += __shfl_xor(sq, o);
            if (r == 0) atomicAdd(SS + row, sq); }
    }
}
__device__ __forceinline__ void s_gu(const Frame& F, unsigned char* ws) {
    const float* SS = (const float*)(ws + WS_SS) + M; bf16* ACTS = (bf16*)(ws + WS_SMP + SM_ACT);
    for (int tl = F.gw; tl < 88; tl += F.NGW) {
        const int jt = tl >> 2, i = tl & 3, n0 = 256 * jt + 32 * i, h = F.lane >> 5;
        const f32x16 ag = sgemm32_tile((const bf16*)(ws + WS_SMP + SM_X1B), DM, (const bf16*)(ws + WS_WGU), DM, n0, F.lane);
        const f32x16 au = sgemm32_tile((const bf16*)(ws + WS_SMP + SM_X1B), DM, (const bf16*)(ws + WS_WGU), DM, n0 + 128, F.lane);
#pragma unroll
        for (int rg = 0; rg < 16; ++rg) { const int row = SROW(rg, h); const float rstd = 1.0f / sqrtf(SS[row] * (1.0f / DM) + NORM_EPS);
            const float gv = ag[rg] * rstd, uv = au[rg] * rstd;
            ACTS[(size_t)row * DFF + 128 * jt + 32 * i + (F.lane & 31)] = (bf16)f2bf(gv * sigmoidf_(gv) * uv); }
    }
}
__device__ __forceinline__ void s_down(const Frame& F, unsigned char* ws) {
    const float* X1 = (const float*)(ws + WS_SMP + SM_X1); float* X2 = (float*)(ws + WS_SMP + SM_X2); float* SS2 = (float*)(ws + WS_SS2) + M;
    for (int tl = F.gw; tl < 32; tl += F.NGW) {
        const int n0 = 32 * tl, r = F.lane & 31, h = F.lane >> 5;
        const f32x16 acc = sgemm32_tile((const bf16*)(ws + WS_SMP + SM_ACT), DFF, (const bf16*)(ws + WS_WD), DFF, n0, F.lane);
#pragma unroll
        for (int rg = 0; rg < 16; ++rg) { const int row = SROW(rg, h), col = n0 + r; const float v = X1[(size_t)row * 1024 + col] + acc[rg];
            X2[(size_t)row * 1024 + col] = v; float sq = v * v;
#pragma unroll
            for (int o = 1; o < 32; o <<= 1) sq += __shfl_xor(sq, o);
            if (r == 0) atomicAdd(SS2 + row, sq); }
    }
}
__device__ __forceinline__ void final_norm(const Frame& F, const Args& a, unsigned char* ws) {
    const float* gfin = a.in[I_NFIN]; const float* SS2 = (const float*)(ws + WS_SS2);
    f32x4 gv[4];
#pragma unroll
    for (int j = 0; j < 4; ++j) gv[j] = *(const f32x4*)(gfin + 4 * F.lane + 256 * j);
    for (int m = F.gw; m < M + SB; m += F.NGW) {
        const float* src = (m < M) ? a.out + O_YP + (size_t)m * DM : (const float*)(ws + WS_SMP + SM_X2) + (size_t)(m - M) * DM;
        float* dst = (m < M) ? a.out + O_YP + (size_t)m * DM : a.out + O_YS + (size_t)(m - M) * DM;
        const float rstd = 1.0f / sqrtf(SS2[m] * (1.0f / DM) + NORM_EPS);
#pragma unroll
        for (int j = 0; j < 4; ++j) { const f32x4 v = *(const f32x4*)(src + 4 * F.lane + 256 * j); *(f32x4*)(dst + 4 * F.lane + 256 * j) = v * rstd * gv[j]; }
    }
}
__global__ void __launch_bounds__(NWAVES * 64, 2) fwd_kernel(Args args) {
    extern __shared__ __attribute__((aligned(16))) unsigned char lds[];
    Frame F;
    F.lds = (LAS unsigned char*)lds;
    F.MISC = (volatile LAS unsigned*)(F.lds + MISC_OFF);
    F.tid = threadIdx.x; F.lane = F.tid & 63; F.wave = __builtin_amdgcn_readfirstlane(F.tid >> 6);
    F.G = gridDim.x; { const int bx = blockIdx.x; F.vcu = (F.G % 8 == 0) ? (bx % 8) * (F.G / 8) + bx / 8 : bx; }
    F.gw = F.vcu * NWAVES + F.wave; F.NGW = F.G * NWAVES;
    unsigned char* ws = args.ws;
    F.ctl = (gu32*)(ws + WS_CTL);
    for (int u = F.tid; u < (LDS_BYTES - LDSCTL_OFF) / 4; u += NWAVES * 64) ((LAS unsigned*)(F.lds + LDSCTL_OFF))[u] = 0u;
    __syncthreads();
    XcdBarrier bar = xcd_barrier_post((unsigned*)(F.ctl + CW_BAR), F.MISC + 8);
#define GRID_BAR() do { xcd_barrier(bar); int t_ = threadIdx.x; asm volatile("" : "+v"(t_)); F.tid = t_; F.lane = t_ & 63; } while (0)
#ifdef PROBE_TIMING
    unsigned long long ts_[14]; int nts_ = 0;
#define STAMP() do { ts_[nts_++] = __builtin_amdgcn_s_memrealtime(); } while (0)
    STAMP();
#else
#define STAMP() do {} while (0)
#endif

#ifndef NO_P0
    for (int rep_ = 0; rep_ < REP_P0; ++rep_) {
    if (rep_ > 0) { GRID_BAR(); }
    p0_prologue(F, args, ws);
    }
#endif
    GRID_BAR(); STAMP();

#ifndef NO_P1
    for (int rep_ = 0; rep_ < REP_P1; ++rep_) {
    if (rep_ > 0) { GRID_BAR(); }
    {
        s_inproj(F, ws);
        pg8::Gemm g{(const pg8::bf16_t*)(ws + WS_XN), (const pg8::bf16_t*)(ws + WS_WIN), M, INP, opaque_int(DM)};
        pg8::StaticOrder S; S.init(M, INP, F.G, (int)blockIdx.x);
        EpiIn E{(bf16*)(ws + WS_Q), (bf16*)(ws + WS_K), (bf16*)(ws + WS_VT), (bf16*)(ws + WS_SC), (bf16*)(ws + WS_GT), args.out, (const float*)(ws + WS_TAB)};
        pg8::gemm_phase<EpiIn, pg8::StaticOrder, true, true>(F.lds + RING_OFF, g, S, E);
    }
    }
#endif
    GRID_BAR(); STAMP();

#ifndef NO_P2
    for (int rep_ = 0; rep_ < REP_P2; ++rep_) {
    if (rep_ > 0) { GRID_BAR(); }
    {
        const bf16* Qb = (const bf16*)(ws + WS_Q); const bf16* Kb = (const bf16*)(ws + WS_K); const bf16* VT = (const bf16*)(ws + WS_VT);
        for (int i = 0; i < 6; ++i) { const int wu = F.vcu * 48 + i * 8 + F.wave; if (wu < 12288 && F.G == 256) attn_unit(wu, Qb, Kb, VT, (bf16*)(ws + WS_OG), (float*)(ws + WS_LSE), F.lane, F.lds + RING_OFF + F.wave * 8192); }
        if (F.G != 256) for (int wu = F.gw; wu < 12288; wu += F.NGW) attn_unit(wu, Qb, Kb, VT, (bf16*)(ws + WS_OG), (float*)(ws + WS_LSE), F.lane, F.lds + RING_OFF + F.wave * 8192);
        r1_rows(F, (const bf16*)(ws + WS_SC), args.in[I_MU], (bf16*)(ws + WS_A1), (bf16*)(ws + WS_A2));
        __syncthreads();
        for (int it = F.vcu; it < SB * AHEADS; it += F.G) s_attn_item(F, args, ws, it >> 3, it & 7);
        for (int it = F.vcu; it < SB * BHEADS; it += F.G) s_rwkv_item(F, args, ws, it >> 4, it & 15);
        { const float* PROJ = (const float*)(ws + WS_SMP + SM_PROJ);
          for (int e = F.vcu * 512 + F.tid; e < SB * SCOLS; e += F.G * 512) { const int b = e / SCOLS, c = e - b * SCOLS; args.out[O_SHS + e] = PROJ[(size_t)b * INP + ACOLS + c]; } }
    }
    }
#endif
    GRID_BAR(); STAMP();

#ifndef NO_P3
    for (int rep_ = 0; rep_ < REP_P3; ++rep_) {
    if (rep_ > 0) { GRID_BAR(); }
    {
        { pg8::Gemm g{(const pg8::bf16_t*)(ws + WS_A1), (const pg8::bf16_t*)(ws + WS_WWA), M, 2048, opaque_int(128)}; pg8::StaticOrder S; S.init(M, 2048, F.G, (int)blockIdx.x);
          EpiWA E{(bf16*)(ws + WS_E), (bf16*)(ws + WS_AV), args.in[I_W0], args.in[I_A0]};
          pg8::gemm_phase<EpiWA, pg8::StaticOrder, true, true>(F.lds + RING_OFF, g, S, E); }
        { pg8::Gemm g{(const pg8::bf16_t*)(ws + WS_A2), (const pg8::bf16_t*)(ws + WS_WG), M, 1024, opaque_int(256)}; pg8::StaticOrder S; S.init(M, 1024, F.G, (int)blockIdx.x);
          EpiPlain E{(bf16*)(ws + WS_GATE), 1024};
          pg8::gemm_phase<EpiPlain, pg8::StaticOrder, true, true>(F.lds + RING_OFF, g, S, E); }
        combine_groups(F, (const bf16*)(ws + WS_OG), (const float*)(ws + WS_LSE), (bf16*)(ws + WS_OA));
    }
    }
#endif
    GRID_BAR(); STAMP();

#ifndef NO_P4
    for (int rep_ = 0; rep_ < REP_P4; ++rep_) {
    if (rep_ > 0) { GRID_BAR(); }
    scan_phase(F, args, ws);
    }
#endif
    GRID_BAR(); STAMP();

#ifndef NO_P5
    for (int rep_ = 0; rep_ < REP_P5; ++rep_) {
    if (rep_ > 0) { GRID_BAR(); }
    r3_rows(F, args, ws);
    }
#endif
    GRID_BAR(); STAMP();

#ifndef NO_P6
    for (int rep_ = 0; rep_ < REP_P6; ++rep_) {
    if (rep_ > 0) { GRID_BAR(); }
    {
        s_proj(F, ws);
        { pg8::Gemm g{(const pg8::bf16_t*)(ws + WS_OA), (const pg8::bf16_t*)(ws + WS_WA), M, DM, opaque_int(AWID)}; pg8::StaticOrder S; S.init(M, DM, F.G, (int)blockIdx.x);
          EpiPA E{(const bf16*)(ws + WS_GT), (float*)(ws + WS_Y1)};
          pg8::gemm_phase<EpiPA, pg8::StaticOrder, true, true>(F.lds + RING_OFF, g, S, E); }
        VM_WAIT(); __syncthreads();
        { pg8::Gemm g{(const pg8::bf16_t*)(ws + WS_OB), (const pg8::bf16_t*)(ws + WS_WB), M, DM, opaque_int(BWID)}; pg8::StaticOrder S; S.init(M, DM, F.G, (int)blockIdx.x);
          EpiPB E{(const bf16*)(ws + WS_GT), (const float*)(ws + WS_Y1), (bf16*)(ws + WS_MG)};
          pg8::gemm_phase<EpiPB, pg8::StaticOrder, true, true>(F.lds + RING_OFF, g, S, E); }
    }
    }
#endif
    GRID_BAR(); STAMP();

#ifndef NO_P7
    {
        s_out(F, args, ws);
        pg8::Gemm g{(const pg8::bf16_t*)(ws + WS_MG), (const pg8::bf16_t*)(ws + WS_WO), M, DM, opaque_int(DM)}; pg8::StaticOrder S; S.init(M, DM, F.G, (int)blockIdx.x);
        EpiRes E{args.in[I_XP], (float*)(ws + WS_X1), (bf16*)(ws + WS_X1B), (float*)(ws + WS_SS)};
        pg8::gemm_phase<EpiRes, pg8::StaticOrder, true, true>(F.lds + RING_OFF, g, S, E);
    }
#endif
    GRID_BAR(); STAMP();

#ifndef NO_P8
    for (int rep_ = 0; rep_ < REP_P8; ++rep_) {
    if (rep_ > 0) { GRID_BAR(); }
    {
        s_gu(F, ws);
        pg8::Gemm g{(const pg8::bf16_t*)(ws + WS_X1B), (const pg8::bf16_t*)(ws + WS_WGU), M, GU, opaque_int(DM)}; pg8::StaticOrder S; S.init(M, GU, F.G, (int)blockIdx.x);
        EpiGU E{(const float*)(ws + WS_SS), (bf16*)(ws + WS_ACT)};
        pg8::gemm_phase<EpiGU, pg8::StaticOrder, true, true>(F.lds + RING_OFF, g, S, E);
    }
    }
#endif
    GRID_BAR(); STAMP();

#ifndef NO_P9
    {
        s_down(F, ws);
        pg8::Gemm g{(const pg8::bf16_t*)(ws + WS_ACT), (const pg8::bf16_t*)(ws + WS_WD), M, DM, opaque_int(DFF)}; pg8::StaticOrder S; S.init(M, DM, F.G, (int)blockIdx.x);
        EpiRes E{(const float*)(ws + WS_X1), args.out + O_YP, nullptr, (float*)(ws + WS_SS2)};
        pg8::gemm_phase<EpiRes, pg8::StaticOrder, true, true>(F.lds + RING_OFF, g, S, E);
    }
#endif
    GRID_BAR(); STAMP();

#ifndef NO_P10
    final_norm(F, args, ws);
#endif
#ifdef PROBE_TIMING
    GRID_BAR(); STAMP();
    if (blockIdx.x == 0 && F.tid == 0) {
        const size_t offs[12] = {O_YP, O_YS, O_KV1P, O_KV2P, O_KV3P, O_SHP, O_WKVP, O_KV1S, O_KV2S, O_KV3S, O_SHS, O_WKVS};
        for (int k = 0; k < 11; ++k) args.out[offs[k]] = (float)(ts_[k + 1] - ts_[k]) * 0.01f;
        args.out[offs[11]] = (float)(ts_[11] - ts_[0]) * 0.01f;
    }
#endif
}

extern "C" void kernel_launch(void* const* d_in, const int* in_sizes, int n_in, void* d_out, int out_size, void* d_ws, size_t ws_size, hipStream_t stream) {
    static int grid = 0;
    if (grid == 0) {
        if (n_in != 28 || in_sizes[0] != M * DM || (size_t)out_size != O_END || ws_size < WS_END) {
            fprintf(stderr, "kernel_launch: unexpected shapes: n_in %d in0 %d out %d ws %zu (need %zu)\n", n_in, n_in > 0 ? in_sizes[0] : -1, out_size, ws_size, (size_t)WS_END); grid = -1; return; }
        int dev = 0, cus = 0, per_cu = 0;
        if (hipGetDevice(&dev) != hipSuccess || hipDeviceGetAttribute(&cus, hipDeviceAttributeMultiprocessorCount, dev) != hipSuccess) { grid = -1; return; }
        if (hipFuncSetAttribute((const void*)fwd_kernel, hipFuncAttributeMaxDynamicSharedMemorySize, LDS_BYTES) != hipSuccess) { fprintf(stderr, "kernel_launch: hipFuncSetAttribute failed\n"); grid = -1; return; }
        if (hipOccupancyMaxActiveBlocksPerMultiprocessor(&per_cu, (const void*)fwd_kernel, NWAVES * 64, LDS_BYTES) != hipSuccess || per_cu < 1) {
            fprintf(stderr, "kernel_launch: occupancy query says %d blocks per CU\n", per_cu); (void)hipGetLastError(); grid = -1; return; }
        grid = cus;
    }
    if (grid < 0) return;
    if (hipMemsetAsync((char*)d_ws + WS_CTL, 0, CTL_ZERO_BYTES, stream) != hipSuccess) return;
    Args a{};
    for (int i = 0; i < 28; ++i) a.in[i] = (const float*)d_in[i];
    a.out = (float*)d_out; a.ws = (unsigned char*)d_ws;
    hipLaunchKernelGGL(fwd_kernel, dim3(grid), dim3(NWAVES * 64), LDS_BYTES, stream, a);
}
```

```cpp
#include <hip/hip_runtime.h>
#include <cstdio>
#include <cstdint>
namespace pg8 {
#define PG8_LAS __attribute__((address_space(3)))
typedef unsigned short bf16_t;
typedef short bf16x8 __attribute__((ext_vector_type(8)));
typedef float f32x4 __attribute__((ext_vector_type(4)));
typedef unsigned u32x4 __attribute__((ext_vector_type(4)));
constexpr int BM = 256, BK = 64, HALF = 128, HTB = HALF * BK * 2  , STAGE_BYTES = 8 * HTB, NXCD = 8, WGM = 8;

__host__ __device__ __forceinline__ int lds_byte(int r, int c) { const int st = (r >> 4) * 2 + (c >> 5), rr = r & 15, cc = c & 31, ob = rr * 64 + cc * 2; return st * 1024 + (ob ^ (((ob >> 9) & 1) << 5)); }
__host__ __device__ __forceinline__ void stage_rc(int b, int& R, int& C) { const int st = b / 1024, sb = b % 1024, swz = sb ^ (((sb >> 9) & 1) << 5); R = (st >> 1) * 16 + swz / 64; C = (st & 1) * 32 + (swz % 64) / 2; }
__host__ __device__ __forceinline__ int perm32(int rho) { const int n = rho >> 4, i = rho & 15; return 8 * (i >> 2) + 4 * n + (i & 3); }

struct Unit { int pm, pn; };
struct Gemm { const bf16_t* A; const bf16_t* Bt; int M, N, K; };

struct StaticOrder {
    int nM, nN, nwg, G, c;
    __host__ __device__ void init(int M, int N, int G_, int c_) { nM = M / BM; nN = N / BM; nwg = nM * nN; G = G_; c = c_; }
    __host__ __device__ bool next(int i, Unit& u) const {
        const long L = (long)i * G + c; if (L >= nwg) return false;
        int wgid = (int)L; { const int q = nwg / NXCD, r = nwg % NXCD, xcd = wgid % NXCD, off = wgid / NXCD; wgid = (xcd < r ? xcd * (q + 1) : r * (q + 1) + (xcd - r) * q) + off; }
        const int nig = WGM * nN, gid = wgid / nig, fm = gid * WGM, gsz = (nM - fm) < WGM ? (nM - fm) : WGM;
        u.pm = fm + ((wgid % nig) % gsz); u.pn = (wgid % nig) / gsz; return true;
    }
    __device__ __forceinline__ void a_ready(const Unit&) const {}
    __device__ __forceinline__ void done(const Unit&) const {}
};

__device__ __forceinline__ unsigned cvt_pk_bf16(float lo, float hi) { unsigned r; asm volatile("v_cvt_pk_bf16_f32 %0, %1, %2" : "=v"(r) : "v"(lo), "v"(hi)); return r; }
template <class Epi, class Sched, bool ALIGN_EPI = false, bool SP2 = false>
__device__ __forceinline__ void gemm_phase(PG8_LAS unsigned char* lds, const Gemm g, const Sched& S, const Epi& E) {
    int tid_ = threadIdx.x; asm volatile("" : "+v"(tid_));
    const int tid = tid_, wid = __builtin_amdgcn_readfirstlane(tid >> 6), lane = tid & 63, wr = wid >> 2, wc = wid & 3, fr = lane & 15, fq = lane >> 4;
    const int K = g.K, nt = K / BK;
    unsigned voffA[2], voffB[2];
#pragma unroll
    for (int i = 0; i < 2; ++i) { int R, C; stage_rc(tid * 16 + i * 8192, R, C); const int Rb = Epi::PERM ? ((R & ~31) + perm32(R & 31)) : R;
        voffA[i] = (unsigned)(R * K + C) * 2u; voffB[i] = (unsigned)(Rb * K + C) * 2u; }
    const size_t kstep = (size_t)(BK * 2);
    const size_t hstep = (size_t)HALF * K * 2;
    const size_t tstep = 2 * hstep;
    const unsigned ldsw = (unsigned)wid * 1024u;
    const int aoff = lds_byte(wr * 64 + fr, fq * 8), boff = lds_byte(wc * 32 + fr, fq * 8);
#define PG8_SA(b, h) (((b) * 2 + (h)) * HTB)
#define PG8_SB(b, h) ((4 + (b) * 2 + (h)) * HTB)
#define PG8_STAGE(bufoff, gbase, voff) do { _Pragma("unroll") for (int _i = 0; _i < 2; ++_i) \
        __builtin_amdgcn_global_load_lds((const unsigned*)((const char*)(gbase) + (voff)[_i]), (PG8_LAS unsigned*)(lds + (bufoff) + ldsw + _i * 8192), 16, 0, 0); } while (0)
#define PG8_LDA(dst, b, h) do { _Pragma("unroll") for (int m = 0; m < 4; ++m) _Pragma("unroll") for (int k = 0; k < 2; ++k) dst[m][k] = *(const PG8_LAS bf16x8*)(lds + PG8_SA(b, h) + aoff + m * 2048 + k * 1024); } while (0)
#define PG8_LDB(dst, b, h) do { _Pragma("unroll") for (int n = 0; n < 2; ++n) _Pragma("unroll") for (int k = 0; k < 2; ++k) dst[n][k] = *(const PG8_LAS bf16x8*)(lds + PG8_SB(b, h) + boff + n * 2048 + k * 1024); } while (0)
#define PG8_MMA(ai, bj, At, Bt) do { __builtin_amdgcn_s_setprio(1); _Pragma("unroll") for (int m = 0; m < 4; ++m) _Pragma("unroll") for (int n = 0; n < 2; ++n) _Pragma("unroll") for (int k = 0; k < 2; ++k) \
        acc[ai][bj][m][n] = __builtin_amdgcn_mfma_f32_16x16x32_bf16(Bt[n][k], At[m][k], acc[ai][bj][m][n], 0, 0, 0); __builtin_amdgcn_s_setprio(0); } while (0)
#define PG8_WAIT_V(n) asm volatile("s_waitcnt vmcnt(" #n ")" ::: "memory")
#define PG8_WAIT_L(n) asm volatile("s_waitcnt lgkmcnt(" #n ")" ::: "memory")
#define PG8_BAR __builtin_amdgcn_s_barrier()
#define PG8_SCHED __builtin_amdgcn_sched_barrier(0)
    Unit cur, nxt; int ui = 0;
    if (!S.next(0, cur)) return;
    f32x4 acc[2][2][4][2];
#pragma unroll
    for (int a = 0; a < 2; ++a)
#pragma unroll
        for (int b = 0; b < 2; ++b)
#pragma unroll
            for (int m = 0; m < 4; ++m)
#pragma unroll
                for (int n = 0; n < 2; ++n) acc[a][b][m][n] = (f32x4){0.f, 0.f, 0.f, 0.f};
    bf16x8 At[4][2], B0[2][2], B1[2][2];
    const char* cA = (const char*)g.A + (size_t)cur.pm * tstep; const char* cB = (const char*)g.Bt + (size_t)cur.pn * tstep;
    S.a_ready(cur);
    if constexpr (SP2) {
        PG8_STAGE(PG8_SB(0, 0), cB, voffB); PG8_STAGE(PG8_SB(0, 1), cB + hstep, voffB); PG8_STAGE(PG8_SA(0, 0), cA, voffA); PG8_STAGE(PG8_SA(0, 1), cA + hstep, voffA);
        if (wr == 1) PG8_BAR;
        PG8_WAIT_V(2); PG8_BAR;
        PG8_STAGE(PG8_SB(1, 0), cB + kstep, voffB); PG8_STAGE(PG8_SA(1, 0), cA + kstep, voffA); PG8_STAGE(PG8_SB(1, 1), cB + hstep + kstep, voffB);
        PG8_WAIT_V(6); PG8_BAR;
    } else {
        PG8_STAGE(PG8_SB(0, 0), cB, voffB); PG8_STAGE(PG8_SA(0, 0), cA, voffA); PG8_STAGE(PG8_SB(0, 1), cB + hstep, voffB); PG8_STAGE(PG8_SA(0, 1), cA + hstep, voffA);
        if (wr == 1) PG8_BAR;
        PG8_WAIT_V(4); PG8_BAR;
        PG8_STAGE(PG8_SB(1, 0), cB + kstep, voffB); PG8_STAGE(PG8_SA(1, 0), cA + kstep, voffA); PG8_STAGE(PG8_SB(1, 1), cB + hstep + kstep, voffB);
        PG8_WAIT_V(6); PG8_BAR;
    }
    for (;;) {
        const bool has_next = S.next(ui + 1, nxt);
        const char* nA = has_next ? (const char*)g.A + (size_t)nxt.pm * tstep : cA; const char* nB = has_next ? (const char*)g.Bt + (size_t)nxt.pn * tstep : cB;
        for (int t = 0; t < nt; t += 2) {
            const bool last = (t == nt - 2);
            const char* a1 = cA + (size_t)(t + 1) * kstep;
            const char* a2 = last ? nA : cA + (size_t)(t + 2) * kstep; const char* b2 = last ? nB : cB + (size_t)(t + 2) * kstep;
            const char* a3 = a2 + kstep; const char* b3 = b2 + kstep;
            if (last && has_next) S.a_ready(nxt);
            if constexpr (SP2) {
            PG8_LDB(B0, 0, 0); PG8_LDB(B1, 0, 1); PG8_SCHED; PG8_LDA(At, 0, 0); PG8_STAGE(PG8_SA(1, 1), a1 + hstep, voffA);
            PG8_WAIT_V(8); PG8_WAIT_L(0); PG8_BAR; PG8_MMA(0, 0, At, B0); PG8_MMA(0, 1, At, B1); PG8_BAR; PG8_SCHED;
            PG8_LDA(At, 0, 1); PG8_STAGE(PG8_SB(0, 0), b2, voffB); PG8_STAGE(PG8_SB(0, 1), b2 + hstep, voffB); PG8_STAGE(PG8_SA(0, 0), a2, voffA);
            PG8_WAIT_V(8); PG8_WAIT_L(0); PG8_BAR; PG8_MMA(1, 0, At, B0); PG8_MMA(1, 1, At, B1); PG8_BAR; PG8_SCHED;
            PG8_LDB(B0, 1, 0); PG8_LDB(B1, 1, 1); PG8_SCHED; PG8_LDA(At, 1, 0); PG8_STAGE(PG8_SA(0, 1), a2 + hstep, voffA);
            PG8_WAIT_V(8); PG8_WAIT_L(0); PG8_BAR; PG8_MMA(0, 0, At, B0); PG8_MMA(0, 1, At, B1); PG8_BAR; PG8_SCHED;
            PG8_LDA(At, 1, 1); PG8_STAGE(PG8_SB(1, 0), b3, voffB); PG8_STAGE(PG8_SB(1, 1), b3 + hstep, voffB); PG8_STAGE(PG8_SA(1, 0), a3, voffA);
            PG8_WAIT_V(8); PG8_WAIT_L(0); PG8_BAR; PG8_MMA(1, 0, At, B0); PG8_MMA(1, 1, At, B1); PG8_BAR; PG8_SCHED;
            } else {
            PG8_LDB(B0, 0, 0); PG8_SCHED; PG8_LDA(At, 0, 0); PG8_STAGE(PG8_SA(1, 1), a1 + hstep, voffA);
            PG8_WAIT_L(8); PG8_BAR; PG8_WAIT_L(0); PG8_MMA(0, 0, At, B0); PG8_BAR; PG8_SCHED;
            PG8_LDB(B1, 0, 1); PG8_STAGE(PG8_SB(0, 0), b2, voffB);
            PG8_BAR; PG8_WAIT_L(0); PG8_MMA(0, 1, At, B1); PG8_BAR;
            PG8_LDA(At, 0, 1); PG8_STAGE(PG8_SA(0, 0), a2, voffA);
            PG8_BAR; PG8_WAIT_L(0); PG8_MMA(1, 0, At, B0); PG8_BAR; PG8_SCHED;
            PG8_STAGE(PG8_SB(0, 1), b2 + hstep, voffB);
            PG8_WAIT_V(6); PG8_BAR; PG8_MMA(1, 1, At, B1); PG8_BAR;
            PG8_LDB(B0, 1, 0); PG8_SCHED; PG8_LDA(At, 1, 0); PG8_STAGE(PG8_SA(0, 1), a2 + hstep, voffA);
            PG8_WAIT_L(8); PG8_BAR; PG8_WAIT_L(0); PG8_MMA(0, 0, At, B0); PG8_BAR; PG8_SCHED;
            PG8_LDB(B1, 1, 1); PG8_STAGE(PG8_SB(1, 0), b3, voffB);
            PG8_BAR; PG8_WAIT_L(0); PG8_MMA(0, 1, At, B1); PG8_BAR;
            PG8_LDA(At, 1, 1); PG8_STAGE(PG8_SA(1, 0), a3, voffA);
            PG8_BAR; PG8_WAIT_L(0); PG8_MMA(1, 0, At, B0); PG8_BAR; PG8_SCHED;
            PG8_STAGE(PG8_SB(1, 1), b3 + hstep, voffB);
            PG8_WAIT_V(6); PG8_BAR; PG8_MMA(1, 1, At, B1); PG8_BAR;
            }
        }
        if constexpr (ALIGN_EPI) { if (wr == 0) PG8_BAR; }
        if constexpr (!Epi::AFTER_DRAIN) { E(acc, cur, wr, wc, fr, fq); S.done(cur); }
        if (!has_next) break;
#pragma unroll
        for (int a = 0; a < 2; ++a)
#pragma unroll
            for (int b = 0; b < 2; ++b)
#pragma unroll
                for (int m = 0; m < 4; ++m)
#pragma unroll
                    for (int n = 0; n < 2; ++n) acc[a][b][m][n] = (f32x4){0.f, 0.f, 0.f, 0.f};
        cur = nxt; cA = nA; cB = nB; ++ui;
        if constexpr (ALIGN_EPI) { if (wr == 1) PG8_BAR; }
    }
    PG8_WAIT_V(0);
    if constexpr (!ALIGN_EPI) { if (wr == 0) PG8_BAR; }
    PG8_BAR;
    if constexpr (Epi::AFTER_DRAIN) { E.fused(acc, cur, wr, wc, fr, fq, lds, wid, lane); S.done(cur); }
#undef PG8_SA
#undef PG8_SB
#undef PG8_STAGE
#undef PG8_LDA
#undef PG8_LDB
#undef PG8_MMA
#undef PG8_WAIT_V
#undef PG8_WAIT_L
#undef PG8_BAR
#undef PG8_SCHED
}
}
#ifndef REP_P0
#define REP_P0 1
#endif
#ifndef REP_P1
#define REP_P1 1
#endif
#ifndef REP_P2
#define REP_P2 1
#endif
#ifndef REP_P3
#define REP_P3 1
#endif
#ifndef REP_P4
#define REP_P4 1
#endif
#ifndef REP_P5
#define REP_P5 1
#endif
#ifndef REP_P6
#define REP_P6 1
#endif
#ifndef REP_P8
#define REP_P8 1
#endif

constexpr int NWAVES = 8;
constexpr int DM = 1024, NB = 8, T = 2048, M = NB * T;
constexpr int SB = 32;
constexpr int PAST = 16384;
constexpr int HD = 64, AHEADS = 8, AWID = 512, BHEADS = 16, BWID = 1024;
constexpr int ACOLS = 4608, SCOLS = 3360, SCP = 3584, INCOLS = 10016, INP = 10240;
constexpr int DFF = 2816, GU = 2 * DFF;
constexpr float NORM_EPS = 1e-6f, GN_EPS = 64e-5f;
constexpr float LOG2E = 1.4426950408889634f, LN2 = 0.6931471805599453f;
constexpr float QSCALE = 0.125f * LOG2E;
constexpr size_t O_YP = 0, O_YS = O_YP + (size_t)M * DM, O_KV1P = O_YS + (size_t)SB * DM, O_KV2P = O_KV1P + (size_t)NB * 128 * 1024,
                 O_KV3P = O_KV2P + (size_t)NB * 512 * 1024, O_SHP = O_KV3P + (size_t)NB * 2048 * 1024, O_WKVP = O_SHP + (size_t)NB * SCOLS,
                 O_KV1S = O_WKVP + (size_t)NB * 16 * 4096, O_KV2S = O_KV1S + (size_t)SB * 1024, O_KV3S = O_KV2S + (size_t)SB * 1024,
                 O_SHS = O_KV3S + (size_t)SB * 1024, O_WKVS = O_SHS + (size_t)SB * SCOLS, O_END = O_WKVS + (size_t)SB * 16 * 4096;
static_assert(O_END == 41684224, "output size");
constexpr size_t MiB = 1u << 20;
constexpr size_t WS_CTL = 0, CTL_ZERO_BYTES = 1 * MiB;
constexpr size_t WS_TAB = 1 * MiB;
constexpr size_t WS_SS = 2 * MiB;
constexpr size_t WS_SS2 = WS_SS + 128 * 1024;
constexpr size_t WS_SMP = 3 * MiB;
constexpr size_t WS_WIN = 8 * MiB, WS_WA = 28 * MiB, WS_WB = 29 * MiB, WS_WO = 31 * MiB, WS_WGU = 33 * MiB, WS_WD = 44 * MiB, WS_WWA = 50 * MiB, WS_WG = 51 * MiB;
constexpr size_t WS_XN = 52 * MiB, WS_Q = 84 * MiB, WS_K = 132 * MiB, WS_VT = 180 * MiB, WS_SC = 228 * MiB, WS_GT = 340 * MiB;
constexpr size_t WS_OG = 404 * MiB, WS_LSE = 452 * MiB, WS_OA = 454 * MiB, WS_A1 = 470 * MiB, WS_A2 = 474 * MiB;
constexpr size_t WS_E = 482 * MiB, WS_AV = 514 * MiB, WS_GATE = 546 * MiB, WS_Y = 578 * MiB, WS_CB = 642 * MiB, WS_OB = 643 * MiB;
constexpr size_t WS_Y1 = 675 * MiB, WS_MG = 739 * MiB, WS_X1 = 771 * MiB, WS_X1B = 835 * MiB, WS_END = 867 * MiB;
constexpr size_t WS_ACT = WS_Q;
static_assert((size_t)M * DFF * 2 <= WS_VT - WS_Q, "ACT overlay");
constexpr size_t SM_HSN = 0;
constexpr size_t SM_PROJ = 64 * 1024;
constexpr size_t SM_OA = SM_PROJ + (size_t)SB * INP * 4;
constexpr size_t SM_OB = SM_OA + 32 * 1024;
constexpr size_t SM_YA = SM_OB + 64 * 1024;
constexpr size_t SM_YB = SM_YA + 128 * 1024;
constexpr size_t SM_X1 = SM_YB + 128 * 1024;
constexpr size_t SM_X1B = SM_X1 + 128 * 1024;
constexpr size_t SM_ACT = SM_X1B + 64 * 1024;
constexpr size_t SM_X2 = SM_ACT + 192 * 1024;
constexpr size_t SM_OG = SM_X2 + 128 * 1024;
constexpr size_t SM_LSE = SM_OG + 192 * 1024;
constexpr size_t SM_END = SM_LSE + 4096;
static_assert(SM_END <= 5 * MiB, "sample scratch");
constexpr int CW_BAR = 4096;
constexpr int RING_OFF = 0, RING_BYTES = 131072, LDSCTL_OFF = RING_BYTES, MISC_OFF = LDSCTL_OFF + 320, LDS_BYTES = 147456;

#define GAS __attribute__((address_space(1)))
#define LAS __attribute__((address_space(3)))
typedef unsigned short bf16;
typedef unsigned v4u __attribute__((ext_vector_type(4)));
typedef float f32x4 __attribute__((ext_vector_type(4)));
typedef short bf16x8 __attribute__((ext_vector_type(8)));
typedef GAS unsigned gu32;
typedef GAS unsigned long long gu64;
#define RLX_AGENT __ATOMIC_RELAXED, __HIP_MEMORY_SCOPE_AGENT
#define LDS_WAIT() asm volatile("s_waitcnt lgkmcnt(0)" ::: "memory")
#define VM_WAIT() asm volatile("s_waitcnt vmcnt(0)" ::: "memory")
__device__ __forceinline__ unsigned long long rt() { return __builtin_amdgcn_s_memrealtime(); }
__device__ __forceinline__ unsigned f2bf(float f) { unsigned u = __builtin_bit_cast(unsigned, f); return (u + 0x7fffu + ((u >> 16) & 1u)) >> 16; }
__device__ __forceinline__ unsigned pk2(float lo, float hi) { return f2bf(lo) | (f2bf(hi) << 16); }

#define XB_TMO      128
#define XB_XCNT(j)  (256  + 64 * (j))
#define XB_XSUB(j)  (1280 + 64 * (j))
#define XB_XGEN(j)  (2304 + 64 * (j))
#define XB_TOP      3328
#define XB_TOPGEN   3392
#define XCD_BAR_WORDS 3456
#define XB_SPIN_CAP (1u << 18)

__device__ __forceinline__ unsigned xb_ld(unsigned* p)              { return __hip_atomic_load(p, __ATOMIC_RELAXED, __HIP_MEMORY_SCOPE_AGENT); }
__device__ __forceinline__ unsigned xb_add(unsigned* p, unsigned v) { return __hip_atomic_fetch_add(p, v, __ATOMIC_RELAXED, __HIP_MEMORY_SCOPE_AGENT); }
__device__ __forceinline__ unsigned xb_xcc_id() { return (unsigned)__builtin_amdgcn_s_getreg((3 << 11) | 20) & 0xFu; }
#define XB_SPIN(cond, bar) do { unsigned _sp = 0; while (cond) { __builtin_amdgcn_s_sleep(1); \
    if ((++_sp & 255u) == 0u) { if (xb_ld(&(bar)[XB_TMO])) break; if (_sp > XB_SPIN_CAP) { atomicAdd(&(bar)[XB_TMO], 1u); break; } } } } while (0)

struct XcdBarrier {
    unsigned* bar; unsigned x;
    volatile LAS unsigned* st;
};

__device__ __forceinline__ XcdBarrier xcd_barrier_post(unsigned* bar, volatile LAS unsigned* st) {
    XcdBarrier b; b.bar = bar; b.x = xb_xcc_id(); b.st = st;
    if (threadIdx.x == 0) (void)xb_add(&bar[XB_XCNT(b.x)], 1u);
    return b;
}
__device__ __forceinline__ void xcd_barrier_complete(unsigned* bar, unsigned x, unsigned& nloc, unsigned& nx) {
    const unsigned G = gridDim.x * gridDim.y * gridDim.z;
    unsigned sum, cnt, mine, sp = 0u;
    for (;;) {
        sum = 0u; cnt = 0u; mine = 0u;
#pragma unroll
        for (unsigned j = 0; j < 16; ++j) { const unsigned c = xb_ld(&bar[XB_XCNT(j)]); sum += c; cnt += (c > 0u) ? 1u : 0u; mine = (j == x) ? c : mine; }
        if (sum == G) break;
        __builtin_amdgcn_s_sleep(1);
        if ((++sp & 255u) == 0u) { if (xb_ld(&bar[XB_TMO])) break; if (sp > XB_SPIN_CAP) { atomicAdd(&bar[XB_TMO], 1u); break; } }
    }
    nloc = mine > 0u ? mine : 1u; nx = cnt > 0u ? cnt : 1u;
}

__device__ __forceinline__ void xcd_barrier(const XcdBarrier& b) {
    asm volatile("s_waitcnt vmcnt(0)" ::: "memory");
    __syncthreads();
    if (threadIdx.x == 0) {
        unsigned* bar = b.bar;
        __builtin_amdgcn_s_waitcnt(0);
        unsigned nloc = b.st[0], nx = b.st[1];
        if (nloc == 0u) { xcd_barrier_complete(bar, b.x, nloc, nx); b.st[0] = nloc; b.st[1] = nx; }
        const unsigned old = xb_add(&bar[XB_XSUB(b.x)], 1u);
        const unsigned gen = old / nloc;
        if (old + 1u == (gen + 1u) * nloc) {
            __builtin_amdgcn_fence(__ATOMIC_RELEASE, "agent");
            asm volatile("s_waitcnt vmcnt(0)" ::: "memory");
            const unsigned og = xb_add(&bar[XB_TOP], 1u);
            const unsigned tg = og / nx;
            if (og + 1u == (tg + 1u) * nx) xb_add(&bar[XB_TOPGEN], 1u);
            else XB_SPIN(xb_ld(&bar[XB_TOPGEN]) == tg, bar);
            __builtin_amdgcn_fence(__ATOMIC_ACQUIRE, "agent");
            xb_add(&bar[XB_XGEN(b.x)], 1u);
            asm volatile("s_waitcnt vmcnt(0)" ::: "memory");
        } else {
            XB_SPIN(xb_ld(&bar[XB_XGEN(b.x)]) == gen, bar);
            __builtin_amdgcn_fence(__ATOMIC_ACQUIRE, "agent");
            asm volatile("s_waitcnt vmcnt(0)" ::: "memory");
        }
    }
    __syncthreads();
}

struct Args { const float* in[28]; float* out; unsigned char* ws; };
enum { I_XP = 0, I_XS, I_C1, I_C2, I_C3, I_SSH, I_SWKV, I_NMIX, I_WIN, I_MU, I_W0, I_W2, I_A0, I_A2, I_G2, I_KK, I_KA, I_RK, I_GNW, I_GNB,
       I_WPA, I_WPB, I_WOUT, I_NFFN, I_WGATE, I_WUP, I_WDOWN, I_NFIN };
typedef float f32x2 __attribute__((ext_vector_type(2)));
typedef unsigned u32x2 __attribute__((ext_vector_type(2)));

__device__ __forceinline__ float wave_sum(float v) {
#pragma unroll
    for (int o = 1; o < 64; o <<= 1) v += __shfl_xor(v, o);
    return v;
}
__device__ __forceinline__ float bf2f(unsigned short h) { return __builtin_bit_cast(float, (unsigned)h << 16); }
__device__ __forceinline__ float bflo(unsigned w) { return __builtin_bit_cast(float, w << 16); }
__device__ __forceinline__ float bfhi(unsigned w) { return __builtin_bit_cast(float, w & 0xffff0000u); }
__device__ __forceinline__ float sigmoidf_(float x) { return 1.0f / (1.0f + __expf(-x)); }

__device__ const float ROPE_FREQ[32] = {
    1.000000000e+00f, 7.498942614e-01f, 5.623413324e-01f, 4.216965139e-01f, 3.162277639e-01f, 2.371373773e-01f, 1.778279394e-01f, 1.333521307e-01f,
    1.000000015e-01f, 7.498941571e-02f, 5.623413250e-02f, 4.216965288e-02f, 3.162277490e-02f, 2.371373773e-02f, 1.778279431e-02f, 1.333521493e-02f,
    9.999999776e-03f, 7.498941850e-03f, 5.623413250e-03f, 4.216964822e-03f, 3.162277630e-03f, 2.371373586e-03f, 1.778279431e-03f, 1.333521446e-03f,
    1.000000047e-03f, 7.498942432e-04f, 5.623413017e-04f, 4.216965172e-04f, 3.162277571e-04f, 2.371373703e-04f, 1.778279402e-04f, 1.333521504e-04f};
__device__ __forceinline__ void sincos_acc(float xf, float& s, float& c) {
    const double x = (double)xf;
    const double q = __builtin_rint(x * 0.63661977236758134308);
    double r = __builtin_fma(-q, 1.57079632679489655800e+00, x); r = __builtin_fma(-q, 6.12323399573676603587e-17, r);
    const double r2 = r * r;
    double sp = -1.0 / 1307674368000.0; sp = sp * r2 + 1.0 / 6227020800.0; sp = sp * r2 - 1.0 / 39916800.0; sp = sp * r2 + 1.0 / 362880.0; sp = sp * r2 - 1.0 / 5040.0; sp = sp * r2 + 1.0 / 120.0; sp = sp * r2 - 1.0 / 6.0; sp = sp * r2 + 1.0; sp *= r;
    double cp = 1.0 / 20922789888000.0; cp = cp * r2 - 1.0 / 87178291200.0; cp = cp * r2 + 1.0 / 479001600.0; cp = cp * r2 - 1.0 / 3628800.0; cp = cp * r2 + 1.0 / 40320.0; cp = cp * r2 - 1.0 / 720.0; cp = cp * r2 + 1.0 / 24.0; cp = cp * r2 - 0.5; cp = cp * r2 + 1.0;
    const int qi = (int)((long long)q & 3);
    const double ss = (qi & 1) ? cp : sp, cc = (qi & 1) ? sp : cp;
    s = (float)((qi & 2) ? -ss : ss);
    c = (float)(((qi + 1) & 2) ? -cc : cc);
}

template <class Src> __device__ __forceinline__ void tr_item(const Src& src, bf16* WT, int Kd, LAS float* scr, int k0, int n0, int lane) {
#pragma unroll 8
    for (int i = 0; i < 32; ++i) { const int kk = 2 * i + (lane >> 5); scr[kk * 33 + (lane & 31)] = src(k0 + kk, n0 + (lane & 31)); }
    LDS_WAIT(); asm volatile("" ::: "memory");
    const int c = lane & 7;
#pragma unroll
    for (int j = 0; j < 4; ++j) { const int n = (lane >> 3) + 8 * j; const LAS float* s = scr + (8 * c) * 33 + n;
        v4u o; o.x = pk2(s[0 * 33], s[1 * 33]); o.y = pk2(s[2 * 33], s[3 * 33]); o.z = pk2(s[4 * 33], s[5 * 33]); o.w = pk2(s[6 * 33], s[7 * 33]);
        *(GAS v4u*)(WT + (size_t)(n0 + n) * Kd + k0 + 8 * c) = o; }
    LDS_WAIT(); asm volatile("" ::: "memory");
}
__device__ __forceinline__ int win_src_col(int np) {
    if (np < ACOLS) { const int part = np >> 9, kind = part % 3, within = np & 511, head = within >> 6, pos = within & 63;
        const int d = (kind < 2) ? ((pos & 1) * 32 + (pos >> 1)) : pos; return part * 512 + head * 64 + d; }
    if (np < ACOLS + SCP) { const int j = np - ACOLS; return j < SCOLS ? ACOLS + j : -1; }
    return ACOLS + SCOLS + (np - (ACOLS + SCP));
}

struct TileListOrder {
    pg8::StaticOrder S; int n0, b0, b1;
    __device__ void init(int M_, int nt, int n0_, int b0_, int b1_, int G_, int c_) { S.init(M_, nt * 256, G_, c_); n0 = n0_; b0 = b0_; b1 = b1_; }
    __device__ bool next(int i, pg8::Unit& u) const { if (!S.next(i, u)) return false; u.pn = (u.pn < n0) ? b0 + u.pn : b1 + (u.pn - n0); return true; }
    __device__ __forceinline__ void a_ready(const pg8::Unit&) const {}
    __device__ __forceinline__ void done(const pg8::Unit&) const {}
};
struct EpiIn {
    static constexpr bool PERM = true, AFTER_DRAIN = false;
    bf16* Q; bf16* Kb; bf16* VT; bf16* SC; bf16* GT; float* out; const float* rope;
    __device__ __forceinline__ void operator()(const pg8::f32x4 (&acc)[2][2][4][2], const pg8::Unit& u, int wr, int wc, int fr, int fq) const {
        const int tn = u.pn;
        const int rowb = u.pm * 256 + wr * 64 + fr;
        if (tn < 18) {
            const int part = tn >> 1, g = part / 3, kind = part - 3 * g, hf = tn & 1;
            const int lgd = 2 * g, dil = 1 << lgd, L = T >> lgd, keep = (g == 0) ? 128 : (g == 1) ? 512 : 2048;
            const size_t okv = (g == 0) ? O_KV1P : (g == 1) ? O_KV2P : O_KV3P;
            const int pos0 = 32 * (wc & 1) + 8 * fq;
#pragma unroll
            for (int ai = 0; ai < 2; ++ai)
#pragma unroll
                for (int m = 0; m < 4; ++m) {
                    const int row = rowb + ai * 128 + m * 16, b = row >> 11, t = row & (T - 1);
                    const int p = (t & (dil - 1)) * L + (t >> lgd);
                    const size_t prow = (size_t)g * M + (size_t)b * T + p;
                    const int tk = t - (T - keep);
                    if (kind < 2) {
                        const int i0 = pos0 >> 1;
                        const pg8::f32x4 cs0 = *(const pg8::f32x4*)(rope + ((size_t)t * 32 + i0) * 2), cs1 = *(const pg8::f32x4*)(rope + ((size_t)t * 32 + i0 + 2) * 2);
#pragma unroll
                        for (int bj = 0; bj < 2; ++bj) {
                            const int head = 4 * hf + 2 * bj + (wc >> 1);
                            const pg8::f32x4 v0 = acc[ai][bj][m][0], v1 = acc[ai][bj][m][1];
                            float o[8];
                            o[0] = v0[0] * cs0[0] - v0[1] * cs0[1]; o[1] = v0[0] * cs0[1] + v0[1] * cs0[0];
                            o[2] = v0[2] * cs0[2] - v0[3] * cs0[3]; o[3] = v0[2] * cs0[3] + v0[3] * cs0[2];
                            o[4] = v1[0] * cs1[0] - v1[1] * cs1[1]; o[5] = v1[0] * cs1[1] + v1[1] * cs1[0];
                            o[6] = v1[2] * cs1[2] - v1[3] * cs1[3]; o[7] = v1[2] * cs1[3] + v1[3] * cs1[2];
                            if (kind == 0) {
                                pg8::u32x4 w; w.x = pg8::cvt_pk_bf16(o[0] * QSCALE, o[1] * QSCALE); w.y = pg8::cvt_pk_bf16(o[2] * QSCALE, o[3] * QSCALE);
                                w.z = pg8::cvt_pk_bf16(o[4] * QSCALE, o[5] * QSCALE); w.w = pg8::cvt_pk_bf16(o[6] * QSCALE, o[7] * QSCALE);
                                *(pg8::u32x4*)(Q + prow * 512 + head * 64 + pos0) = w;
                            } else {
                                pg8::u32x4 w; w.x = pg8::cvt_pk_bf16(o[0], o[1]); w.y = pg8::cvt_pk_bf16(o[2], o[3]); w.z = pg8::cvt_pk_bf16(o[4], o[5]); w.w = pg8::cvt_pk_bf16(o[6], o[7]);
                                *(pg8::u32x4*)(Kb + prow * 512 + head * 64 + pos0) = w;
                                if (tk >= 0) { float* ob = out + okv + (((size_t)b * keep + tk) * 2 + 0) * 512 + head * 64;
                                    *(pg8::f32x4*)(ob + i0) = (pg8::f32x4){o[0], o[2], o[4], o[6]}; *(pg8::f32x4*)(ob + 32 + i0) = (pg8::f32x4){o[1], o[3], o[5], o[7]}; }
                            }
                        }
                    } else {
#pragma unroll
                        for (int bj = 0; bj < 2; ++bj) {
                            const int head = 4 * hf + 2 * bj + (wc >> 1);
                            const pg8::f32x4 v0 = acc[ai][bj][m][0], v1 = acc[ai][bj][m][1];
                            pg8::u32x4 w; w.x = pg8::cvt_pk_bf16(v0[0], v0[1]); w.y = pg8::cvt_pk_bf16(v0[2], v0[3]); w.z = pg8::cvt_pk_bf16(v1[0], v1[1]); w.w = pg8::cvt_pk_bf16(v1[2], v1[3]);
                            *(pg8::u32x4*)(VT + prow * 512 + head * 64 + pos0) = w;
                            if (tk >= 0) { float* ob = out + okv + (((size_t)b * keep + tk) * 2 + 1) * 512 + head * 64 + pos0;
                                *(pg8::f32x4*)(ob) = v0; *(pg8::f32x4*)(ob + 4) = v1; }
                        }
                    }
                }
        } else if (tn < 32) {
            const int cb = (tn - 18) * 256 + wc * 32 + 8 * fq;
#pragma unroll
            for (int ai = 0; ai < 2; ++ai)
#pragma unroll
                for (int m = 0; m < 4; ++m) {
                    const int row = rowb + ai * 128 + m * 16, b = row >> 11, t = row & (T - 1);
#pragma unroll
                    for (int bj = 0; bj < 2; ++bj) {
                        const int col = cb + bj * 128;
                        const pg8::f32x4 v0 = acc[ai][bj][m][0], v1 = acc[ai][bj][m][1];
                        pg8::u32x4 w; w.x = pg8::cvt_pk_bf16(v0[0], v0[1]); w.y = pg8::cvt_pk_bf16(v0[2], v0[3]); w.z = pg8::cvt_pk_bf16(v1[0], v1[1]); w.w = pg8::cvt_pk_bf16(v1[2], v1[3]);
                        *(pg8::u32x4*)(SC + (size_t)row * SCP + col) = w;
                        if (t == T - 1 && col < SCOLS) { float* ob = out + O_SHP + (size_t)b * SCOLS + col; *(pg8::f32x4*)(ob) = v0; *(pg8::f32x4*)(ob + 4) = v1; }
                    }
                }
        } else {
            const int cb = (tn - 32) * 256 + wc * 32 + 8 * fq;
#pragma unroll
            for (int ai = 0; ai < 2; ++ai)
#pragma unroll
                for (int m = 0; m < 4; ++m) {
                    const int row = rowb + ai * 128 + m * 16;
#pragma unroll
                    for (int bj = 0; bj < 2; ++bj) {
                        const int col = cb + bj * 128;
                        const pg8::f32x4 v0 = acc[ai][bj][m][0], v1 = acc[ai][bj][m][1];
                        pg8::u32x4 w; w.x = pg8::cvt_pk_bf16(sigmoidf_(v0[0]), sigmoidf_(v0[1])); w.y = pg8::cvt_pk_bf16(sigmoidf_(v0[2]), sigmoidf_(v0[3]));
                        w.z = pg8::cvt_pk_bf16(sigmoidf_(v1[0]), sigmoidf_(v1[1])); w.w = pg8::cvt_pk_bf16(sigmoidf_(v1[2]), sigmoidf_(v1[3]));
                        *(pg8::u32x4*)(GT + (size_t)row * 2048 + col) = w;
                    }
                }
        }
    }
};

__device__ __forceinline__ int opaque_int(int v) { asm volatile("" : "+s"(v)); return v; }
struct Frame {
    LAS unsigned char* lds; volatile LAS unsigned* MISC; gu32* ctl;
    int tid, lane, wave, vcu, G, gw, NGW;
};

__device__ __forceinline__ void p0_prologue(const Frame& F, const Args& a, unsigned char* ws) {
    LAS float* scr = (LAS float*)(F.lds + RING_OFF + F.wave * 16384);
    const int gw = F.gw, NGW = F.NGW, lane = F.lane;
    constexpr int IT_WIN = 16 * (INP / 32), IT_WA = 8 * 32, IT_WB = 16 * 32, IT_WO = 16 * 32, IT_WGU = 16 * (GU / 32), IT_WD = 44 * 32, IT_WWA = 2 * 64, IT_WG = 4 * 32;
    constexpr int NITEMS = IT_WIN + IT_WA + IT_WB + IT_WO + IT_WGU + IT_WD + IT_WWA + IT_WG;
    for (int it = gw; it < NITEMS; it += NGW) {
        int r = it;
        if (r < IT_WIN) { const int nb = r % (INP / 32), kb = r / (INP / 32); const float* W = a.in[I_WIN];
            tr_item([&](int k, int np) { const int sc = win_src_col(np); return sc >= 0 ? W[(size_t)k * INCOLS + sc] : 0.f; }, (bf16*)(ws + WS_WIN), DM, scr, 64 * kb, 32 * nb, lane); continue; }
        r -= IT_WIN;
        if (r < IT_WA) { const int nb = r % 32, kb = r / 32; const float* W = a.in[I_WPA];
            tr_item([&](int k, int n) { return W[(size_t)k * DM + n]; }, (bf16*)(ws + WS_WA), AWID, scr, 64 * kb, 32 * nb, lane); continue; }
        r -= IT_WA;
        if (r < IT_WB) { const int nb = r % 32, kb = r / 32; const float* W = a.in[I_WPB];
            tr_item([&](int k, int n) { return W[(size_t)k * DM + n]; }, (bf16*)(ws + WS_WB), BWID, scr, 64 * kb, 32 * nb, lane); continue; }
        r -= IT_WB;
        if (r < IT_WO) { const int nb = r % 32, kb = r / 32; const float* W = a.in[I_WOUT];
            tr_item([&](int k, int n) { return W[(size_t)k * DM + n]; }, (bf16*)(ws + WS_WO), DM, scr, 64 * kb, 32 * nb, lane); continue; }
        r -= IT_WO;
        if (r < IT_WGU) { const int nb = r % (GU / 32), kb = r / (GU / 32); const int n0 = 32 * nb, tile = n0 >> 8, w0 = n0 & 255;
            const float* W = (w0 < 128) ? a.in[I_WGATE] : a.in[I_WUP]; const float* gsc = a.in[I_NFFN]; const int cbase = tile * 128 + (w0 & 127) - n0;
            tr_item([&](int k, int np) { return W[(size_t)k * DFF + cbase + np] * gsc[k]; }, (bf16*)(ws + WS_WGU), DM, scr, 64 * kb, n0, lane); continue; }
        r -= IT_WGU;
        if (r < IT_WD) { const int nb = r % 32, kb = r / 32; const float* W = a.in[I_WDOWN];
            tr_item([&](int k, int n) { return W[(size_t)k * DM + n]; }, (bf16*)(ws + WS_WD), DFF, scr, 64 * kb, 32 * nb, lane); continue; }
        r -= IT_WD;
        if (r < IT_WWA) { const int nb = r % 64, kb = r / 64; const float* W2 = a.in[I_W2]; const float* A2 = a.in[I_A2];
            tr_item([&](int k, int n) { return (n < 1024) ? (k < 64 ? W2[(size_t)k * BWID + n] : 0.f) : (k >= 64 ? A2[(size_t)(k - 64) * BWID + (n - 1024)] : 0.f); }, (bf16*)(ws + WS_WWA), 128, scr, 64 * kb, 32 * nb, lane); continue; }
        r -= IT_WWA;
        { const int nb = r % 32, kb = r / 32; const float* G2 = a.in[I_G2];
            tr_item([&](int k, int n) { return k < 160 ? G2[(size_t)k * BWID + n] : 0.f; }, (bf16*)(ws + WS_WG), 256, scr, 64 * kb, 32 * nb, lane); }
    }
    {
        const float* gmix = a.in[I_NMIX];
        f32x4 gv[4];
#pragma unroll
        for (int j = 0; j < 4; ++j) gv[j] = *(const f32x4*)(gmix + 4 * lane + 256 * j);
        for (int m = gw; m < M + SB; m += NGW) {
            const float* xrow = (m < M) ? a.in[I_XP] + (size_t)m * DM : a.in[I_XS] + (size_t)(m - M) * DM;
            bf16* orow = (m < M) ? (bf16*)(ws + WS_XN) + (size_t)m * DM : (bf16*)(ws + WS_SMP + SM_HSN) + (size_t)(m - M) * DM;
            const GAS f32x4* xr = (const GAS f32x4*)xrow + lane;
            f32x4 v[4]; float s = 0.f;
#pragma unroll
            for (int j = 0; j < 4; ++j) { v[j] = xr[64 * j]; s += (v[j].x * v[j].x + v[j].y * v[j].y) + (v[j].z * v[j].z + v[j].w * v[j].w); }
            const float rstd = 1.0f / sqrtf(wave_sum(s) * (1.f / DM) + NORM_EPS);
            GAS unsigned long long* o8 = (GAS unsigned long long*)orow + lane;
#pragma unroll
            for (int j = 0; j < 4; ++j) { const f32x4 y = v[j] * rstd * gv[j]; o8[64 * j] = (unsigned long long)pk2(y.x, y.y) | ((unsigned long long)pk2(y.z, y.w) << 32); }
        }
    }
    {
        float* tab = (float*)(ws + WS_TAB);
        for (int e = F.vcu * 512 + F.tid; e < 2049 * 32; e += F.G * 512) {
            const int pi = e >> 5, i = e & 31; const float pos = (pi < 2048) ? (float)pi : (float)PAST;
            const float ang = pos * ROPE_FREQ[i]; float s, c; sincos_acc(ang, s, c);
            *(f32x2*)(tab + 2 * (size_t)e) = (f32x2){c, s};
        }
    }
    {
        float* ss = (float*)(ws + WS_SS);
        for (int e = F.vcu * 512 + F.tid; e < 65536; e += F.G * 512) ss[e] = 0.f;
    }
}


typedef float f32x16 __attribute__((ext_vector_type(16)));
__device__ __forceinline__ float dpp_f(float v, const int ctrl_sel) {
    const int x = __builtin_bit_cast(int, v); int r;
    if (ctrl_sel == 0) r = __builtin_amdgcn_update_dpp(0, x, 0xB1, 0xF, 0xF, true);
    else if (ctrl_sel == 1) r = __builtin_amdgcn_update_dpp(0, x, 0x4E, 0xF, 0xF, true);
    else if (ctrl_sel == 2) r = __builtin_amdgcn_update_dpp(0, x, 0x141, 0xF, 0xF, true);
    else r = __builtin_amdgcn_update_dpp(0, x, 0x140, 0xF, 0xF, true);
    return __builtin_bit_cast(float, r);
}
__device__ __forceinline__ float red4(float v) { v += dpp_f(v, 0); v += dpp_f(v, 1); return v; }
__device__ __forceinline__ float red8(float v) { v = red4(v); v += dpp_f(v, 2); return v; }
__device__ __forceinline__ float red16(float v) { v = red8(v); v += dpp_f(v, 3); return v; }
__device__ __forceinline__ float fma_s(float a, float b, float c) { float r; asm("v_fma_f32 %0, %1, %2, %3" : "=v"(r) : "v"(a), "v"(b), "v"(c)); return r; }
__device__ __forceinline__ float mul_s(float a, float b) { float r; asm("v_mul_f32 %0, %1, %2" : "=v"(r) : "v"(a), "v"(b)); return r; }
__device__ __forceinline__ void red16x2(float& a, float& b) {
    a += dpp_f(a, 0); b += dpp_f(b, 0); a += dpp_f(a, 1); b += dpp_f(b, 1); a += dpp_f(a, 2); b += dpp_f(b, 2); a += dpp_f(a, 3); b += dpp_f(b, 3);
}
__device__ __forceinline__ void red8x2(float& a, float& b) {
    a += dpp_f(a, 0); b += dpp_f(b, 0); a += dpp_f(a, 1); b += dpp_f(b, 1); a += dpp_f(a, 2); b += dpp_f(b, 2);
}
__device__ __forceinline__ float tanh_(float x) { return 1.0f - 2.0f / (1.0f + __expf(2.0f * x)); }
typedef float f32x2_t __attribute__((ext_vector_type(2))); typedef __bf16 bf16x2_t __attribute__((ext_vector_type(2)));
__device__ __forceinline__ unsigned cvtpk_s(float lo, float hi) { f32x2_t v = {lo, hi}; bf16x2_t b = __builtin_convertvector(v, bf16x2_t); return __builtin_bit_cast(unsigned, b); }
__device__ __forceinline__ bf16x8 pack8(const float* p) {
    v4u w; w.x = cvtpk_s(p[0], p[1]); w.y = cvtpk_s(p[2], p[3]); w.z = cvtpk_s(p[4], p[5]); w.w = cvtpk_s(p[6], p[7]);
    return __builtin_bit_cast(bf16x8, w);
}

typedef short v4i16_t __attribute__((ext_vector_type(4)));
__device__ __forceinline__ void attn_unit(int g, int b, int head, int qt, const bf16* Qb, const bf16* Kb, const bf16* VT, bf16* OG, float* LSE, int lane, LAS unsigned char* vl) {
    const int lgd = 2 * g, dil = 1 << lgd, L = T >> lgd;
    const int p0 = qt * 32, r = p0 >> (11 - lgd), u0 = p0 & (L - 1);
    const int q = lane & 31, h = lane >> 5;
    const size_t rb = ((size_t)g * M + (size_t)b * T) * 512 + head * 64;
    const bf16* Qg = Qb + rb; const bf16* Kg = Kb + rb;
    const bf16* Vg = VT + rb;
    bf16x8 qf[4];
#pragma unroll
    for (int ks = 0; ks < 4; ++ks) qf[ks] = *(const bf16x8*)(Qg + (size_t)(p0 + q) * 512 + 16 * ks + 8 * h);
    const int kt0 = (u0 >= 128) ? 0 : 4 - (u0 >> 5);
    const int kbase = r * L + u0 - 128;
    f32x16 s[5];
#pragma unroll
    for (int kt = 0; kt < 5; ++kt) {
        if (kt >= kt0) {
            f32x16 acc = {};
            const bf16* kp = Kg + (size_t)(kbase + 32 * kt + q) * 512 + 8 * h;
#pragma unroll
            for (int ks = 0; ks < 4; ++ks) { const bf16x8 kf = *(const bf16x8*)(kp + 16 * ks); acc = __builtin_amdgcn_mfma_f32_32x32x16_bf16(kf, qf[ks], acc, 0, 0, 0); }
            if (kt == 0) {
#pragma unroll
                for (int rg = 0; rg < 16; ++rg) { const int krow = (rg & 3) + 8 * (rg >> 2) + 4 * h; if (krow < q) acc[rg] = -INFINITY; }
            }
            if (kt == 4) {
#pragma unroll
                for (int rg = 0; rg < 16; ++rg) { const int krow = (rg & 3) + 8 * (rg >> 2) + 4 * h; if (krow > q) acc[rg] = -INFINITY; }
            }
            s[kt] = acc;
        } else {
#pragma unroll
            for (int rg = 0; rg < 16; ++rg) s[kt][rg] = -INFINITY;
        }
    }
    float mx = -INFINITY;
#pragma unroll
    for (int kt = 0; kt < 5; ++kt)
#pragma unroll
        for (int rg = 0; rg < 16; ++rg) mx = fmaxf(mx, s[kt][rg]);
    mx = fmaxf(mx, __shfl_xor(mx, 32));
    float l = 0.f;
#pragma unroll
    for (int kt = 0; kt < 5; ++kt)
#pragma unroll
        for (int rg = 0; rg < 16; ++rg) { const float p = __builtin_amdgcn_exp2f(s[kt][rg] - mx); s[kt][rg] = p; l += p; }
    l += __shfl_xor(l, 32);
    f32x16 o0 = {}, o1 = {};
#pragma unroll
    for (int kt = 0; kt < 5; ++kt) {
        if (kt >= kt0) {
            {
                const bf16* vsrc = Vg + (size_t)(kbase + 32 * kt + (lane >> 3)) * 512 + (lane & 7) * 8;
#pragma unroll
                for (int i = 0; i < 4; ++i) { const v4u t = *(const v4u*)(vsrc + (size_t)(8 * i) * 512); *(LAS v4u*)(vl + ((lane >> 3) + 8 * i) * 192 + (lane & 7) * 16) = t; }
            }
#pragma unroll
            for (int si = 0; si < 2; ++si) {
                float pp[8];
#pragma unroll
                for (int j = 0; j < 8; ++j) pp[j] = s[kt][8 * si + j];
                const bf16x8 pb = pack8(pp);
                const int gi = lane >> 4, i16 = lane & 15;
                LAS unsigned char* tb = vl + (16 * si + 4 * (gi >> 1) + (i16 >> 2)) * 192 + (16 * (gi & 1) + 4 * (i16 & 3)) * 2;
                const v4i16_t a0 = __builtin_amdgcn_ds_read_tr16_b64_v4i16((LAS v4i16_t*)(tb));
                const v4i16_t a1 = __builtin_amdgcn_ds_read_tr16_b64_v4i16((LAS v4i16_t*)(tb + 8 * 192));
                const v4i16_t c0 = __builtin_amdgcn_ds_read_tr16_b64_v4i16((LAS v4i16_t*)(tb + 64));
                const v4i16_t c1 = __builtin_amdgcn_ds_read_tr16_b64_v4i16((LAS v4i16_t*)(tb + 8 * 192 + 64));
                const bf16x8 va = {a0[0], a0[1], a0[2], a0[3], a1[0], a1[1], a1[2], a1[3]}, vc = {c0[0], c0[1], c0[2], c0[3], c1[0], c1[1], c1[2], c1[3]};
                o0 = __builtin_amdgcn_mfma_f32_32x32x16_bf16(va, pb, o0, 0, 0, 0);
                o1 = __builtin_amdgcn_mfma_f32_32x32x16_bf16(vc, pb, o1, 0, 0, 0);
            }
        }
    }
    const float inv = 1.0f / l;
    const int t = r + dil * (u0 + q);
    bf16* op = OG + ((size_t)g * M + (size_t)b * T + t) * 512 + head * 64 + 4 * h;
#pragma unroll
    for (int rg = 0; rg < 4; ++rg) {
        u32x2 w; w.x = pg8::cvt_pk_bf16(o0[4 * rg] * inv, o0[4 * rg + 1] * inv); w.y = pg8::cvt_pk_bf16(o0[4 * rg + 2] * inv, o0[4 * rg + 3] * inv);
        *(u32x2*)(op + 8 * rg) = w;
        u32x2 w2; w2.x = pg8::cvt_pk_bf16(o1[4 * rg] * inv, o1[4 * rg + 1] * inv); w2.y = pg8::cvt_pk_bf16(o1[4 * rg + 2] * inv, o1[4 * rg + 3] * inv);
        *(u32x2*)(op + 32 + 8 * rg) = w2;
    }
    if (h == 0) LSE[((size_t)g * M + (size_t)b * T + t) * 8 + head] = (mx + __builtin_amdgcn_logf(l)) * LN2;
}

__device__ __forceinline__ void r1_rows(const Frame& F, const bf16* SC, const float* mu, bf16* A1, bf16* A2) {
    float mul[6];
#pragma unroll
    for (int i = 0; i < 6; ++i) { const int e = F.lane + 64 * i; mul[i] = (e < 288) ? mu[3072 + e] : 0.f; }
    for (int m = F.gw; m < M; m += F.NGW) {
        const int t = m & (T - 1);
        const bf16* p = SC + (size_t)m * SCP + 3072;
#pragma unroll
        for (int i = 0; i < 6; ++i) {
            const int e = F.lane + 64 * i;
            if (e < 288) {
                const float x = bf2f(p[e]); const float xp = (t > 0) ? bf2f(p[e - SCP]) : 0.f;
                const float xm = x + (xp - x) * mul[i];
                if (e < 64) A1[(size_t)m * 128 + e] = (bf16)f2bf(tanh_(xm));
                else if (e < 128) A1[(size_t)m * 128 + e] = (bf16)f2bf(xm);
                else A2[(size_t)m * 256 + (e - 128)] = (bf16)f2bf(sigmoidf_(xm));
            } else A2[(size_t)m * 256 + (e - 128)] = 0;
        }
    }
}

__device__ __forceinline__ void attn_item(const Frame& F, int item, const bf16* Qb, const bf16* Kb, const bf16* VT, bf16* OG, float* LSE, bf16* OA) {
    const int b = item >> 5, head = (item >> 2) & 7, tb = item & 3;
#pragma unroll 1
    for (int i = 0; i < 6; ++i) {
        const int u = F.wave + 8 * i, g = u >> 4, q = u & 15;
        const int qt = (g == 0) ? (16 * tb + q) : (g == 1) ? ((q >> 2) * 16 + 4 * tb + (q & 3)) : (q * 4 + tb);
        attn_unit(g, b, head, qt, Qb, Kb, VT, OG, LSE, F.lane, F.lds + RING_OFF + F.wave * 8192);
    }
    VM_WAIT(); __syncthreads();
    for (int it = F.tid; it < 512 * 8; it += 512) {
        const int m = b * T + tb * 512 + (it >> 3), cg = head * 8 + (it & 7);
        const float l0 = LSE[(size_t)m * 8 + head], l1 = LSE[((size_t)M + m) * 8 + head], l2 = LSE[((size_t)2 * M + m) * 8 + head];
        const float mx = fmaxf(l0, fmaxf(l1, l2));
        float e0 = __expf(l0 - mx), e1 = __expf(l1 - mx), e2 = __expf(l2 - mx); const float inv = 1.0f / (e0 + e1 + e2); e0 *= inv; e1 *= inv; e2 *= inv;
        const v4u a = *(const v4u*)(OG + (size_t)m * 512 + cg * 8), bb = *(const v4u*)(OG + ((size_t)M + m) * 512 + cg * 8), c = *(const v4u*)(OG + ((size_t)2 * M + m) * 512 + cg * 8);
        v4u o;
        o.x = pg8::cvt_pk_bf16(e0 * bflo(a.x) + e1 * bflo(bb.x) + e2 * bflo(c.x), e0 * bfhi(a.x) + e1 * bfhi(bb.x) + e2 * bfhi(c.x));
        o.y = pg8::cvt_pk_bf16(e0 * bflo(a.y) + e1 * bflo(bb.y) + e2 * bflo(c.y), e0 * bfhi(a.y) + e1 * bfhi(bb.y) + e2 * bfhi(c.y));
        o.z = pg8::cvt_pk_bf16(e0 * bflo(a.z) + e1 * bflo(bb.z) + e2 * bflo(c.z), e0 * bfhi(a.z) + e1 * bfhi(bb.z) + e2 * bfhi(c.z));
        o.w = pg8::cvt_pk_bf16(e0 * bflo(a.w) + e1 * bflo(bb.w) + e2 * bflo(c.w), e0 * bfhi(a.w) + e1 * bfhi(bb.w) + e2 * bfhi(c.w));
        *(v4u*)(OA + (size_t)m * 512 + cg * 8) = o;
    }
    __syncthreads();
}
__device__ __forceinline__ void combine_groups(const Frame& F, const bf16* OG, const float* LSE, bf16* OA) {
    for (int it = F.vcu * 512 + F.tid; it < M * 64; it += F.G * 512) {
        const int m = it >> 6, cg = it & 63, head = cg >> 3;
        const float l0 = LSE[(size_t)m * 8 + head], l1 = LSE[((size_t)M + m) * 8 + head], l2 = LSE[((size_t)2 * M + m) * 8 + head];
        const float mx = fmaxf(l0, fmaxf(l1, l2));
        float e0 = __expf(l0 - mx), e1 = __expf(l1 - mx), e2 = __expf(l2 - mx); const float inv = 1.0f / (e0 + e1 + e2); e0 *= inv; e1 *= inv; e2 *= inv;
        const v4u a = *(const v4u*)(OG + (size_t)m * 512 + cg * 8), b = *(const v4u*)(OG + ((size_t)M + m) * 512 + cg * 8), c = *(const v4u*)(OG + ((size_t)2 * M + m) * 512 + cg * 8);
        v4u o;
        o.x = pg8::cvt_pk_bf16(e0 * bflo(a.x) + e1 * bflo(b.x) + e2 * bflo(c.x), e0 * bfhi(a.x) + e1 * bfhi(b.x) + e2 * bfhi(c.x));
        o.y = pg8::cvt_pk_bf16(e0 * bflo(a.y) + e1 * bflo(b.y) + e2 * bflo(c.y), e0 * bfhi(a.y) + e1 * bfhi(b.y) + e2 * bfhi(c.y));
        o.z = pg8::cvt_pk_bf16(e0 * bflo(a.z) + e1 * bflo(b.z) + e2 * bflo(c.z), e0 * bfhi(a.z) + e1 * bfhi(b.z) + e2 * bfhi(c.z));
        o.w = pg8::cvt_pk_bf16(e0 * bflo(a.w) + e1 * bflo(b.w) + e2 * bflo(c.w), e0 * bfhi(a.w) + e1 * bfhi(b.w) + e2 * bfhi(c.w));
        *(v4u*)(OA + (size_t)m * 512 + cg * 8) = o;
    }
}

struct EpiWA {
    static constexpr bool PERM = true, AFTER_DRAIN = false;
    float* LW; bf16* AV; const float* w0; const float* a0;
    __device__ __forceinline__ void operator()(const pg8::f32x4 (&acc)[2][2][4][2], const pg8::Unit& u, int wr, int wc, int fr, int fq) const {
        const bool isw = u.pn < 4; const int cb = (u.pn & 3) * 256 + wc * 32 + 8 * fq; const float* bias = isw ? w0 : a0;
#pragma unroll
        for (int bj = 0; bj < 2; ++bj) {
            const int col = cb + bj * 128; const f32x4 b0 = *(const f32x4*)(bias + col), b1 = *(const f32x4*)(bias + col + 4);
#pragma unroll
            for (int ai = 0; ai < 2; ++ai)
#pragma unroll
                for (int m = 0; m < 4; ++m) {
                    const int row = u.pm * 256 + wr * 64 + fr + ai * 128 + m * 16;
                    const pg8::f32x4 v0 = acc[ai][bj][m][0], v1 = acc[ai][bj][m][1];
                    float e[8] = {sigmoidf_(v0[0] + b0[0]), sigmoidf_(v0[1] + b0[1]), sigmoidf_(v0[2] + b0[2]), sigmoidf_(v0[3] + b0[3]), sigmoidf_(v1[0] + b1[0]), sigmoidf_(v1[1] + b1[1]), sigmoidf_(v1[2] + b1[2]), sigmoidf_(v1[3] + b1[3])};
                    if (isw) {
#pragma unroll
                        for (int q = 0; q < 8; ++q) { float x = e[q] * -0.60653065971263342f;
                            x += __builtin_bit_cast(float, __builtin_amdgcn_update_dpp(0, __builtin_bit_cast(int, x), 0x111, 0xF, 0xF, true));
                            x += __builtin_bit_cast(float, __builtin_amdgcn_update_dpp(0, __builtin_bit_cast(int, x), 0x112, 0xF, 0xF, true));
                            x += __builtin_bit_cast(float, __builtin_amdgcn_update_dpp(0, __builtin_bit_cast(int, x), 0x114, 0xF, 0xF, true));
                            x += __builtin_bit_cast(float, __builtin_amdgcn_update_dpp(0, __builtin_bit_cast(int, x), 0x118, 0xF, 0xF, true));
                            e[q] = x; }
                        *(f32x4*)(LW + (size_t)row * 1024 + col) = (f32x4){e[0], e[1], e[2], e[3]}; *(f32x4*)(LW + (size_t)row * 1024 + col + 4) = (f32x4){e[4], e[5], e[6], e[7]};
                    } else {
                        pg8::u32x4 w; w.x = pg8::cvt_pk_bf16(e[0], e[1]); w.y = pg8::cvt_pk_bf16(e[2], e[3]); w.z = pg8::cvt_pk_bf16(e[4], e[5]); w.w = pg8::cvt_pk_bf16(e[6], e[7]);
                        *(pg8::u32x4*)(AV + (size_t)row * 1024 + col) = w;
                    }
                }
        }
    }
};
struct EpiPlain {
    static constexpr bool PERM = true, AFTER_DRAIN = false;
    bf16* O; int ldc;
    __device__ __forceinline__ void operator()(const pg8::f32x4 (&acc)[2][2][4][2], const pg8::Unit& u, int wr, int wc, int fr, int fq) const {
        const int cb = u.pn * 256 + wc * 32 + 8 * fq;
#pragma unroll
        for (int ai = 0; ai < 2; ++ai)
#pragma unroll
            for (int m = 0; m < 4; ++m) {
                const int row = u.pm * 256 + wr * 64 + fr + ai * 128 + m * 16;
#pragma unroll
                for (int bj = 0; bj < 2; ++bj) {
                    const pg8::f32x4 v0 = acc[ai][bj][m][0], v1 = acc[ai][bj][m][1];
                    pg8::u32x4 w; w.x = pg8::cvt_pk_bf16(v0[0], v0[1]); w.y = pg8::cvt_pk_bf16(v0[2], v0[3]); w.z = pg8::cvt_pk_bf16(v1[0], v1[1]); w.w = pg8::cvt_pk_bf16(v1[2], v1[3]);
                    *(pg8::u32x4*)(O + (size_t)row * ldc + cb + bj * 128) = w;
                }
            }
    }
};

struct ScanRegs { u32x2 pr, pk, pv, qr, qk, qv, e4, a4; };
__device__ __forceinline__ void scan_load(ScanRegs& R, const bf16* SC, const bf16* E, const bf16* AV, int b, int t, int cr) {
    const size_t m = (size_t)b * T + t; const bf16* p = SC + m * SCP + cr;
    R.pr = *(const u32x2*)(p); R.pk = *(const u32x2*)(p + 1024); R.pv = *(const u32x2*)(p + 2048);
    if (t > 0) { R.qr = *(const u32x2*)(p - SCP); R.qk = *(const u32x2*)(p - SCP + 1024); R.qv = *(const u32x2*)(p - SCP + 2048); }
    else { R.qr = (u32x2){0u, 0u}; R.qk = (u32x2){0u, 0u}; R.qv = (u32x2){0u, 0u}; }
    R.e4 = *(const u32x2*)(E + m * 1024 + cr); R.a4 = *(const u32x2*)(AV + m * 1024 + cr);
}
__device__ __forceinline__ f32x4 bf4(u32x2 w) { return (f32x4){bflo(w.x), bfhi(w.x), bflo(w.y), bfhi(w.y)}; }
__device__ __forceinline__ void scan_phase(const Frame& F, const Args& a, unsigned char* ws, int first, int stride) {
    const bf16* SC = (const bf16*)(ws + WS_SC); const bf16* E = (const bf16*)(ws + WS_E); const bf16* AV = (const bf16*)(ws + WS_AV);
    float* Y = (float*)(ws + WS_Y); float* CB = (float*)(ws + WS_CB);
    LAS float* L = (LAS float*)(F.lds + RING_OFF); LAS float* YB = (LAS float*)(F.lds + RING_OFF + 49152);
    const int tid = F.tid, lane = F.lane, wave = F.wave;
    for (int chain = first; chain < NB * BHEADS; chain += stride) {
        const int b = chain >> 4, head = chain & 15;
        const int ss = tid >> 4, j4 = (tid & 15) * 4, cr = head * 64 + j4;
        const f32x4 mur = *(const f32x4*)(a.in[I_MU] + cr), muk = *(const f32x4*)(a.in[I_MU] + 1024 + cr), muv = *(const f32x4*)(a.in[I_MU] + 2048 + cr);
        const f32x4 kkw = *(const f32x4*)(a.in[I_KK] + cr), kaw = *(const f32x4*)(a.in[I_KA] + cr), rkw = *(const f32x4*)(a.in[I_RK] + cr);
        const int rloc8 = 8 * wave + (lane >> 3), c8 = (lane & 7) * 8;
        f32x4 Sa = {0.f, 0.f, 0.f, 0.f}, Sb = {0.f, 0.f, 0.f, 0.f};
        ScanRegs cur, nxt; scan_load(cur, SC, E, AV, b, ss, cr);
        for (int ch = 0; ch < T / 32; ++ch) {
            const int t0 = ch * 32;
            if (ch + 1 < T / 32) scan_load(nxt, SC, E, AV, b, t0 + 32 + ss, cr); else nxt = cur;
            {
                const f32x4 pr = bf4(cur.pr), pk = bf4(cur.pk), pv = bf4(cur.pv), qr = bf4(cur.qr), qk = bf4(cur.qk), qv = bf4(cur.qv);
                const f32x4 r = pr + (qr - pr) * mur, k = pk + (qk - pk) * muk, v = pv + (qv - pv) * muv;
                const f32x4 ev = bf4(cur.e4), av = bf4(cur.a4);
                f32x4 w; w[0] = __expf(-ev[0]); w[1] = __expf(-ev[1]); w[2] = __expf(-ev[2]); w[3] = __expf(-ev[3]);
                const f32x4 kr = k * kkw;
                const float n2 = red16((kr[0] * kr[0] + kr[1] * kr[1]) + (kr[2] * kr[2] + kr[3] * kr[3]));
                const float rn = 1.0f / fmaxf(sqrtf(n2), 1e-12f);
                const f32x4 kk = kr * rn;
                const f32x4 kp = k * (1.0f + (av - 1.0f) * kaw);
                const f32x4 bb = kk * av;
                const f32x4 rkk = r * kp * rkw;
                const float cb = red16((rkk[0] + rkk[1]) + (rkk[2] + rkk[3]));
                LAS float* d = L + ss * 384 + j4;
                *(LAS f32x4*)(d) = w; *(LAS f32x4*)(d + 64) = kk; *(LAS f32x4*)(d + 128) = bb; *(LAS f32x4*)(d + 192) = kp; *(LAS f32x4*)(d + 256) = r; *(LAS f32x4*)(d + 320) = v;
                if ((tid & 15) == 0) CB[((size_t)b * T + t0 + ss) * 16 + head] = cb;
            }
            __syncthreads();
            {
                const int k8 = lane & 7;
                const LAS float* d0 = L + k8 * 8; const LAS float* dv = L + 320 + rloc8;
                f32x4 w0 = *(const LAS f32x4*)(d0), w1 = *(const LAS f32x4*)(d0 + 4), kka = *(const LAS f32x4*)(d0 + 64), kkb = *(const LAS f32x4*)(d0 + 68), bba = *(const LAS f32x4*)(d0 + 128), bbb = *(const LAS f32x4*)(d0 + 132),
                      kpa = *(const LAS f32x4*)(d0 + 192), kpb = *(const LAS f32x4*)(d0 + 196), ra = *(const LAS f32x4*)(d0 + 256), rb = *(const LAS f32x4*)(d0 + 260);
                float vi = dv[0];
                float py = 0.f, yk0 = 0.f, yk1 = 0.f, yk2 = 0.f, yk3 = 0.f;
#pragma unroll
                for (int si = 0; si < 32; ++si) {
                    const int sn = (si + 1 < 32) ? (si + 1) : 31;
                    const LAS float* d = d0 + sn * 384;
                    const f32x4 w0n = *(const LAS f32x4*)(d), w1n = *(const LAS f32x4*)(d + 4), kkan = *(const LAS f32x4*)(d + 64), kkbn = *(const LAS f32x4*)(d + 68), bban = *(const LAS f32x4*)(d + 128), bbbn = *(const LAS f32x4*)(d + 132),
                                kpan = *(const LAS f32x4*)(d + 192), kpbn = *(const LAS f32x4*)(d + 196), ran = *(const LAS f32x4*)(d + 256), rbn = *(const LAS f32x4*)(d + 260);
                    const float vin = dv[sn * 384];
                    const f32x4 pa = Sa * kka + Sb * kkb;
                    float ps = (pa[0] + pa[1]) + (pa[2] + pa[3]);
                    red8x2(ps, py);
                    if (si > 0) { const int q = si - 1; if (q < 8) yk0 = (k8 == q) ? py : yk0; else if (q < 16) yk1 = (k8 == q - 8) ? py : yk1; else if (q < 24) yk2 = (k8 == q - 16) ? py : yk2; else yk3 = (k8 == q - 24) ? py : yk3; }
                    const float sa = -ps;
                    Sa = Sa * w0 + (sa * bba + vi * kpa); Sb = Sb * w1 + (sa * bbb + vi * kpb);
                    const f32x4 pb = Sa * ra + Sb * rb;
                    py = (pb[0] + pb[1]) + (pb[2] + pb[3]);
                    w0 = w0n; w1 = w1n; kka = kkan; kkb = kkbn; bba = bban; bbb = bbbn; kpa = kpan; kpb = kpbn; ra = ran; rb = rbn; vi = vin;
                }
                py = red8(py); yk3 = (k8 == 7) ? py : yk3;
                YB[k8 * 64 + rloc8] = yk0; YB[(8 + k8) * 64 + rloc8] = yk1; YB[(16 + k8) * 64 + rloc8] = yk2; YB[(24 + k8) * 64 + rloc8] = yk3;
            }
            __syncthreads();
            {
                const f32x4 yv = *(const LAS f32x4*)(YB + ss * 64 + j4);
                *(f32x4*)(Y + ((size_t)b * T + t0 + ss) * 1024 + head * 64 + j4) = yv;
            }
            cur = nxt;
        }
        { float* so = a.out + O_WKVP + (((size_t)b * 16 + head) * 64 + rloc8) * 64 + c8; *(f32x4*)(so) = Sa; *(f32x4*)(so + 4) = Sb; }
        __syncthreads();
    }
}

__device__ __forceinline__ void r3_rows(const Frame& F, const Args& a, unsigned char* ws) {
    const bf16* SC = (const bf16*)(ws + WS_SC); const bf16* GATE = (const bf16*)(ws + WS_GATE); const float* Y = (const float*)(ws + WS_Y); const float* CB = (const float*)(ws + WS_CB);
    bf16* OB = (bf16*)(ws + WS_OB);
    const int lane = F.lane, c0 = 16 * lane, head = lane >> 2;
    f32x4 gw[4], gb[4], mv[4];
#pragma unroll
    for (int j = 0; j < 4; ++j) { gw[j] = *(const f32x4*)(a.in[I_GNW] + c0 + 4 * j); gb[j] = *(const f32x4*)(a.in[I_GNB] + c0 + 4 * j); mv[j] = *(const f32x4*)(a.in[I_MU] + 2048 + c0 + 4 * j); }
    for (int m = F.gw; m < M; m += F.NGW) {
        const int t = m & (T - 1);
        f32x4 y[4]; float s = 0.f;
#pragma unroll
        for (int j = 0; j < 4; ++j) { y[j] = *(const f32x4*)(Y + (size_t)m * 1024 + c0 + 4 * j); s += (y[j][0] + y[j][1]) + (y[j][2] + y[j][3]); }
        const float mean = red4(s) * (1.0f / 64.0f); float q = 0.f;
#pragma unroll
        for (int j = 0; j < 4; ++j) { y[j] = y[j] - mean; q += (y[j][0] * y[j][0] + y[j][1] * y[j][1]) + (y[j][2] * y[j][2] + y[j][3] * y[j][3]); }
        const float rs = 1.0f / sqrtf(red4(q) * (1.0f / 64.0f) + GN_EPS);
        const float cb = CB[(size_t)m * 16 + head];
        const bf16* p = SC + (size_t)m * SCP + 2048 + c0;
        const v4u p0 = *(const v4u*)(p), p1 = *(const v4u*)(p + 8);
        v4u q0 = {0u, 0u, 0u, 0u}, q1 = {0u, 0u, 0u, 0u};
        if (t > 0) { q0 = *(const v4u*)(p - SCP); q1 = *(const v4u*)(p - SCP + 8); }
        const v4u g0 = *(const v4u*)(GATE + (size_t)m * 1024 + c0), g1 = *(const v4u*)(GATE + (size_t)m * 1024 + c0 + 8);
        const unsigned pw[8] = {p0.x, p0.y, p0.z, p0.w, p1.x, p1.y, p1.z, p1.w}, qw[8] = {q0.x, q0.y, q0.z, q0.w, q1.x, q1.y, q1.z, q1.w}, gw8[8] = {g0.x, g0.y, g0.z, g0.w, g1.x, g1.y, g1.z, g1.w};
        unsigned ow[8];
#pragma unroll
        for (int e = 0; e < 8; ++e) {
            const int j = e >> 1, i0 = (e & 1) * 2;
            const float pa = bflo(pw[e]), pb = bfhi(pw[e]), qa = bflo(qw[e]), qb = bfhi(qw[e]);
            const float va = pa + (qa - pa) * mv[j][i0], vb = pb + (qb - pb) * mv[j][i0 + 1];
            const float oa = (y[j][i0] * rs * gw[j][i0] + gb[j][i0] + cb * va) * bflo(gw8[e]);
            const float ob = (y[j][i0 + 1] * rs * gw[j][i0 + 1] + gb[j][i0 + 1] + cb * vb) * bfhi(gw8[e]);
            ow[e] = pg8::cvt_pk_bf16(oa, ob);
        }
        *(v4u*)(OB + (size_t)m * 1024 + c0) = (v4u){ow[0], ow[1], ow[2], ow[3]};
        *(v4u*)(OB + (size_t)m * 1024 + c0 + 8) = (v4u){ow[4], ow[5], ow[6], ow[7]};
    }
}

struct EpiPA {
    static constexpr bool PERM = true, AFTER_DRAIN = false;
    const bf16* GT; float* Y1;
    __device__ __forceinline__ void operator()(const pg8::f32x4 (&acc)[2][2][4][2], const pg8::Unit& u, int wr, int wc, int fr, int fq) const {
        const int cb = u.pn * 256 + wc * 32 + 8 * fq;
#pragma unroll
        for (int ai = 0; ai < 2; ++ai)
#pragma unroll
            for (int m = 0; m < 4; ++m) {
                const int row = u.pm * 256 + wr * 64 + fr + ai * 128 + m * 16;
#pragma unroll
                for (int bj = 0; bj < 2; ++bj) {
                    const int col = cb + bj * 128; const v4u gq = *(const v4u*)(GT + (size_t)row * 2048 + col);
                    const pg8::f32x4 v0 = acc[ai][bj][m][0], v1 = acc[ai][bj][m][1];
                    *(f32x4*)(Y1 + (size_t)row * 1024 + col) = (f32x4){v0[0] * bflo(gq.x), v0[1] * bfhi(gq.x), v0[2] * bflo(gq.y), v0[3] * bfhi(gq.y)};
                    *(f32x4*)(Y1 + (size_t)row * 1024 + col + 4) = (f32x4){v1[0] * bflo(gq.z), v1[1] * bfhi(gq.z), v1[2] * bflo(gq.w), v1[3] * bfhi(gq.w)};
                }
            }
    }
};
struct EpiPB {
    static constexpr bool PERM = true, AFTER_DRAIN = false;
    const bf16* GT; const float* Y1; bf16* MG;
    __device__ __forceinline__ void operator()(const pg8::f32x4 (&acc)[2][2][4][2], const pg8::Unit& u, int wr, int wc, int fr, int fq) const {
        const int cb = u.pn * 256 + wc * 32 + 8 * fq;
#pragma unroll
        for (int ai = 0; ai < 2; ++ai)
#pragma unroll
            for (int m = 0; m < 4; ++m) {
                const int row = u.pm * 256 + wr * 64 + fr + ai * 128 + m * 16;
#pragma unroll
                for (int bj = 0; bj < 2; ++bj) {
                    const int col = cb + bj * 128; const v4u gq = *(const v4u*)(GT + (size_t)row * 2048 + 1024 + col);
                    const f32x4 y0 = *(const f32x4*)(Y1 + (size_t)row * 1024 + col), y1 = *(const f32x4*)(Y1 + (size_t)row * 1024 + col + 4);
                    const pg8::f32x4 v0 = acc[ai][bj][m][0], v1 = acc[ai][bj][m][1];
                    pg8::u32x4 w; w.x = pg8::cvt_pk_bf16(y0[0] + v0[0] * bflo(gq.x), y0[1] + v0[1] * bfhi(gq.x)); w.y = pg8::cvt_pk_bf16(y0[2] + v0[2] * bflo(gq.y), y0[3] + v0[3] * bfhi(gq.y));
                    w.z = pg8::cvt_pk_bf16(y1[0] + v1[0] * bflo(gq.z), y1[1] + v1[1] * bfhi(gq.z)); w.w = pg8::cvt_pk_bf16(y1[2] + v1[2] * bflo(gq.w), y1[3] + v1[3] * bfhi(gq.w));
                    *(pg8::u32x4*)(MG + (size_t)row * 1024 + col) = w;
                }
            }
    }
};
struct EpiRes {
    static constexpr bool PERM = true, AFTER_DRAIN = false;
    const float* base; float* Xo; bf16* Xb; float* ssq;
    __device__ __forceinline__ void operator()(const pg8::f32x4 (&acc)[2][2][4][2], const pg8::Unit& u, int wr, int wc, int fr, int fq) const {
        const int cb = u.pn * 256 + wc * 32 + 8 * fq;
#pragma unroll
        for (int ai = 0; ai < 2; ++ai)
#pragma unroll
            for (int m = 0; m < 4; ++m) {
                const int row = u.pm * 256 + wr * 64 + fr + ai * 128 + m * 16; float sq = 0.f;
#pragma unroll
                for (int bj = 0; bj < 2; ++bj) {
                    const int col = cb + bj * 128;
                    const f32x4 x0 = *(const f32x4*)(base + (size_t)row * 1024 + col), x1 = *(const f32x4*)(base + (size_t)row * 1024 + col + 4);
                    const pg8::f32x4 a0 = acc[ai][bj][m][0], a1 = acc[ai][bj][m][1];
                    const f32x4 o0 = {x0[0] + a0[0], x0[1] + a0[1], x0[2] + a0[2], x0[3] + a0[3]}, o1 = {x1[0] + a1[0], x1[1] + a1[1], x1[2] + a1[2], x1[3] + a1[3]};
                    *(f32x4*)(Xo + (size_t)row * 1024 + col) = o0; *(f32x4*)(Xo + (size_t)row * 1024 + col + 4) = o1;
                    sq += (o0[0] * o0[0] + o0[1] * o0[1]) + (o0[2] * o0[2] + o0[3] * o0[3]) + (o1[0] * o1[0] + o1[1] * o1[1]) + (o1[2] * o1[2] + o1[3] * o1[3]);
                    if (Xb) { pg8::u32x4 w; w.x = pg8::cvt_pk_bf16(o0[0], o0[1]); w.y = pg8::cvt_pk_bf16(o0[2], o0[3]); w.z = pg8::cvt_pk_bf16(o1[0], o1[1]); w.w = pg8::cvt_pk_bf16(o1[2], o1[3]);
                        *(pg8::u32x4*)(Xb + (size_t)row * 1024 + col) = w; }
                }
                sq += __shfl_xor(sq, 16); sq += __shfl_xor(sq, 32);
                if (fq == 0) atomicAdd(ssq + row, sq);
            }
    }
};
struct EpiGU {
    static constexpr bool PERM = true, AFTER_DRAIN = false;
    const float* ssq; bf16* ACT;
    __device__ __forceinline__ void operator()(const pg8::f32x4 (&acc)[2][2][4][2], const pg8::Unit& u, int wr, int wc, int fr, int fq) const {
        const int col = u.pn * 128 + wc * 32 + 8 * fq;
#pragma unroll
        for (int ai = 0; ai < 2; ++ai)
#pragma unroll
            for (int m = 0; m < 4; ++m) {
                const int row = u.pm * 256 + wr * 64 + fr + ai * 128 + m * 16;
                const float rstd = 1.0f / sqrtf(ssq[row] * (1.0f / DM) + NORM_EPS);
                float o[8];
#pragma unroll
                for (int n = 0; n < 2; ++n)
#pragma unroll
                    for (int j = 0; j < 4; ++j) { const float gv = acc[ai][0][m][n][j] * rstd, uv = acc[ai][1][m][n][j] * rstd; o[4 * n + j] = gv * sigmoidf_(gv) * uv; }
                pg8::u32x4 w; w.x = pg8::cvt_pk_bf16(o[0], o[1]); w.y = pg8::cvt_pk_bf16(o[2], o[3]); w.z = pg8::cvt_pk_bf16(o[4], o[5]); w.w = pg8::cvt_pk_bf16(o[6], o[7]);
                *(pg8::u32x4*)(ACT + (size_t)row * DFF + col) = w;
            }
    }
};

__device__ __forceinline__ f32x16 sgemm32_tile(const bf16* A, int lda, const bf16* Bt, int K, int n0, int lane) {
    const int r = lane & 31, h = lane >> 5;
    const bf16* ap = A + (size_t)r * lda + 8 * h; const bf16* bp = Bt + (size_t)(n0 + r) * K + 8 * h;
    f32x16 acc = {};
#pragma unroll 8
    for (int k = 0; k < K; k += 16) { const bf16x8 av = *(const bf16x8*)(ap + k), bv = *(const bf16x8*)(bp + k); acc = __builtin_amdgcn_mfma_f32_32x32x16_bf16(av, bv, acc, 0, 0, 0); }
    return acc;
}
#define SROW(rg, h) (((rg) & 3) + 8 * ((rg) >> 2) + 4 * (h))

__device__ __forceinline__ void s_inproj(const Frame& F, unsigned char* ws) {
    float* PROJ = (float*)(ws + WS_SMP + SM_PROJ);
    for (int tl = F.gw; tl < INP / 32; tl += F.NGW) {
        const f32x16 acc = sgemm32_tile((const bf16*)(ws + WS_SMP + SM_HSN), DM, (const bf16*)(ws + WS_WIN), DM, 32 * tl, F.lane);
#pragma unroll
        for (int rg = 0; rg < 16; ++rg) PROJ[(size_t)SROW(rg, F.lane >> 5) * INP + 32 * tl + (F.lane & 31)] = acc[rg];
    }
}

__device__ __forceinline__ float block_max(float v, LAS float* red, int tid) {
#pragma unroll
    for (int o = 1; o < 64; o <<= 1) v = fmaxf(v, __shfl_xor(v, o));
    __syncthreads(); if ((tid & 63) == 0) red[tid >> 6] = v; __syncthreads();
    float r = red[0];
#pragma unroll
    for (int i = 1; i < 8; ++i) r = fmaxf(r, red[i]);
    return r;
}
__device__ __forceinline__ float block_sum(float v, LAS float* red, int tid) {
    v = wave_sum(v);
    __syncthreads(); if ((tid & 63) == 0) red[tid >> 6] = v; __syncthreads();
    float r = 0.f;
#pragma unroll
    for (int i = 0; i < 8; ++i) r += red[i];
    return r;
}

__device__ __forceinline__ void s_attn_item(const Frame& F, const Args& a, unsigned char* ws, int b, int head) {
    const float* PROJ = (const float*)(ws + WS_SMP + SM_PROJ) + (size_t)b * INP; const float* tab = (const float*)(ws + WS_TAB) + (size_t)2048 * 64;
    LAS float* sm = (LAS float*)(F.lds + RING_OFF);
    LAS float* qn = sm;
    LAS float* kn = sm + 64;
    LAS float* vn = sm + 128;
    LAS float* pj = sm + 192;
    LAS float* red = sm + 336;
    LAS float* part = sm + 352;
    LAS float* og = sm + 864;
    LAS float* lse = sm + 1056;
    const int tid = F.tid;
    for (int g = 0; g < 3; ++g) {
        const int dil = 1 << (2 * g), buf = (g == 0) ? 128 : (g == 1) ? 512 : 2048;
        const float* cache = a.in[I_C1 + g]; const size_t okv = (g == 0) ? O_KV1S : (g == 1) ? O_KV2S : O_KV3S;
        __syncthreads();
        if (tid < 64) {
            const int i = tid & 31, isk = tid >> 5; const float* src = PROJ + (3 * g + isk) * 512 + head * 64;
            const float x1 = src[2 * i], x2 = src[2 * i + 1], c = tab[2 * i], s = tab[2 * i + 1];
            const float o1 = x1 * c - x2 * s, o2 = x1 * s + x2 * c;
            if (isk == 0) { qn[i] = o1 * 0.125f; qn[32 + i] = o2 * 0.125f; }
            else { kn[i] = o1; kn[32 + i] = o2; float* ob = a.out + okv + ((size_t)b * 2 + 0) * 512 + head * 64; ob[i] = o1; ob[32 + i] = o2; }
        } else if (tid < 128) {
            const int d = tid - 64; const float v = PROJ[(3 * g + 2) * 512 + head * 64 + d]; vn[d] = v; a.out[okv + ((size_t)b * 2 + 1) * 512 + head * 64 + d] = v;
        }
        __syncthreads();
        const int j = tid >> 2, pt = tid & 3;
        const size_t crow = ((size_t)b * buf + (buf - dil * (j + 1))) * 2;
        const float* kc = cache + ((crow + 0) * 8 + head) * 64 + 16 * pt;
        float sc = 0.f;
#pragma unroll
        for (int d4 = 0; d4 < 4; ++d4) { const f32x4 kv = *(const f32x4*)(kc + 4 * d4); sc += kv[0] * qn[16 * pt + 4 * d4] + kv[1] * qn[16 * pt + 4 * d4 + 1] + kv[2] * qn[16 * pt + 4 * d4 + 2] + kv[3] * qn[16 * pt + 4 * d4 + 3]; }
        sc = red4(sc);
        float snew = 0.f;
        if (tid < 64) snew = qn[tid] * kn[tid];
        snew = block_sum(snew, red, tid);
        const float mx = fmaxf(block_max(sc, red, tid), snew);
        const float pe = __expf(sc - mx), pn = __expf(snew - mx);
        if (pt == 0) pj[j] = pe;
        if (tid == 0) pj[128] = pn;
        const float den = block_sum(pt == 0 ? pe : 0.f, red, tid) + pn;
        const int d = tid & 63, kg = tid >> 6; float acc = 0.f;
#pragma unroll 4
        for (int jj = 0; jj < 16; ++jj) { const int j2 = kg * 16 + jj; const size_t cr2 = ((size_t)b * buf + (buf - dil * (j2 + 1))) * 2; acc += pj[j2] * cache[((cr2 + 1) * 8 + head) * 64 + d]; }
        if (kg == 0) acc += pj[128] * vn[d];
        part[kg * 64 + d] = acc;
        __syncthreads();
        if (tid < 64) { float o = 0.f;
#pragma unroll
            for (int k2 = 0; k2 < 8; ++k2) o += part[k2 * 64 + tid];
            og[g * 64 + tid] = o / den; }
        if (tid == 0) lse[g] = mx + __logf(den);
    }
    __syncthreads();
    if (tid < 64) {
        const float l0 = lse[0], l1 = lse[1], l2 = lse[2], mx = fmaxf(l0, fmaxf(l1, l2));
        const float e0 = __expf(l0 - mx), e1 = __expf(l1 - mx), e2 = __expf(l2 - mx), inv = 1.0f / (e0 + e1 + e2);
        const float o = (e0 * og[tid] + e1 * og[64 + tid] + e2 * og[128 + tid]) * inv;
        ((bf16*)(ws + WS_SMP + SM_OA))[(size_t)b * 512 + head * 64 + tid] = (bf16)f2bf(o);
    }
    __syncthreads();
}

__device__ __forceinline__ void s_rwkv_item(const Frame& F, const Args& a, unsigned char* ws, int b, int head) {
    const float* P = (const float*)(ws + WS_SMP + SM_PROJ) + (size_t)b * INP + ACOLS;
    const float* prev = a.in[I_SSH] + (size_t)b * SCOLS; const float* mu = a.in[I_MU];
    LAS float* sm = (LAS float*)(F.lds + RING_OFF);
    LAS float* xl = sm;
    LAS float* rr = sm + 288;
    LAS float* kr = sm + 352;
    LAS float* vv = sm + 416;
    LAS float* part = sm + 480;
    LAS float* wv = sm + 2016;
    LAS float* av = sm + 2080;
    LAS float* gv = sm + 2144;
    LAS float* kkv = sm + 2208;
    LAS float* kpv = sm + 2272;
    LAS float* bbv = sm + 2336;
    LAS float* yv = sm + 2400;
    LAS float* red = sm + 2464;
    const int tid = F.tid, hc0 = head * 64;
    __syncthreads();
    if (tid < 288) { const int c = 3072 + tid; const float x = P[c], xm = x + (prev[c] - x) * mu[c];
        xl[tid] = (tid < 64) ? tanh_(xm) : (tid < 128) ? xm : sigmoidf_(xm); }
    else if (tid < 288 + 192) { const int e = tid - 288, which = e >> 6, d = e & 63, c = which * 1024 + hc0 + d; const float x = P[c], xm = x + (prev[c] - x) * mu[c];
        if (which == 0) rr[d] = xm; else if (which == 1) kr[d] = xm; else vv[d] = xm; }
    __syncthreads();
    {
        const int c = tid & 63, sl = tid >> 6; const float* W2 = a.in[I_W2] + hc0 + c; const float* A2 = a.in[I_A2] + hc0 + c; const float* G2 = a.in[I_G2] + hc0 + c;
        float sw = 0.f, sa = 0.f, sg = 0.f;
#pragma unroll
        for (int e = 0; e < 8; ++e) { const int k = sl * 8 + e; sw += xl[k] * W2[(size_t)k * BWID]; sa += xl[64 + k] * A2[(size_t)k * BWID]; }
#pragma unroll 4
        for (int e = 0; e < 20; ++e) { const int k = sl * 20 + e; sg += xl[128 + k] * G2[(size_t)k * BWID]; }
        part[sl * 64 + c] = sw; part[512 + sl * 64 + c] = sa; part[1024 + sl * 64 + c] = sg;
    }
    __syncthreads();
    float n2p = 0.f;
    if (tid < 64) {
        float sw = 0.f, sa = 0.f, sg = 0.f;
#pragma unroll
        for (int s2 = 0; s2 < 8; ++s2) { sw += part[s2 * 64 + tid]; sa += part[512 + s2 * 64 + tid]; sg += part[1024 + s2 * 64 + tid]; }
        const float e = 0.60653065971263342f * sigmoidf_(a.in[I_W0][hc0 + tid] + sw);
        wv[tid] = __expf(-e); const float aa = sigmoidf_(a.in[I_A0][hc0 + tid] + sa); av[tid] = aa; gv[tid] = sg;
        const float kraw = kr[tid] * a.in[I_KK][hc0 + tid]; n2p = kraw * kraw; kkv[tid] = kraw;
        kpv[tid] = kr[tid] * (1.0f + (aa - 1.0f) * a.in[I_KA][hc0 + tid]);
    }
    const float n2 = block_sum(n2p, red, tid);
    const float rn = 1.0f / fmaxf(sqrtf(n2), 1e-12f);
    float cbp = 0.f;
    if (tid < 64) { const float kk = kkv[tid] * rn; kkv[tid] = kk; bbv[tid] = kk * av[tid]; cbp = rr[tid] * kpv[tid] * a.in[I_RK][hc0 + tid]; }
    const float cb = block_sum(cbp, red, tid);
    {
        const int i = tid >> 3, j0 = (tid & 7) * 8;
        const float* Sp = a.in[I_SWKV] + (((size_t)b * 16 + head) * 64 + i) * 64 + j0;
        float* So = a.out + O_WKVS + (((size_t)b * 16 + head) * 64 + i) * 64 + j0;
        const f32x4 s0 = *(const f32x4*)(Sp), s1 = *(const f32x4*)(Sp + 4);
        float S[8] = {s0[0], s0[1], s0[2], s0[3], s1[0], s1[1], s1[2], s1[3]};
        float dot = 0.f;
#pragma unroll
        for (int j = 0; j < 8; ++j) dot += S[j] * kkv[j0 + j];
        const float sa = -red8(dot), vi = vv[i];
        float yd = 0.f;
#pragma unroll
        for (int j = 0; j < 8; ++j) { S[j] = S[j] * wv[j0 + j] + sa * bbv[j0 + j] + vi * kpv[j0 + j]; yd += S[j] * rr[j0 + j]; }
        *(f32x4*)(So) = (f32x4){S[0], S[1], S[2], S[3]}; *(f32x4*)(So + 4) = (f32x4){S[4], S[5], S[6], S[7]};
        yd = red8(yd);
        if ((tid & 7) == 0) yv[i] = yd;
    }
    __syncthreads();
    const float yi = (tid < 64) ? yv[tid] : 0.f;
    const float mean = block_sum(yi, red, tid) * (1.0f / 64.0f);
    const float dv = (tid < 64) ? (yi - mean) : 0.f;
    const float var = block_sum(dv * dv, red, tid) * (1.0f / 64.0f);
    if (tid < 64) {
        const float yn = dv * (1.0f / sqrtf(var + GN_EPS)) * a.in[I_GNW][hc0 + tid] + a.in[I_GNB][hc0 + tid];
        const float o = (yn + cb * vv[tid]) * gv[tid];
        ((bf16*)(ws + WS_SMP + SM_OB))[(size_t)b * 1024 + hc0 + tid] = (bf16)f2bf(o);
    }
    __syncthreads();
}

__device__ __forceinline__ void s_proj(const Frame& F, unsigned char* ws) {
    for (int tl = F.gw; tl < 64; tl += F.NGW) {
        const int which = tl >> 5, n0 = 32 * (tl & 31);
        const f32x16 acc = which == 0 ? sgemm32_tile((const bf16*)(ws + WS_SMP + SM_OA), AWID, (const bf16*)(ws + WS_WA), AWID, n0, F.lane)
                                      : sgemm32_tile((const bf16*)(ws + WS_SMP + SM_OB), BWID, (const bf16*)(ws + WS_WB), BWID, n0, F.lane);
        float* O = (float*)(ws + WS_SMP + (which == 0 ? SM_YA : SM_YB));
#pragma unroll
        for (int rg = 0; rg < 16; ++rg) O[(size_t)SROW(rg, F.lane >> 5) * 1024 + n0 + (F.lane & 31)] = acc[rg];
    }
}
__device__ __forceinline__ void s_out(const Frame& F, const Args& a, unsigned char* ws) {
    const float* PROJ = (const float*)(ws + WS_SMP + SM_PROJ); const float* YA = (const float*)(ws + WS_SMP + SM_YA); const float* YBv = (const float*)(ws + WS_SMP + SM_YB);
    const bf16* Bt = (const bf16*)(ws + WS_WO);
    for (int tl = F.gw; tl < 32; tl += F.NGW) {
        const int n0 = 32 * tl, r = F.lane & 31, h = F.lane >> 5;
        f32x16 acc = {};
        for (int k = 0; k < DM; k += 16) {
            float mg[8];
#pragma unroll
            for (int j = 0; j < 8; ++j) { const int c = k + 8 * h + j;
                mg[j] = sigmoidf_(PROJ[(size_t)r * INP + ACOLS + SCP + c]) * YA[(size_t)r * 1024 + c] + sigmoidf_(PROJ[(size_t)r * INP + ACOLS + SCP + 1024 + c]) * YBv[(size_t)r * 1024 + c]; }
            const bf16x8 av = pack8(mg), bv = *(const bf16x8*)(Bt + (size_t)(n0 + r) * DM + k + 8 * h);
            acc = __builtin_amdgcn_mfma_f32_32x32x16_bf16(av, bv, acc, 0, 0, 0);
        }
        float* X1 = (float*)(ws + WS_SMP + SM_X1); bf16* X1B = (bf16*)(ws + WS_SMP + SM_X1B); float* SS = (float*)(ws + WS_SS) + M;
#pragma unroll
        for (int rg = 0; rg < 16; ++rg) { const int row = SROW(rg, h), col = n0 + r; const float v = a.in[I_XS][(size_t)row * DM + col] + acc[rg];
            X1[(size_t)row * 1024 + col] = v; X1B[(size_t)row * 1024 + col] = (bf16)f2bf(v);
            float sq = v * v;
#pragma unroll
            for (int o = 1; o < 32; o <<= 1) sq += __shfl_xor(sq, o);
            if (r == 0) atomicAdd(SS + row, sq); }
    }
}
__device__ __forceinline__ void s_gu(const Frame& F, unsigned char* ws) {
    const float* SS = (const float*)(ws + WS_SS) + M; bf16* ACTS = (bf16*)(ws + WS_SMP + SM_ACT);
    for (int tl = F.gw; tl < 88; tl += F.NGW) {
        const int jt = tl >> 2, i = tl & 3, n0 = 256 * jt + 32 * i, h = F.lane >> 5;
        const f32x16 ag = sgemm32_tile((const bf16*)(ws + WS_SMP + SM_X1B), DM, (const bf16*)(ws + WS_WGU), DM, n0, F.lane);
        const f32x16 au = sgemm32_tile((const bf16*)(ws + WS_SMP + SM_X1B), DM, (const bf16*)(ws + WS_WGU), DM, n0 + 128, F.lane);
#pragma unroll
        for (int rg = 0; rg < 16; ++rg) { const int row = SROW(rg, h); const float rstd = 1.0f / sqrtf(SS[row] * (1.0f / DM) + NORM_EPS);
            const float gv = ag[rg] * rstd, uv = au[rg] * rstd;
            ACTS[(size_t)row * DFF + 128 * jt + 32 * i + (F.lane & 31)] = (bf16)f2bf(gv * sigmoidf_(gv) * uv); }
    }
}
__device__ __forceinline__ void s_down(const Frame& F, unsigned char* ws) {
    const float* X1 = (const float*)(ws + WS_SMP + SM_X1); float* X2 = (float*)(ws + WS_SMP + SM_X2); float* SS2 = (float*)(ws + WS_SS2) + M;
    for (int tl = F.gw; tl < 32; tl += F.NGW) {
        const int n0 = 32 * tl, r = F.lane & 31, h = F.lane >> 5;
        const f32x16 acc = sgemm32_tile((const bf16*)(ws + WS_SMP + SM_ACT), DFF, (const bf16*)(ws + WS_WD), DFF, n0, F.lane);
#pragma unroll
        for (int rg = 0; rg < 16; ++rg) { const int row = SROW(rg, h), col = n0 + r; const float v = X1[(size_t)row * 1024 + col] + acc[rg];
            X2[(size_t)row * 1024 + col] = v; float sq = v * v;
#pragma unroll
            for (int o = 1; o < 32; o <<= 1) sq += __shfl_xor(sq, o);
            if (r == 0) atomicAdd(SS2 + row, sq); }
    }
}
__device__ __forceinline__ void final_norm(const Frame& F, const Args& a, unsigned char* ws) {
    const float* gfin = a.in[I_NFIN]; const float* SS2 = (const float*)(ws + WS_SS2);
    f32x4 gv[4];
#pragma unroll
    for (int j = 0; j < 4; ++j) gv[j] = *(const f32x4*)(gfin + 4 * F.lane + 256 * j);
    for (int m = F.gw; m < M + SB; m += F.NGW) {
        const float* src = (m < M) ? a.out + O_YP + (size_t)m * DM : (const float*)(ws + WS_SMP + SM_X2) + (size_t)(m - M) * DM;
        float* dst = (m < M) ? a.out + O_YP + (size_t)m * DM : a.out + O_YS + (size_t)(m - M) * DM;
        const float rstd = 1.0f / sqrtf(SS2[m] * (1.0f / DM) + NORM_EPS);
#pragma unroll
        for (int j = 0; j < 4; ++j) { const f32x4 v = *(const f32x4*)(src + 4 * F.lane + 256 * j); *(f32x4*)(dst + 4 * F.lane + 256 * j) = v * rstd * gv[j]; }
    }
}

namespace cs {
constexpr int IA = 0, IB = 4352, IBBT = 8704, IKBT = 11264, IVT = 13824, IVF = 16384, IGC = 20480, ICB = 20736, IMG_SZ = 20992;
constexpr int SM_OFF = 3 * IMG_SZ, SM_SZ = 2560, SMT = 0, SMLAK = 640, SMMRB = 1280, SMMRK = 1920;
constexpr int LB_OFF = SM_OFF + 2 * SM_SZ, YT_OFF = LB_OFF + 1024, YT_SZ = 4096, END = YT_OFF + 2 * YT_SZ;
static_assert(END <= 131072, "chunked scan LDS");
}
__device__ __forceinline__ bf16x8 ld2x8(const LAS unsigned char* p0, const LAS unsigned char* p1) {
    const u32x2 a = *(const LAS u32x2*)p0, b = *(const LAS u32x2*)p1; return __builtin_bit_cast(bf16x8, (v4u){a.x, a.y, b.x, b.y});
}
__device__ __forceinline__ void wave_sum2(float& a, float& b) {
    red16x2(a, b);
    const int ai = __builtin_bit_cast(int, a), bi = __builtin_bit_cast(int, b);
#define RL_(x, l) __builtin_bit_cast(float, __builtin_amdgcn_readlane(x, l))
    const float a0 = RL_(ai, 0), a1 = RL_(ai, 16), a2 = RL_(ai, 32), a3 = RL_(ai, 48), b0 = RL_(bi, 0), b1 = RL_(bi, 16), b2 = RL_(bi, 32), b3 = RL_(bi, 48);
#undef RL_
    a = (a0 + a1) + (a2 + a3); b = (b0 + b1) + (b2 + b3);
}
struct CsLd { unsigned short pr, pk, pv, qr, qk, qv, av; float lw, lwp; };
__device__ __forceinline__ void cs_load(CsLd& R, const bf16* SC, const float* LW, const bf16* AV, int b, int t, int col) {
    const size_t m = (size_t)b * T + t; const bf16* p = SC + m * SCP + col;
    R.pr = p[0]; R.pk = p[1024]; R.pv = p[2048];
    if (t > 0) { R.qr = p[-SCP]; R.qk = p[1024 - SCP]; R.qv = p[2048 - SCP]; } else { R.qr = 0; R.qk = 0; R.qv = 0; }
    R.av = AV[m * 1024 + col]; R.lw = LW[m * 1024 + col]; R.lwp = ((t & 15) != 0) ? LW[(m - 1) * 1024 + col] : 0.f;
}
__device__ __forceinline__ void scan_chunked(const Frame& F, const Args& a, unsigned char* ws, int chain) {
    using namespace cs;
    const bf16* SC = (const bf16*)(ws + WS_SC); const float* LW = (const float*)(ws + WS_Y); const bf16* AV = (const bf16*)(ws + WS_AV); const bf16* GATE = (const bf16*)(ws + WS_GATE);
    bf16* OB = (bf16*)(ws + WS_OB);
    LAS unsigned char* lds = F.lds + RING_OFF;
    const int lane = F.lane, wave = F.wave, b = chain >> 4, head = chain & 15, hc = head * 64;
    const int r32 = lane & 31, h = lane >> 5;
    constexpr int NCH = T / 16;
    f32x16 ST0 = {}, ST1 = {};
    CsLd ld[3], ldn[3]; float lwend = 0.f, lwendn = 0.f; unsigned short gt[3] = {0, 0, 0}, gtn[3] = {0, 0, 0};
    float mur = 0.f, muk = 0.f, muv = 0.f, kkw = 0.f, kaw = 0.f, rkw = 0.f, gnw = 0.f, gnb = 0.f;
    const int wp = wave - 3;
    const int nst = (wave >= 3) ? 3 : (wave == 0 ? 1 : 0), sbase = (wave >= 3) ? wp : 15;
    if (nst > 0) {
        const int c = hc + lane;
        mur = a.in[I_MU][c]; muk = a.in[I_MU][1024 + c]; muv = a.in[I_MU][2048 + c]; kkw = a.in[I_KK][c]; kaw = a.in[I_KA][c]; rkw = a.in[I_RK][c]; gnw = a.in[I_GNW][c]; gnb = a.in[I_GNB][c];
#pragma unroll
        for (int i = 0; i < 3; ++i) { const int s = sbase + 5 * i; if (i < nst) cs_load(ld[i], SC, LW, AV, b, s, c); }
        lwend = LW[((size_t)b * T + 15) * 1024 + c];
    }
    for (int it = -2; it <= NCH; ++it) {
        const int nA = it + 2, nB = it + 1, nC = it, nD = it - 1;
        if (wave == 2) {
            if (nB >= 0 && nB < NCH) {
                const LAS unsigned char* img = lds + (nB % 3) * IMG_SZ; LAS unsigned char* sm = lds + SM_OFF + (nB & 1) * SM_SZ; LAS float* Lb = (LAS float*)(lds + LB_OFF);
                f32x16 P = {};
#pragma unroll
                for (int ks = 0; ks < 4; ++ks) {
                    const LAS unsigned char* pa = img + IA + r32 * 136 + (16 * ks + 8 * h) * 2; const LAS unsigned char* pb = img + IB + r32 * 136 + (16 * ks + 8 * h) * 2;
                    P = __builtin_amdgcn_mfma_f32_32x32x16_bf16(ld2x8(pa, pa + 8), ld2x8(pb, pb + 8), P, 0, 0, 0);
                }
                const int sp = r32, s16 = r32 & 15; const bool lo = sp < 16;
#pragma unroll
                for (int rg = 0; rg < 8; ++rg) {
                    const int t = (rg & 3) + 8 * (rg >> 2) + 4 * h; const float v = (s16 < t) ? P[rg] : 0.f;
                    if (lo) Lb[t * 16 + s16] = v; else *(LAS bf16*)(sm + SMLAK + t * 40 + s16 * 2) = (bf16)(cvtpk_s(v, 0.f) & 0xffff);
                }
#pragma unroll
                for (int rg = 8; rg < 16; ++rg) {
                    const int t = (rg & 3) + 8 * ((rg >> 2) - 2) + 4 * h; const float v = (s16 <= t) ? P[rg] : 0.f;
                    *(LAS bf16*)(sm + (lo ? SMMRB : SMMRK) + t * 40 + s16 * 2) = (bf16)(cvtpk_s(v, 0.f) & 0xffff);
                }
                float Tr[16];
                const int cc = lane & 15;
#pragma unroll
                for (int t = 0; t < 16; ++t) {
                    float acc = (cc == t) ? 1.0f : 0.0f;
#pragma unroll
                    for (int u4 = 0; u4 < (t + 3) / 4; ++u4) {
                        const f32x4 lv = *(const LAS f32x4*)(Lb + t * 16 + 4 * u4);
#pragma unroll
                        for (int q = 0; q < 4; ++q) { const int u = 4 * u4 + q; if (u < t) acc += lv[q] * Tr[u]; }
                    }
                    Tr[t] = acc;
                }
                if (lane < 16) {
#pragma unroll
                    for (int t = 0; t < 16; ++t) *(LAS bf16*)(sm + SMT + t * 40 + cc * 2) = (bf16)(cvtpk_s(Tr[t], 0.f) & 0xffff);
                }
            }
        } else if (wave < 2) {
            if (nC >= 0 && nC < NCH) {
                const LAS unsigned char* img = lds + (nC % 3) * IMG_SZ; const LAS unsigned char* sm = lds + SM_OFF + (nC & 1) * SM_SZ; LAS float* YT = (LAS float*)(lds + YT_OFF + (nC & 1) * YT_SZ);
                const int vcol = 32 * wave + r32, t16 = r32 & 15;
                bf16x8 Bf[4];
                { float tmp[8];
#pragma unroll
                  for (int ks = 0; ks < 4; ++ks) {
#pragma unroll
                      for (int e = 0; e < 8; ++e) tmp[e] = (ks < 2) ? ST0[8 * (ks & 1) + e] : ST1[8 * (ks & 1) + e];
                      Bf[ks] = pack8(tmp); } }
                const LAS unsigned char* pv = img + IVT + vcol * 40 + 16 * h; const bf16x8 Vf = ld2x8(pv, pv + 8);
                f32x16 X = {};
                { const LAS unsigned char* p = sm + SMLAK + t16 * 40 + 16 * h; X = __builtin_amdgcn_mfma_f32_32x32x16_bf16(ld2x8(p, p + 8), Vf, X, 0, 0, 0); }
#pragma unroll
                for (int ks = 0; ks < 4; ++ks) { const LAS unsigned char* p = img + IA + t16 * 136 + (16 * ks + 4 * h) * 2; X = __builtin_amdgcn_mfma_f32_32x32x16_bf16(ld2x8(p, p + 16), Bf[ks], X, 0, 0, 0); }
                f32x16 SA = {};
                { float tmp[8];
#pragma unroll
                  for (int e = 0; e < 8; ++e) tmp[e] = X[e];
                  const LAS unsigned char* p = sm + SMT + t16 * 40 + 8 * h; SA = __builtin_amdgcn_mfma_f32_32x32x16_bf16(ld2x8(p, p + 16), pack8(tmp), SA, 0, 0, 0); }
                bf16x8 SAb;
                { float tmp[8];
#pragma unroll
                  for (int e = 0; e < 8; ++e) tmp[e] = SA[e];
                  SAb = pack8(tmp); }
                f32x16 Y = {};
                { const LAS unsigned char* p = sm + SMMRK + t16 * 40 + 16 * h; Y = __builtin_amdgcn_mfma_f32_32x32x16_bf16(ld2x8(p, p + 8), Vf, Y, 0, 0, 0); }
                { const LAS unsigned char* p = sm + SMMRB + t16 * 40 + 8 * h; Y = __builtin_amdgcn_mfma_f32_32x32x16_bf16(ld2x8(p, p + 16), SAb, Y, 0, 0, 0); }
#pragma unroll
                for (int ks = 0; ks < 4; ++ks) { const LAS unsigned char* p = img + IA + (16 + t16) * 136 + (16 * ks + 4 * h) * 2; Y = __builtin_amdgcn_mfma_f32_32x32x16_bf16(ld2x8(p, p + 16), Bf[ks], Y, 0, 0, 0); }
#pragma unroll
                for (int rg = 0; rg < 8; ++rg) YT[((rg & 3) + 8 * (rg >> 2) + 4 * h) * 64 + vcol] = Y[rg];
                const LAS float* GC = (const LAS float*)(img + IGC);
#pragma unroll
                for (int jt = 0; jt < 2; ++jt) {
                    f32x16 S = jt == 0 ? ST0 : ST1;
#pragma unroll
                    for (int g4 = 0; g4 < 4; ++g4) { const f32x4 dc = *(const LAS f32x4*)(GC + 32 * jt + 8 * g4 + 4 * h);
#pragma unroll
                        for (int q = 0; q < 4; ++q) S[4 * g4 + q] *= dc[q]; }
                    const int jrow = 32 * jt + r32;
                    { const LAS unsigned char* p = img + IBBT + jrow * 40 + 8 * h; S = __builtin_amdgcn_mfma_f32_32x32x16_bf16(ld2x8(p, p + 16), SAb, S, 0, 0, 0); }
                    { const LAS unsigned char* p = img + IKBT + jrow * 40 + 16 * h; S = __builtin_amdgcn_mfma_f32_32x32x16_bf16(ld2x8(p, p + 8), Vf, S, 0, 0, 0); }
                    if (jt == 0) ST0 = S; else ST1 = S;
                }
            }
        }
        if (nst > 0) {
            const int c = hc + lane;
            if (nA + 1 < NCH) {
#pragma unroll
                for (int i = 0; i < 3; ++i) { const int s = sbase + 5 * i; if (i < nst) cs_load(ldn[i], SC, LW, AV, b, (nA + 1) * 16 + s, c); }
                lwendn = LW[((size_t)b * T + (nA + 1) * 16 + 15) * 1024 + c];
            }
            if (nD + 1 >= 0 && nD + 1 < NCH) {
#pragma unroll
                for (int i = 0; i < 3; ++i) { const int s = sbase + 5 * i; if (i < nst) gtn[i] = GATE[((size_t)b * T + (nD + 1) * 16 + s) * 1024 + c]; }
            }
            if (nD >= 0 && nD < NCH) {
                const LAS unsigned char* img = lds + (nD % 3) * IMG_SZ; const LAS float* YT = (const LAS float*)(lds + YT_OFF + (nD & 1) * YT_SZ);
#pragma unroll
                for (int i = 0; i < 3; ++i) { const int s = sbase + 5 * i; if (i < nst) {
                    const size_t m = (size_t)b * T + nD * 16 + s;
                    const float gtv = bf2f(gt[i]);
                    const float y = YT[s * 64 + lane]; float s1 = y, s2 = y * y; wave_sum2(s1, s2);
                    const float mean = s1 * (1.0f / 64.0f), var = fmaxf(s2 * (1.0f / 64.0f) - mean * mean, 0.f);
                    const float yn = (y - mean) * __builtin_amdgcn_rsqf(var + GN_EPS) * gnw + gnb;
                    const float cbn = ((const LAS float*)(img + ICB))[s], vv = ((const LAS float*)(img + IVF))[s * 64 + lane];
                    OB[m * 1024 + c] = (bf16)(cvtpk_s((yn + cbn * vv) * gtv, 0.f) & 0xffff);
                } }
            }
            if (nA < NCH) {
                LAS unsigned char* img = lds + (nA % 3) * IMG_SZ;
                const float gC = __expf(lwend);
#pragma unroll
                for (int i = 0; i < 3; ++i) { const int s = sbase + 5 * i; if (i < nst) {
                    const CsLd& R = ld[i];
                    const float pr = bf2f(R.pr), pk = bf2f(R.pk), pv = bf2f(R.pv), qr = bf2f(R.qr), qk = bf2f(R.qk), qv = bf2f(R.qv), av = bf2f(R.av);
                    const float r = pr + (qr - pr) * mur, k = pk + (qk - pk) * muk, v = pv + (qv - pv) * muv;
                    const float gs = __expf(R.lw), gp = __expf(R.lwp), ig = __expf(-R.lw), rat = __expf(lwend - R.lw);
                    const float kr = k * kkw, kp = k * (1.0f + (av - 1.0f) * kaw);
                    float n2 = kr * kr, cb = r * kp * rkw; wave_sum2(n2, cb);
                    const float kk = kr * __builtin_amdgcn_rsqf(fmaxf(n2, 1e-24f)), beta = kk * av;
                    const unsigned w0 = cvtpk_s(-kk * gp, r * gs), w1 = cvtpk_s(beta * ig, kp * ig), w2 = cvtpk_s(beta * rat, kp * rat), w3 = cvtpk_s(v, 0.f);
                    *(LAS bf16*)(img + IA + s * 136 + lane * 2) = (bf16)(w0 & 0xffff); *(LAS bf16*)(img + IA + (16 + s) * 136 + lane * 2) = (bf16)(w0 >> 16);
                    *(LAS bf16*)(img + IB + s * 136 + lane * 2) = (bf16)(w1 & 0xffff); *(LAS bf16*)(img + IB + (16 + s) * 136 + lane * 2) = (bf16)(w1 >> 16);
                    *(LAS bf16*)(img + IBBT + lane * 40 + s * 2) = (bf16)(w2 & 0xffff); *(LAS bf16*)(img + IKBT + lane * 40 + s * 2) = (bf16)(w2 >> 16);
                    *(LAS bf16*)(img + IVT + lane * 40 + s * 2) = (bf16)(w3 & 0xffff);
                    ((LAS float*)(img + IVF))[s * 64 + lane] = v;
                    if (lane == 0) ((LAS float*)(img + ICB))[s] = cb;
                    if (s == 15) ((LAS float*)(img + IGC))[lane] = gC;
                } }
            }
#pragma unroll
            for (int i = 0; i < 3; ++i) { ld[i] = ldn[i]; gt[i] = gtn[i]; }
            lwend = lwendn;
        }
        __syncthreads();
    }
    if (wave < 2) {
        float* so = a.out + O_WKVP + (((size_t)b * 16 + head) * 64 + 32 * wave + r32) * 64;
#pragma unroll
        for (int rg = 0; rg < 16; ++rg) { const int j = (rg & 3) + 8 * (rg >> 2) + 4 * h; so[j] = ST0[rg]; so[32 + j] = ST1[rg]; }
    }
    __syncthreads();
}
__global__ void __launch_bounds__(NWAVES * 64, 2) fwd_kernel(Args args) {
    extern __shared__ __attribute__((aligned(16))) unsigned char lds[];
    Frame F;
    F.lds = (LAS unsigned char*)lds;
    F.MISC = (volatile LAS unsigned*)(F.lds + MISC_OFF);
    F.tid = threadIdx.x; F.lane = F.tid & 63; F.wave = __builtin_amdgcn_readfirstlane(F.tid >> 6);
    F.G = gridDim.x; { const int bx = blockIdx.x; F.vcu = (F.G % 8 == 0) ? (bx % 8) * (F.G / 8) + bx / 8 : bx; }
    F.gw = F.vcu * NWAVES + F.wave; F.NGW = F.G * NWAVES;
    unsigned char* ws = args.ws;
    F.ctl = (gu32*)(ws + WS_CTL);
    for (int u = F.tid; u < (LDS_BYTES - LDSCTL_OFF) / 4; u += NWAVES * 64) ((LAS unsigned*)(F.lds + LDSCTL_OFF))[u] = 0u;
    __syncthreads();
    XcdBarrier bar = xcd_barrier_post((unsigned*)(F.ctl + CW_BAR), F.MISC + 8);
#define GRID_BAR() do { xcd_barrier(bar); int t_ = threadIdx.x; asm volatile("" : "+v"(t_)); F.tid = t_; F.lane = t_ & 63; } while (0)
#ifdef PROBE_TIMING
    unsigned long long ts_[14]; int nts_ = 0;
#define STAMP() do { ts_[nts_++] = __builtin_amdgcn_s_memrealtime(); } while (0)
    STAMP();
#else
#define STAMP() do {} while (0)
#endif

    p0_prologue(F, args, ws);
    GRID_BAR(); STAMP();

    const int NSCAN = (F.G >= 256) ? 128 : 0;
    EpiIn Ein{(bf16*)(ws + WS_Q), (bf16*)(ws + WS_K), (bf16*)(ws + WS_VT), (bf16*)(ws + WS_SC), (bf16*)(ws + WS_GT), args.out, (const float*)(ws + WS_TAB)};
    {
        s_inproj(F, ws);
        pg8::Gemm g{(const pg8::bf16_t*)(ws + WS_XN), (const pg8::bf16_t*)(ws + WS_WIN), M, INP, opaque_int(DM)};
        TileListOrder S; S.init(M, 20, 20, 18, 0, F.G, (int)blockIdx.x);
        pg8::gemm_phase<EpiIn, TileListOrder, true, true>(F.lds + RING_OFF, g, S, Ein);
    }
    GRID_BAR(); STAMP();

    r1_rows(F, (const bf16*)(ws + WS_SC), args.in[I_MU], (bf16*)(ws + WS_A1), (bf16*)(ws + WS_A2));
    GRID_BAR(); STAMP();

    {
        { pg8::Gemm g{(const pg8::bf16_t*)(ws + WS_A1), (const pg8::bf16_t*)(ws + WS_WWA), M, 2048, opaque_int(128)}; pg8::StaticOrder S; S.init(M, 2048, F.G, (int)blockIdx.x);
          EpiWA E{(float*)(ws + WS_Y), (bf16*)(ws + WS_AV), args.in[I_W0], args.in[I_A0]};
          pg8::gemm_phase<EpiWA, pg8::StaticOrder, true, true>(F.lds + RING_OFF, g, S, E); }
        { pg8::Gemm g{(const pg8::bf16_t*)(ws + WS_A2), (const pg8::bf16_t*)(ws + WS_WG), M, 1024, opaque_int(256)}; pg8::StaticOrder S; S.init(M, 1024, F.G, (int)blockIdx.x);
          EpiPlain E{(bf16*)(ws + WS_GATE), 1024};
          pg8::gemm_phase<EpiPlain, pg8::StaticOrder, true, true>(F.lds + RING_OFF, g, S, E); }
    }
    GRID_BAR(); STAMP();

    {
        if (NSCAN == 0) { for (int ch = F.vcu; ch < NB * BHEADS; ch += F.G) scan_chunked(F, args, ws, ch); }
        else if ((int)blockIdx.x < NSCAN) scan_chunked(F, args, ws, (int)blockIdx.x);
        if (NSCAN == 0 || (int)blockIdx.x >= NSCAN) {
            pg8::Gemm g{(const pg8::bf16_t*)(ws + WS_XN), (const pg8::bf16_t*)(ws + WS_WIN), M, INP, opaque_int(DM)};
            TileListOrder S; S.init(M, 20, 18, 0, 38, F.G - NSCAN, (int)blockIdx.x - NSCAN);
            pg8::gemm_phase<EpiIn, TileListOrder, true, true>(F.lds + RING_OFF, g, S, Ein);
        }
    }
    GRID_BAR(); STAMP();

    {
        for (int it = F.vcu; it < NB * AHEADS * 4; it += F.G)
            attn_item(F, it, (const bf16*)(ws + WS_Q), (const bf16*)(ws + WS_K), (const bf16*)(ws + WS_VT), (bf16*)(ws + WS_OG), (float*)(ws + WS_LSE), (bf16*)(ws + WS_OA));
        __syncthreads();
        for (int it = F.vcu; it < SB * AHEADS; it += F.G) s_attn_item(F, args, ws, it >> 3, it & 7);
        for (int it = F.vcu; it < SB * BHEADS; it += F.G) s_rwkv_item(F, args, ws, it >> 4, it & 15);
        { const float* PROJ = (const float*)(ws + WS_SMP + SM_PROJ);
          for (int e = F.vcu * 512 + F.tid; e < SB * SCOLS; e += F.G * 512) { const int b = e / SCOLS, c = e - b * SCOLS; args.out[O_SHS + e] = PROJ[(size_t)b * INP + ACOLS + c]; } }
    }
    GRID_BAR(); STAMP();

    {
        s_proj(F, ws);
        { pg8::Gemm g{(const pg8::bf16_t*)(ws + WS_OA), (const pg8::bf16_t*)(ws + WS_WA), M, DM, opaque_int(AWID)}; pg8::StaticOrder S; S.init(M, DM, F.G, (int)blockIdx.x);
          EpiPA E{(const bf16*)(ws + WS_GT), (float*)(ws + WS_Y1)};
          pg8::gemm_phase<EpiPA, pg8::StaticOrder, true, true>(F.lds + RING_OFF, g, S, E); }
        VM_WAIT(); __syncthreads();
        { pg8::Gemm g{(const pg8::bf16_t*)(ws + WS_OB), (const pg8::bf16_t*)(ws + WS_WB), M, DM, opaque_int(BWID)}; pg8::StaticOrder S; S.init(M, DM, F.G, (int)blockIdx.x);
          EpiPB E{(const bf16*)(ws + WS_GT), (const float*)(ws + WS_Y1), (bf16*)(ws + WS_MG)};
          pg8::gemm_phase<EpiPB, pg8::StaticOrder, true, true>(F.lds + RING_OFF, g, S, E); }
    }
    GRID_BAR(); STAMP();

    {
        s_out(F, args, ws);
        pg8::Gemm g{(const pg8::bf16_t*)(ws + WS_MG), (const pg8::bf16_t*)(ws + WS_WO), M, DM, opaque_int(DM)}; pg8::StaticOrder S; S.init(M, DM, F.G, (int)blockIdx.x);
        EpiRes E{args.in[I_XP], (float*)(ws + WS_X1), (bf16*)(ws + WS_X1B), (float*)(ws + WS_SS)};
        pg8::gemm_phase<EpiRes, pg8::StaticOrder, true, true>(F.lds + RING_OFF, g, S, E);
    }
    GRID_BAR(); STAMP();

    {
        s_gu(F, ws);
        pg8::Gemm g{(const pg8::bf16_t*)(ws + WS_X1B), (const pg8::bf16_t*)(ws + WS_WGU), M, GU, opaque_int(DM)}; pg8::StaticOrder S; S.init(M, GU, F.G, (int)blockIdx.x);
        EpiGU E{(const float*)(ws + WS_SS), (bf16*)(ws + WS_ACT)};
        pg8::gemm_phase<EpiGU, pg8::StaticOrder, true, true>(F.lds + RING_OFF, g, S, E);
    }
    GRID_BAR(); STAMP();

    {
        s_down(F, ws);
        pg8::Gemm g{(const pg8::bf16_t*)(ws + WS_ACT), (const pg8::bf16_t*)(ws + WS_WD), M, DM, opaque_int(DFF)}; pg8::StaticOrder S; S.init(M, DM, F.G, (int)blockIdx.x);
        EpiRes E{(const float*)(ws + WS_X1), args.out + O_YP, nullptr, (float*)(ws + WS_SS2)};
        pg8::gemm_phase<EpiRes, pg8::StaticOrder, true, true>(F.lds + RING_OFF, g, S, E);
    }
    GRID_BAR(); STAMP();

    final_norm(F, args, ws);
#ifdef PROBE_TIMING
    GRID_BAR(); STAMP();
    if (blockIdx.x == 0 && F.tid == 0) {
        const size_t offs[12] = {O_YP, O_YS, O_KV1P, O_KV2P, O_KV3P, O_SHP, O_WKVP, O_KV1S, O_KV2S, O_KV3S, O_SHS, O_WKVS};
        for (int k = 0; k < 11; ++k) args.out[offs[k]] = (float)(ts_[k + 1] - ts_[k]) * 0.01f;
        args.out[offs[11]] = (float)(ts_[11] - ts_[0]) * 0.01f;
    }
#endif
}

extern "C" void kernel_launch(void* const* d_in, const int* in_sizes, int n_in, void* d_out, int out_size, void* d_ws, size_t ws_size, hipStream_t stream) {
    static int grid = 0;
    if (grid == 0) {
        if (n_in != 28 || in_sizes[0] != M * DM || (size_t)out_size != O_END || ws_size < WS_END) {
            fprintf(stderr, "kernel_launch: unexpected shapes: n_in %d in0 %d out %d ws %zu (need %zu)\n", n_in, n_in > 0 ? in_sizes[0] : -1, out_size, ws_size, (size_t)WS_END); grid = -1; return; }
        int dev = 0, cus = 0, per_cu = 0;
        if (hipGetDevice(&dev) != hipSuccess || hipDeviceGetAttribute(&cus, hipDeviceAttributeMultiprocessorCount, dev) != hipSuccess) { grid = -1; return; }
        if (hipFuncSetAttribute((const void*)fwd_kernel, hipFuncAttributeMaxDynamicSharedMemorySize, LDS_BYTES) != hipSuccess) { fprintf(stderr, "kernel_launch: hipFuncSetAttribute failed\n"); grid = -1; return; }
        if (hipOccupancyMaxActiveBlocksPerMultiprocessor(&per_cu, (const void*)fwd_kernel, NWAVES * 64, LDS_BYTES) != hipSuccess || per_cu < 1) {
            fprintf(stderr, "kernel_launch: occupancy query says %d blocks per CU\n", per_cu); (void)hipGetLastError(); grid = -1; return; }
        grid = cus;
    }
    if (grid < 0) return;
    if (hipMemsetAsync((char*)d_ws + WS_CTL, 0, CTL_ZERO_BYTES, stream) != hipSuccess) return;
    Args a{};
    for (int i = 0; i < 28; ++i) a.in[i] = (const float*)d_in[i];
    a.out = (float*)d_out; a.ws = (unsigned char*)d_ws;
    hipLaunchKernelGGL(fwd_kernel, dim3(grid), dim3(NWAVES * 64), LDS_BYTES, stream, a);
}
```

```cpp
#include <hip/hip_runtime.h>
#include <cstdio>
#include <cstdint>
#include <type_traits>
namespace pg8 {
#define PG8_LAS __attribute__((address_space(3)))
typedef unsigned short bf16_t;
typedef short bf16x8 __attribute__((ext_vector_type(8)));
typedef float f32x4 __attribute__((ext_vector_type(4)));
typedef unsigned u32x4 __attribute__((ext_vector_type(4)));
constexpr int BM = 256, BK = 64, HALF = 128, HTB = HALF * BK * 2  , STAGE_BYTES = 8 * HTB, NXCD = 8, WGM = 8;

__host__ __device__ __forceinline__ int lds_byte(int r, int c) { const int st = (r >> 4) * 2 + (c >> 5), rr = r & 15, cc = c & 31, ob = rr * 64 + cc * 2; return st * 1024 + (ob ^ (((ob >> 9) & 1) << 5)); }
__host__ __device__ __forceinline__ void stage_rc(int b, int& R, int& C) { const int st = b / 1024, sb = b % 1024, swz = sb ^ (((sb >> 9) & 1) << 5); R = (st >> 1) * 16 + swz / 64; C = (st & 1) * 32 + (swz % 64) / 2; }
__host__ __device__ __forceinline__ int perm32(int rho) { const int n = rho >> 4, i = rho & 15; return 8 * (i >> 2) + 4 * n + (i & 3); }

struct Unit { int pm, pn; };
struct Gemm { const bf16_t* A; const bf16_t* Bt; int M, N, K; };

struct StaticOrder {
    int nM, nN, nwg, G, c;
    __host__ __device__ void init(int M, int N, int G_, int c_) { nM = M / BM; nN = N / BM; nwg = nM * nN; G = G_; c = c_; }
    __host__ __device__ bool next(int i, Unit& u) const {
        const long L = (long)i * G + c; if (L >= nwg) return false;
        int wgid = (int)L; { const int q = nwg / NXCD, r = nwg % NXCD, xcd = wgid % NXCD, off = wgid / NXCD; wgid = (xcd < r ? xcd * (q + 1) : r * (q + 1) + (xcd - r) * q) + off; }
        const int nig = WGM * nN, gid = wgid / nig, fm = gid * WGM, gsz = (nM - fm) < WGM ? (nM - fm) : WGM;
        u.pm = fm + ((wgid % nig) % gsz); u.pn = (wgid % nig) / gsz; return true;
    }
    __device__ __forceinline__ void a_ready(const Unit&) const {}
    __device__ __forceinline__ void done(const Unit&) const {}
};

__device__ __forceinline__ unsigned cvt_pk_bf16(float lo, float hi) { unsigned r; asm volatile("v_cvt_pk_bf16_f32 %0, %1, %2" : "=v"(r) : "v"(lo), "v"(hi)); return r; }
template <class Epi, class Sched, bool ALIGN_EPI = false, bool SP2 = false>
__device__ __forceinline__ void gemm_phase(PG8_LAS unsigned char* lds, const Gemm g, const Sched& S, const Epi& E) {
    int tid_ = threadIdx.x; asm volatile("" : "+v"(tid_));
    const int tid = tid_, wid = __builtin_amdgcn_readfirstlane(tid >> 6), lane = tid & 63, wr = wid >> 2, wc = wid & 3, fr = lane & 15, fq = lane >> 4;
    const int K = g.K, nt = K / BK;
    unsigned voffA[2], voffB[2];
#pragma unroll
    for (int i = 0; i < 2; ++i) { int R, C; stage_rc(tid * 16 + i * 8192, R, C); const int Rb = Epi::PERM ? ((R & ~31) + perm32(R & 31)) : R;
        voffA[i] = (unsigned)(R * K + C) * 2u; voffB[i] = (unsigned)(Rb * K + C) * 2u; }
    const size_t kstep = (size_t)(BK * 2);
    const size_t hstep = (size_t)HALF * K * 2;
    const size_t tstep = 2 * hstep;
    const unsigned ldsw = (unsigned)wid * 1024u;
    const int aoff = lds_byte(wr * 64 + fr, fq * 8), boff = lds_byte(wc * 32 + fr, fq * 8);
#define PG8_SA(b, h) (((b) * 2 + (h)) * HTB)
#define PG8_SB(b, h) ((4 + (b) * 2 + (h)) * HTB)
#define PG8_STAGE(bufoff, gbase, voff) do { _Pragma("unroll") for (int _i = 0; _i < 2; ++_i) \
        __builtin_amdgcn_global_load_lds((const unsigned*)((const char*)(gbase) + (voff)[_i]), (PG8_LAS unsigned*)(lds + (bufoff) + ldsw + _i * 8192), 16, 0, 0); } while (0)
#define PG8_LDA(dst, b, h) do { _Pragma("unroll") for (int m = 0; m < 4; ++m) _Pragma("unroll") for (int k = 0; k < 2; ++k) dst[m][k] = *(const PG8_LAS bf16x8*)(lds + PG8_SA(b, h) + aoff + m * 2048 + k * 1024); } while (0)
#define PG8_LDB(dst, b, h) do { _Pragma("unroll") for (int n = 0; n < 2; ++n) _Pragma("unroll") for (int k = 0; k < 2; ++k) dst[n][k] = *(const PG8_LAS bf16x8*)(lds + PG8_SB(b, h) + boff + n * 2048 + k * 1024); } while (0)
#define PG8_MMA(ai, bj, At, Bt) do { __builtin_amdgcn_s_setprio(1); _Pragma("unroll") for (int m = 0; m < 4; ++m) _Pragma("unroll") for (int n = 0; n < 2; ++n) _Pragma("unroll") for (int k = 0; k < 2; ++k) \
        acc[ai][bj][m][n] = __builtin_amdgcn_mfma_f32_16x16x32_bf16(Bt[n][k], At[m][k], acc[ai][bj][m][n], 0, 0, 0); __builtin_amdgcn_s_setprio(0); } while (0)
#define PG8_WAIT_V(n) asm volatile("s_waitcnt vmcnt(" #n ")" ::: "memory")
#define PG8_WAIT_L(n) asm volatile("s_waitcnt lgkmcnt(" #n ")" ::: "memory")
#define PG8_BAR __builtin_amdgcn_s_barrier()
#define PG8_SCHED __builtin_amdgcn_sched_barrier(0)
    Unit cur, nxt; int ui = 0;
    if (!S.next(0, cur)) return;
    f32x4 acc[2][2][4][2];
#pragma unroll
    for (int a = 0; a < 2; ++a)
#pragma unroll
        for (int b = 0; b < 2; ++b)
#pragma unroll
            for (int m = 0; m < 4; ++m)
#pragma unroll
                for (int n = 0; n < 2; ++n) acc[a][b][m][n] = (f32x4){0.f, 0.f, 0.f, 0.f};
    bf16x8 At[4][2], B0[2][2], B1[2][2];
    const char* cA = (const char*)g.A + (size_t)cur.pm * tstep; const char* cB = (const char*)g.Bt + (size_t)cur.pn * tstep;
    S.a_ready(cur);
    if constexpr (SP2) {
        PG8_STAGE(PG8_SB(0, 0), cB, voffB); PG8_STAGE(PG8_SB(0, 1), cB + hstep, voffB); PG8_STAGE(PG8_SA(0, 0), cA, voffA); PG8_STAGE(PG8_SA(0, 1), cA + hstep, voffA);
        if (wr == 1) PG8_BAR;
        PG8_WAIT_V(2); PG8_BAR;
        PG8_STAGE(PG8_SB(1, 0), cB + kstep, voffB); PG8_STAGE(PG8_SA(1, 0), cA + kstep, voffA); PG8_STAGE(PG8_SB(1, 1), cB + hstep + kstep, voffB);
        PG8_WAIT_V(6); PG8_BAR;
    } else {
        PG8_STAGE(PG8_SB(0, 0), cB, voffB); PG8_STAGE(PG8_SA(0, 0), cA, voffA); PG8_STAGE(PG8_SB(0, 1), cB + hstep, voffB); PG8_STAGE(PG8_SA(0, 1), cA + hstep, voffA);
        if (wr == 1) PG8_BAR;
        PG8_WAIT_V(4); PG8_BAR;
        PG8_STAGE(PG8_SB(1, 0), cB + kstep, voffB); PG8_STAGE(PG8_SA(1, 0), cA + kstep, voffA); PG8_STAGE(PG8_SB(1, 1), cB + hstep + kstep, voffB);
        PG8_WAIT_V(6); PG8_BAR;
    }
    for (;;) {
        const bool has_next = S.next(ui + 1, nxt);
        const char* nA = has_next ? (const char*)g.A + (size_t)nxt.pm * tstep : cA; const char* nB = has_next ? (const char*)g.Bt + (size_t)nxt.pn * tstep : cB;
        for (int t = 0; t < nt; t += 2) {
            const bool last = (t == nt - 2);
            const char* a1 = cA + (size_t)(t + 1) * kstep;
            const char* a2 = last ? nA : cA + (size_t)(t + 2) * kstep; const char* b2 = last ? nB : cB + (size_t)(t + 2) * kstep;
            const char* a3 = a2 + kstep; const char* b3 = b2 + kstep;
            if (last && has_next) S.a_ready(nxt);
            if constexpr (SP2) {
            PG8_LDB(B0, 0, 0); PG8_LDB(B1, 0, 1); PG8_SCHED; PG8_LDA(At, 0, 0); PG8_STAGE(PG8_SA(1, 1), a1 + hstep, voffA);
            PG8_WAIT_V(8); PG8_WAIT_L(0); PG8_BAR; PG8_MMA(0, 0, At, B0); PG8_MMA(0, 1, At, B1); PG8_BAR; PG8_SCHED;
            PG8_LDA(At, 0, 1); PG8_STAGE(PG8_SB(0, 0), b2, voffB); PG8_STAGE(PG8_SB(0, 1), b2 + hstep, voffB); PG8_STAGE(PG8_SA(0, 0), a2, voffA);
            PG8_WAIT_V(8); PG8_WAIT_L(0); PG8_BAR; PG8_MMA(1, 0, At, B0); PG8_MMA(1, 1, At, B1); PG8_BAR; PG8_SCHED;
            PG8_LDB(B0, 1, 0); PG8_LDB(B1, 1, 1); PG8_SCHED; PG8_LDA(At, 1, 0); PG8_STAGE(PG8_SA(0, 1), a2 + hstep, voffA);
            PG8_WAIT_V(8); PG8_WAIT_L(0); PG8_BAR; PG8_MMA(0, 0, At, B0); PG8_MMA(0, 1, At, B1); PG8_BAR; PG8_SCHED;
            PG8_LDA(At, 1, 1); PG8_STAGE(PG8_SB(1, 0), b3, voffB); PG8_STAGE(PG8_SB(1, 1), b3 + hstep, voffB); PG8_STAGE(PG8_SA(1, 0), a3, voffA);
            PG8_WAIT_V(8); PG8_WAIT_L(0); PG8_BAR; PG8_MMA(1, 0, At, B0); PG8_MMA(1, 1, At, B1); PG8_BAR; PG8_SCHED;
            } else {
            PG8_LDB(B0, 0, 0); PG8_SCHED; PG8_LDA(At, 0, 0); PG8_STAGE(PG8_SA(1, 1), a1 + hstep, voffA);
            PG8_WAIT_L(8); PG8_BAR; PG8_WAIT_L(0); PG8_MMA(0, 0, At, B0); PG8_BAR; PG8_SCHED;
            PG8_LDB(B1, 0, 1); PG8_STAGE(PG8_SB(0, 0), b2, voffB);
            PG8_BAR; PG8_WAIT_L(0); PG8_MMA(0, 1, At, B1); PG8_BAR;
            PG8_LDA(At, 0, 1); PG8_STAGE(PG8_SA(0, 0), a2, voffA);
            PG8_BAR; PG8_WAIT_L(0); PG8_MMA(1, 0, At, B0); PG8_BAR; PG8_SCHED;
            PG8_STAGE(PG8_SB(0, 1), b2 + hstep, voffB);
            PG8_WAIT_V(6); PG8_BAR; PG8_MMA(1, 1, At, B1); PG8_BAR;
            PG8_LDB(B0, 1, 0); PG8_SCHED; PG8_LDA(At, 1, 0); PG8_STAGE(PG8_SA(0, 1), a2 + hstep, voffA);
            PG8_WAIT_L(8); PG8_BAR; PG8_WAIT_L(0); PG8_MMA(0, 0, At, B0); PG8_BAR; PG8_SCHED;
            PG8_LDB(B1, 1, 1); PG8_STAGE(PG8_SB(1, 0), b3, voffB);
            PG8_BAR; PG8_WAIT_L(0); PG8_MMA(0, 1, At, B1); PG8_BAR;
            PG8_LDA(At, 1, 1); PG8_STAGE(PG8_SA(1, 0), a3, voffA);
            PG8_BAR; PG8_WAIT_L(0); PG8_MMA(1, 0, At, B0); PG8_BAR; PG8_SCHED;
            PG8_STAGE(PG8_SB(1, 1), b3 + hstep, voffB);
            PG8_WAIT_V(6); PG8_BAR; PG8_MMA(1, 1, At, B1); PG8_BAR;
            }
        }
        if constexpr (ALIGN_EPI) { if (wr == 0) PG8_BAR; }
        if constexpr (!Epi::AFTER_DRAIN) { E(acc, cur, wr, wc, fr, fq); S.done(cur); }
        if (!has_next) break;
#pragma unroll
        for (int a = 0; a < 2; ++a)
#pragma unroll
            for (int b = 0; b < 2; ++b)
#pragma unroll
                for (int m = 0; m < 4; ++m)
#pragma unroll
                    for (int n = 0; n < 2; ++n) acc[a][b][m][n] = (f32x4){0.f, 0.f, 0.f, 0.f};
        cur = nxt; cA = nA; cB = nB; ++ui;
        if constexpr (ALIGN_EPI) { if (wr == 1) PG8_BAR; }
    }
    PG8_WAIT_V(0);
    if constexpr (!ALIGN_EPI) { if (wr == 0) PG8_BAR; }
    PG8_BAR;
    if constexpr (Epi::AFTER_DRAIN) { E.fused(acc, cur, wr, wc, fr, fq, lds, wid, lane); S.done(cur); }
#undef PG8_SA
#undef PG8_SB
#undef PG8_STAGE
#undef PG8_LDA
#undef PG8_LDB
#undef PG8_MMA
#undef PG8_WAIT_V
#undef PG8_WAIT_L
#undef PG8_BAR
#undef PG8_SCHED
}
}
#ifndef REP_P0
#define REP_P0 1
#endif
#ifndef REP_P1
#define REP_P1 1
#endif
#ifndef REP_P2
#define REP_P2 1
#endif
#ifndef REP_P3
#define REP_P3 1
#endif
#ifndef REP_P4
#define REP_P4 1
#endif
#ifndef REP_P5
#define REP_P5 1
#endif
#ifndef REP_P6
#define REP_P6 1
#endif
#ifndef REP_P8
#define REP_P8 1
#endif

constexpr int NWAVES = 8;
constexpr int DM = 1024, NB = 8, T = 2048, M = NB * T;
constexpr int SB = 32;
constexpr int PAST = 16384;
constexpr int HD = 64, AHEADS = 8, AWID = 512, BHEADS = 16, BWID = 1024;
constexpr int ACOLS = 4608, SCOLS = 3360, SCP = 3584, INCOLS = 10016, INP = 10240;
constexpr int DFF = 2816, GU = 2 * DFF;
constexpr float NORM_EPS = 1e-6f, GN_EPS = 64e-5f;
constexpr float LOG2E = 1.4426950408889634f, LN2 = 0.6931471805599453f;
constexpr float QSCALE = 0.125f * LOG2E;
constexpr size_t O_YP = 0, O_YS = O_YP + (size_t)M * DM, O_KV1P = O_YS + (size_t)SB * DM, O_KV2P = O_KV1P + (size_t)NB * 128 * 1024,
                 O_KV3P = O_KV2P + (size_t)NB * 512 * 1024, O_SHP = O_KV3P + (size_t)NB * 2048 * 1024, O_WKVP = O_SHP + (size_t)NB * SCOLS,
                 O_KV1S = O_WKVP + (size_t)NB * 16 * 4096, O_KV2S = O_KV1S + (size_t)SB * 1024, O_KV3S = O_KV2S + (size_t)SB * 1024,
                 O_SHS = O_KV3S + (size_t)SB * 1024, O_WKVS = O_SHS + (size_t)SB * SCOLS, O_END = O_WKVS + (size_t)SB * 16 * 4096;
static_assert(O_END == 41684224, "output size");
constexpr size_t MiB = 1u << 20;
constexpr size_t WS_CTL = 0, CTL_ZERO_BYTES = 1 * MiB;
constexpr size_t WS_TAB = 1 * MiB;
constexpr size_t WS_SS = 2 * MiB;
constexpr size_t WS_SS2 = WS_SS + 128 * 1024;
constexpr size_t WS_SMP = 3 * MiB;
constexpr size_t WS_WIN = 8 * MiB, WS_WA = 28 * MiB, WS_WB = 29 * MiB, WS_WO = 31 * MiB, WS_WGU = 33 * MiB, WS_WD = 44 * MiB, WS_WWA = 50 * MiB, WS_WG = 51 * MiB;
constexpr size_t WS_XN = 52 * MiB, WS_Q = 84 * MiB, WS_K = 132 * MiB, WS_VT = 180 * MiB, WS_SC = 228 * MiB, WS_GT = 340 * MiB;
constexpr size_t WS_OG = 404 * MiB, WS_LSE = 452 * MiB, WS_OA = 454 * MiB, WS_A1 = 470 * MiB, WS_A2 = 474 * MiB;
constexpr size_t WS_E = 482 * MiB, WS_AV = 514 * MiB, WS_GATE = 546 * MiB, WS_Y = 578 * MiB, WS_CB = 642 * MiB, WS_OB = 643 * MiB;
constexpr size_t WS_Y1 = 675 * MiB, WS_MG = 739 * MiB, WS_X1 = 771 * MiB, WS_X1B = 835 * MiB, WS_END = 867 * MiB;
constexpr size_t WS_ACT = WS_Q;
static_assert((size_t)M * DFF * 2 <= WS_VT - WS_Q, "ACT overlay");
constexpr size_t SM_HSN = 0;
constexpr size_t SM_PROJ = 64 * 1024;
constexpr size_t SM_OA = SM_PROJ + (size_t)SB * INP * 4;
constexpr size_t SM_OB = SM_OA + 32 * 1024;
constexpr size_t SM_YA = SM_OB + 64 * 1024;
constexpr size_t SM_YB = SM_YA + 128 * 1024;
constexpr size_t SM_X1 = SM_YB + 128 * 1024;
constexpr size_t SM_X1B = SM_X1 + 128 * 1024;
constexpr size_t SM_ACT = SM_X1B + 64 * 1024;
constexpr size_t SM_X2 = SM_ACT + 192 * 1024;
constexpr size_t SM_OG = SM_X2 + 128 * 1024;
constexpr size_t SM_LSE = SM_OG + 192 * 1024;
constexpr size_t SM_END = SM_LSE + 4096;
static_assert(SM_END <= 5 * MiB, "sample scratch");
constexpr int CW_BAR = 4096;
constexpr int RING_OFF = 0, RING_BYTES = 131072, LDSCTL_OFF = RING_BYTES, MISC_OFF = LDSCTL_OFF + 320, LDS_BYTES = 147456;

#define GAS __attribute__((address_space(1)))
#define LAS __attribute__((address_space(3)))
typedef unsigned short bf16;
typedef unsigned v4u __attribute__((ext_vector_type(4)));
typedef float f32x4 __attribute__((ext_vector_type(4)));
typedef short bf16x8 __attribute__((ext_vector_type(8)));
typedef GAS unsigned gu32;
typedef GAS unsigned long long gu64;
#define RLX_AGENT __ATOMIC_RELAXED, __HIP_MEMORY_SCOPE_AGENT
#define LDS_WAIT() asm volatile("s_waitcnt lgkmcnt(0)" ::: "memory")
#define VM_WAIT() asm volatile("s_waitcnt vmcnt(0)" ::: "memory")
__device__ __forceinline__ unsigned long long rt() { return __builtin_amdgcn_s_memrealtime(); }
__device__ __forceinline__ unsigned f2bf(float f) { unsigned u = __builtin_bit_cast(unsigned, f); return (u + 0x7fffu + ((u >> 16) & 1u)) >> 16; }
__device__ __forceinline__ unsigned pk2(float lo, float hi) { return f2bf(lo) | (f2bf(hi) << 16); }

#define XB_TMO      128
#define XB_XCNT(j)  (256  + 64 * (j))
#define XB_XSUB(j)  (1280 + 64 * (j))
#define XB_XGEN(j)  (2304 + 64 * (j))
#define XB_TOP      3328
#define XB_TOPGEN   3392
#define XCD_BAR_WORDS 3456
#define XB_SPIN_CAP (1u << 18)

__device__ __forceinline__ unsigned xb_ld(unsigned* p)              { return __hip_atomic_load(p, __ATOMIC_RELAXED, __HIP_MEMORY_SCOPE_AGENT); }
__device__ __forceinline__ unsigned xb_add(unsigned* p, unsigned v) { return __hip_atomic_fetch_add(p, v, __ATOMIC_RELAXED, __HIP_MEMORY_SCOPE_AGENT); }
__device__ __forceinline__ unsigned xb_xcc_id() { return (unsigned)__builtin_amdgcn_s_getreg((3 << 11) | 20) & 0xFu; }
#define XB_SPIN(cond, bar) do { unsigned _sp = 0; while (cond) { __builtin_amdgcn_s_sleep(1); \
    if ((++_sp & 255u) == 0u) { if (xb_ld(&(bar)[XB_TMO])) break; if (_sp > XB_SPIN_CAP) { atomicAdd(&(bar)[XB_TMO], 1u); break; } } } } while (0)

struct XcdBarrier {
    unsigned* bar; unsigned x;
    volatile LAS unsigned* st;
};

__device__ __forceinline__ XcdBarrier xcd_barrier_post(unsigned* bar, volatile LAS unsigned* st) {
    XcdBarrier b; b.bar = bar; b.x = xb_xcc_id(); b.st = st;
    if (threadIdx.x == 0) (void)xb_add(&bar[XB_XCNT(b.x)], 1u);
    return b;
}
__device__ __forceinline__ void xcd_barrier_complete(unsigned* bar, unsigned x, unsigned& nloc, unsigned& nx) {
    const unsigned G = gridDim.x * gridDim.y * gridDim.z;
    unsigned sum, cnt, mine, sp = 0u;
    for (;;) {
        sum = 0u; cnt = 0u; mine = 0u;
#pragma unroll
        for (unsigned j = 0; j < 16; ++j) { const unsigned c = xb_ld(&bar[XB_XCNT(j)]); sum += c; cnt += (c > 0u) ? 1u : 0u; mine = (j == x) ? c : mine; }
        if (sum == G) break;
        __builtin_amdgcn_s_sleep(1);
        if ((++sp & 255u) == 0u) { if (xb_ld(&bar[XB_TMO])) break; if (sp > XB_SPIN_CAP) { atomicAdd(&bar[XB_TMO], 1u); break; } }
    }
    nloc = mine > 0u ? mine : 1u; nx = cnt > 0u ? cnt : 1u;
}

__device__ __forceinline__ void xcd_barrier(const XcdBarrier& b) {
    asm volatile("s_waitcnt vmcnt(0)" ::: "memory");
    __syncthreads();
    if (threadIdx.x == 0) {
        unsigned* bar = b.bar;
        __builtin_amdgcn_s_waitcnt(0);
        unsigned nloc = b.st[0], nx = b.st[1];
        if (nloc == 0u) { xcd_barrier_complete(bar, b.x, nloc, nx); b.st[0] = nloc; b.st[1] = nx; }
        const unsigned old = xb_add(&bar[XB_XSUB(b.x)], 1u);
        const unsigned gen = old / nloc;
        if (old + 1u == (gen + 1u) * nloc) {
            __builtin_amdgcn_fence(__ATOMIC_RELEASE, "agent");
            asm volatile("s_waitcnt vmcnt(0)" ::: "memory");
            const unsigned og = xb_add(&bar[XB_TOP], 1u);
            const unsigned tg = og / nx;
            if (og + 1u == (tg + 1u) * nx) xb_add(&bar[XB_TOPGEN], 1u);
            else XB_SPIN(xb_ld(&bar[XB_TOPGEN]) == tg, bar);
            __builtin_amdgcn_fence(__ATOMIC_ACQUIRE, "agent");
            xb_add(&bar[XB_XGEN(b.x)], 1u);
            asm volatile("s_waitcnt vmcnt(0)" ::: "memory");
        } else {
            XB_SPIN(xb_ld(&bar[XB_XGEN(b.x)]) == gen, bar);
            __builtin_amdgcn_fence(__ATOMIC_ACQUIRE, "agent");
            asm volatile("s_waitcnt vmcnt(0)" ::: "memory");
        }
    }
    __syncthreads();
}

struct Args { const float* in[28]; float* out; unsigned char* ws; };
enum { I_XP = 0, I_XS, I_C1, I_C2, I_C3, I_SSH, I_SWKV, I_NMIX, I_WIN, I_MU, I_W0, I_W2, I_A0, I_A2, I_G2, I_KK, I_KA, I_RK, I_GNW, I_GNB,
       I_WPA, I_WPB, I_WOUT, I_NFFN, I_WGATE, I_WUP, I_WDOWN, I_NFIN };
typedef float f32x2 __attribute__((ext_vector_type(2)));
typedef unsigned u32x2 __attribute__((ext_vector_type(2)));

__device__ __forceinline__ float wave_sum(float v) {
#pragma unroll
    for (int o = 1; o < 64; o <<= 1) v += __shfl_xor(v, o);
    return v;
}
__device__ __forceinline__ float bf2f(unsigned short h) { return __builtin_bit_cast(float, (unsigned)h << 16); }
__device__ __forceinline__ float bflo(unsigned w) { return __builtin_bit_cast(float, w << 16); }
__device__ __forceinline__ float bfhi(unsigned w) { return __builtin_bit_cast(float, w & 0xffff0000u); }
__device__ __forceinline__ float sigmoidf_(float x) { return 1.0f / (1.0f + __expf(-x)); }

__device__ const float ROPE_FREQ[32] = {
    1.000000000e+00f, 7.498942614e-01f, 5.623413324e-01f, 4.216965139e-01f, 3.162277639e-01f, 2.371373773e-01f, 1.778279394e-01f, 1.333521307e-01f,
    1.000000015e-01f, 7.498941571e-02f, 5.623413250e-02f, 4.216965288e-02f, 3.162277490e-02f, 2.371373773e-02f, 1.778279431e-02f, 1.333521493e-02f,
    9.999999776e-03f, 7.498941850e-03f, 5.623413250e-03f, 4.216964822e-03f, 3.162277630e-03f, 2.371373586e-03f, 1.778279431e-03f, 1.333521446e-03f,
    1.000000047e-03f, 7.498942432e-04f, 5.623413017e-04f, 4.216965172e-04f, 3.162277571e-04f, 2.371373703e-04f, 1.778279402e-04f, 1.333521504e-04f};
__device__ __forceinline__ void sincos_acc(float xf, float& s, float& c) {
    const double x = (double)xf;
    const double q = __builtin_rint(x * 0.63661977236758134308);
    double r = __builtin_fma(-q, 1.57079632679489655800e+00, x); r = __builtin_fma(-q, 6.12323399573676603587e-17, r);
    const double r2 = r * r;
    double sp = -1.0 / 1307674368000.0; sp = sp * r2 + 1.0 / 6227020800.0; sp = sp * r2 - 1.0 / 39916800.0; sp = sp * r2 + 1.0 / 362880.0; sp = sp * r2 - 1.0 / 5040.0; sp = sp * r2 + 1.0 / 120.0; sp = sp * r2 - 1.0 / 6.0; sp = sp * r2 + 1.0; sp *= r;
    double cp = 1.0 / 20922789888000.0; cp = cp * r2 - 1.0 / 87178291200.0; cp = cp * r2 + 1.0 / 479001600.0; cp = cp * r2 - 1.0 / 3628800.0; cp = cp * r2 + 1.0 / 40320.0; cp = cp * r2 - 1.0 / 720.0; cp = cp * r2 + 1.0 / 24.0; cp = cp * r2 - 0.5; cp = cp * r2 + 1.0;
    const int qi = (int)((long long)q & 3);
    const double ss = (qi & 1) ? cp : sp, cc = (qi & 1) ? sp : cp;
    s = (float)((qi & 2) ? -ss : ss);
    c = (float)(((qi + 1) & 2) ? -cc : cc);
}

template <class Src> __device__ __forceinline__ void tr_item(const Src& src, bf16* WT, int Kd, LAS float* scr, int k0, int n0, int lane) {
#pragma unroll 8
    for (int i = 0; i < 32; ++i) { const int kk = 2 * i + (lane >> 5); scr[kk * 33 + (lane & 31)] = src(k0 + kk, n0 + (lane & 31)); }
    LDS_WAIT(); asm volatile("" ::: "memory");
    const int c = lane & 7;
#pragma unroll
    for (int j = 0; j < 4; ++j) { const int n = (lane >> 3) + 8 * j; const LAS float* s = scr + (8 * c) * 33 + n;
        v4u o; o.x = pk2(s[0 * 33], s[1 * 33]); o.y = pk2(s[2 * 33], s[3 * 33]); o.z = pk2(s[4 * 33], s[5 * 33]); o.w = pk2(s[6 * 33], s[7 * 33]);
        *(GAS v4u*)(WT + (size_t)(n0 + n) * Kd + k0 + 8 * c) = o; }
    LDS_WAIT(); asm volatile("" ::: "memory");
}
__device__ __forceinline__ int win_src_col(int np) {
    if (np < ACOLS) { const int part = np >> 9, kind = part % 3, within = np & 511, head = within >> 6, pos = within & 63;
        const int d = (kind < 2) ? ((pos & 1) * 32 + (pos >> 1)) : pos; return part * 512 + head * 64 + d; }
    if (np < ACOLS + SCP) { const int j = np - ACOLS; return j < SCOLS ? ACOLS + j : -1; }
    return ACOLS + SCOLS + (np - (ACOLS + SCP));
}

struct TileListOrder {
    pg8::StaticOrder S; int n0, b0, b1;
    __device__ void init(int M_, int nt, int n0_, int b0_, int b1_, int G_, int c_) { S.init(M_, nt * 256, G_, c_); n0 = n0_; b0 = b0_; b1 = b1_; }
    __device__ bool next(int i, pg8::Unit& u) const { if (!S.next(i, u)) return false; u.pn = (u.pn < n0) ? b0 + u.pn : b1 + (u.pn - n0); return true; }
    __device__ __forceinline__ void a_ready(const pg8::Unit&) const {}
    __device__ __forceinline__ void done(const pg8::Unit&) const {}
};
struct EpiIn {
    static constexpr bool PERM = true, AFTER_DRAIN = false;
    bf16* Q; bf16* Kb; bf16* VT; bf16* SC; bf16* GT; float* out; const float* rope;
    __device__ __forceinline__ void operator()(const pg8::f32x4 (&acc)[2][2][4][2], const pg8::Unit& u, int wr, int wc, int fr, int fq) const {
        const int tn = u.pn;
        const int rowb = u.pm * 256 + wr * 64 + fr;
        if (tn < 18) {
            const int part = tn >> 1, g = part / 3, kind = part - 3 * g, hf = tn & 1;
            const int lgd = 2 * g, dil = 1 << lgd, L = T >> lgd, keep = (g == 0) ? 128 : (g == 1) ? 512 : 2048;
            const size_t okv = (g == 0) ? O_KV1P : (g == 1) ? O_KV2P : O_KV3P;
            const int pos0 = 32 * (wc & 1) + 8 * fq;
#pragma unroll
            for (int ai = 0; ai < 2; ++ai)
#pragma unroll
                for (int m = 0; m < 4; ++m) {
                    const int row = rowb + ai * 128 + m * 16, b = row >> 11, t = row & (T - 1);
                    const int p = (t & (dil - 1)) * L + (t >> lgd);
                    const size_t prow = (size_t)g * M + (size_t)b * T + p;
                    const int tk = t - (T - keep);
                    if (kind < 2) {
                        const int i0 = pos0 >> 1;
                        const pg8::f32x4 cs0 = *(const pg8::f32x4*)(rope + ((size_t)t * 32 + i0) * 2), cs1 = *(const pg8::f32x4*)(rope + ((size_t)t * 32 + i0 + 2) * 2);
#pragma unroll
                        for (int bj = 0; bj < 2; ++bj) {
                            const int head = 4 * hf + 2 * bj + (wc >> 1);
                            const pg8::f32x4 v0 = acc[ai][bj][m][0], v1 = acc[ai][bj][m][1];
                            float o[8];
                            o[0] = v0[0] * cs0[0] - v0[1] * cs0[1]; o[1] = v0[0] * cs0[1] + v0[1] * cs0[0];
                            o[2] = v0[2] * cs0[2] - v0[3] * cs0[3]; o[3] = v0[2] * cs0[3] + v0[3] * cs0[2];
                            o[4] = v1[0] * cs1[0] - v1[1] * cs1[1]; o[5] = v1[0] * cs1[1] + v1[1] * cs1[0];
                            o[6] = v1[2] * cs1[2] - v1[3] * cs1[3]; o[7] = v1[2] * cs1[3] + v1[3] * cs1[2];
                            if (kind == 0) {
                                pg8::u32x4 w; w.x = pg8::cvt_pk_bf16(o[0] * QSCALE, o[1] * QSCALE); w.y = pg8::cvt_pk_bf16(o[2] * QSCALE, o[3] * QSCALE);
                                w.z = pg8::cvt_pk_bf16(o[4] * QSCALE, o[5] * QSCALE); w.w = pg8::cvt_pk_bf16(o[6] * QSCALE, o[7] * QSCALE);
                                *(pg8::u32x4*)(Q + prow * 512 + head * 64 + pos0) = w;
                            } else {
                                pg8::u32x4 w; w.x = pg8::cvt_pk_bf16(o[0], o[1]); w.y = pg8::cvt_pk_bf16(o[2], o[3]); w.z = pg8::cvt_pk_bf16(o[4], o[5]); w.w = pg8::cvt_pk_bf16(o[6], o[7]);
                                *(pg8::u32x4*)(Kb + prow * 512 + head * 64 + pos0) = w;
                                if (tk >= 0) { float* ob = out + okv + (((size_t)b * keep + tk) * 2 + 0) * 512 + head * 64;
                                    *(pg8::f32x4*)(ob + i0) = (pg8::f32x4){o[0], o[2], o[4], o[6]}; *(pg8::f32x4*)(ob + 32 + i0) = (pg8::f32x4){o[1], o[3], o[5], o[7]}; }
                            }
                        }
                    } else {
#pragma unroll
                        for (int bj = 0; bj < 2; ++bj) {
                            const int head = 4 * hf + 2 * bj + (wc >> 1);
                            const pg8::f32x4 v0 = acc[ai][bj][m][0], v1 = acc[ai][bj][m][1];
                            pg8::u32x4 w; w.x = pg8::cvt_pk_bf16(v0[0], v0[1]); w.y = pg8::cvt_pk_bf16(v0[2], v0[3]); w.z = pg8::cvt_pk_bf16(v1[0], v1[1]); w.w = pg8::cvt_pk_bf16(v1[2], v1[3]);
                            *(pg8::u32x4*)(VT + prow * 512 + head * 64 + pos0) = w;
                            if (tk >= 0) { float* ob = out + okv + (((size_t)b * keep + tk) * 2 + 1) * 512 + head * 64 + pos0;
                                *(pg8::f32x4*)(ob) = v0; *(pg8::f32x4*)(ob + 4) = v1; }
                        }
                    }
                }
        } else if (tn < 32) {
            const int cb = (tn - 18) * 256 + wc * 32 + 8 * fq;
#pragma unroll
            for (int ai = 0; ai < 2; ++ai)
#pragma unroll
                for (int m = 0; m < 4; ++m) {
                    const int row = rowb + ai * 128 + m * 16, b = row >> 11, t = row & (T - 1);
#pragma unroll
                    for (int bj = 0; bj < 2; ++bj) {
                        const int col = cb + bj * 128;
                        const pg8::f32x4 v0 = acc[ai][bj][m][0], v1 = acc[ai][bj][m][1];
                        pg8::u32x4 w; w.x = pg8::cvt_pk_bf16(v0[0], v0[1]); w.y = pg8::cvt_pk_bf16(v0[2], v0[3]); w.z = pg8::cvt_pk_bf16(v1[0], v1[1]); w.w = pg8::cvt_pk_bf16(v1[2], v1[3]);
                        *(pg8::u32x4*)(SC + (size_t)row * SCP + col) = w;
                        if (t == T - 1 && col < SCOLS) { float* ob = out + O_SHP + (size_t)b * SCOLS + col; *(pg8::f32x4*)(ob) = v0; *(pg8::f32x4*)(ob + 4) = v1; }
                    }
                }
        } else {
            const int cb = (tn - 32) * 256 + wc * 32 + 8 * fq;
#pragma unroll
            for (int ai = 0; ai < 2; ++ai)
#pragma unroll
                for (int m = 0; m < 4; ++m) {
                    const int row = rowb + ai * 128 + m * 16;
#pragma unroll
                    for (int bj = 0; bj < 2; ++bj) {
                        const int col = cb + bj * 128;
                        const pg8::f32x4 v0 = acc[ai][bj][m][0], v1 = acc[ai][bj][m][1];
                        pg8::u32x4 w; w.x = pg8::cvt_pk_bf16(sigmoidf_(v0[0]), sigmoidf_(v0[1])); w.y = pg8::cvt_pk_bf16(sigmoidf_(v0[2]), sigmoidf_(v0[3]));
                        w.z = pg8::cvt_pk_bf16(sigmoidf_(v1[0]), sigmoidf_(v1[1])); w.w = pg8::cvt_pk_bf16(sigmoidf_(v1[2]), sigmoidf_(v1[3]));
                        *(pg8::u32x4*)(GT + (size_t)row * 2048 + col) = w;
                    }
                }
        }
    }
};

__device__ __forceinline__ int opaque_int(int v) { asm volatile("" : "+s"(v)); return v; }
struct Frame {
    LAS unsigned char* lds; volatile LAS unsigned* MISC; gu32* ctl;
    int tid, lane, wave, vcu, G, gw, NGW;
};

__device__ __forceinline__ void p0_prologue(const Frame& F, const Args& a, unsigned char* ws) {
    LAS float* scr = (LAS float*)(F.lds + RING_OFF + F.wave * 16384);
    const int gw = F.gw, NGW = F.NGW, lane = F.lane;
    constexpr int IT_WIN = 16 * (INP / 32), IT_WA = 8 * 32, IT_WB = 16 * 32, IT_WO = 16 * 32, IT_WGU = 16 * (GU / 32), IT_WD = 44 * 32, IT_WWA = 2 * 64, IT_WG = 4 * 32;
    constexpr int NITEMS = IT_WIN + IT_WA + IT_WB + IT_WO + IT_WGU + IT_WD + IT_WWA + IT_WG;
    for (int it = gw; it < NITEMS; it += NGW) {
        int r = it;
        if (r < IT_WIN) { const int nb = r % (INP / 32), kb = r / (INP / 32); const float* W = a.in[I_WIN];
            tr_item([&](int k, int np) { const int sc = win_src_col(np); return sc >= 0 ? W[(size_t)k * INCOLS + sc] : 0.f; }, (bf16*)(ws + WS_WIN), DM, scr, 64 * kb, 32 * nb, lane); continue; }
        r -= IT_WIN;
        if (r < IT_WA) { const int nb = r % 32, kb = r / 32; const float* W = a.in[I_WPA];
            tr_item([&](int k, int n) { return W[(size_t)k * DM + n]; }, (bf16*)(ws + WS_WA), AWID, scr, 64 * kb, 32 * nb, lane); continue; }
        r -= IT_WA;
        if (r < IT_WB) { const int nb = r % 32, kb = r / 32; const float* W = a.in[I_WPB];
            tr_item([&](int k, int n) { return W[(size_t)k * DM + n]; }, (bf16*)(ws + WS_WB), BWID, scr, 64 * kb, 32 * nb, lane); continue; }
        r -= IT_WB;
        if (r < IT_WO) { const int nb = r % 32, kb = r / 32; const float* W = a.in[I_WOUT];
            tr_item([&](int k, int n) { return W[(size_t)k * DM + n]; }, (bf16*)(ws + WS_WO), DM, scr, 64 * kb, 32 * nb, lane); continue; }
        r -= IT_WO;
        if (r < IT_WGU) { const int nb = r % (GU / 32), kb = r / (GU / 32); const int n0 = 32 * nb, tile = n0 >> 8, w0 = n0 & 255;
            const float* W = (w0 < 128) ? a.in[I_WGATE] : a.in[I_WUP]; const float* gsc = a.in[I_NFFN]; const int cbase = tile * 128 + (w0 & 127) - n0;
            tr_item([&](int k, int np) { return W[(size_t)k * DFF + cbase + np] * gsc[k]; }, (bf16*)(ws + WS_WGU), DM, scr, 64 * kb, n0, lane); continue; }
        r -= IT_WGU;
        if (r < IT_WD) { const int nb = r % 32, kb = r / 32; const float* W = a.in[I_WDOWN];
            tr_item([&](int k, int n) { return W[(size_t)k * DM + n]; }, (bf16*)(ws + WS_WD), DFF, scr, 64 * kb, 32 * nb, lane); continue; }
        r -= IT_WD;
        if (r < IT_WWA) { const int nb = r % 64, kb = r / 64; const float* W2 = a.in[I_W2]; const float* A2 = a.in[I_A2];
            tr_item([&](int k, int n) { return (n < 1024) ? (k < 64 ? W2[(size_t)k * BWID + n] : 0.f) : (k >= 64 ? A2[(size_t)(k - 64) * BWID + (n - 1024)] : 0.f); }, (bf16*)(ws + WS_WWA), 128, scr, 64 * kb, 32 * nb, lane); continue; }
        r -= IT_WWA;
        { const int nb = r % 32, kb = r / 32; const float* G2 = a.in[I_G2];
            tr_item([&](int k, int n) { return k < 160 ? G2[(size_t)k * BWID + n] : 0.f; }, (bf16*)(ws + WS_WG), 256, scr, 64 * kb, 32 * nb, lane); }
    }
    {
        const float* gmix = a.in[I_NMIX];
        f32x4 gv[4];
#pragma unroll
        for (int j = 0; j < 4; ++j) gv[j] = *(const f32x4*)(gmix + 4 * lane + 256 * j);
        for (int m = gw; m < M + SB; m += NGW) {
            const float* xrow = (m < M) ? a.in[I_XP] + (size_t)m * DM : a.in[I_XS] + (size_t)(m - M) * DM;
            bf16* orow = (m < M) ? (bf16*)(ws + WS_XN) + (size_t)m * DM : (bf16*)(ws + WS_SMP + SM_HSN) + (size_t)(m - M) * DM;
            const GAS f32x4* xr = (const GAS f32x4*)xrow + lane;
            f32x4 v[4]; float s = 0.f;
#pragma unroll
            for (int j = 0; j < 4; ++j) { v[j] = xr[64 * j]; s += (v[j].x * v[j].x + v[j].y * v[j].y) + (v[j].z * v[j].z + v[j].w * v[j].w); }
            const float rstd = 1.0f / sqrtf(wave_sum(s) * (1.f / DM) + NORM_EPS);
            GAS unsigned long long* o8 = (GAS unsigned long long*)orow + lane;
#pragma unroll
            for (int j = 0; j < 4; ++j) { const f32x4 y = v[j] * rstd * gv[j]; o8[64 * j] = (unsigned long long)pk2(y.x, y.y) | ((unsigned long long)pk2(y.z, y.w) << 32); }
        }
    }
    {
        float* tab = (float*)(ws + WS_TAB);
        for (int e = F.vcu * 512 + F.tid; e < 2049 * 32; e += F.G * 512) {
            const int pi = e >> 5, i = e & 31; const float pos = (pi < 2048) ? (float)pi : (float)PAST;
            const float ang = pos * ROPE_FREQ[i]; float s, c; sincos_acc(ang, s, c);
            *(f32x2*)(tab + 2 * (size_t)e) = (f32x2){c, s};
        }
    }
    {
        float* ss = (float*)(ws + WS_SS);
        for (int e = F.vcu * 512 + F.tid; e < 65536; e += F.G * 512) ss[e] = 0.f;
    }
}


typedef float f32x16 __attribute__((ext_vector_type(16)));
__device__ __forceinline__ float dpp_f(float v, const int ctrl_sel) {
    const int x = __builtin_bit_cast(int, v); int r;
    if (ctrl_sel == 0) r = __builtin_amdgcn_update_dpp(0, x, 0xB1, 0xF, 0xF, true);
    else if (ctrl_sel == 1) r = __builtin_amdgcn_update_dpp(0, x, 0x4E, 0xF, 0xF, true);
    else if (ctrl_sel == 2) r = __builtin_amdgcn_update_dpp(0, x, 0x141, 0xF, 0xF, true);
    else r = __builtin_amdgcn_update_dpp(0, x, 0x140, 0xF, 0xF, true);
    return __builtin_bit_cast(float, r);
}
__device__ __forceinline__ float red4(float v) { v += dpp_f(v, 0); v += dpp_f(v, 1); return v; }
__device__ __forceinline__ float red8(float v) { v = red4(v); v += dpp_f(v, 2); return v; }
__device__ __forceinline__ float red16(float v) { v = red8(v); v += dpp_f(v, 3); return v; }
__device__ __forceinline__ float fma_s(float a, float b, float c) { float r; asm("v_fma_f32 %0, %1, %2, %3" : "=v"(r) : "v"(a), "v"(b), "v"(c)); return r; }
__device__ __forceinline__ float mul_s(float a, float b) { float r; asm("v_mul_f32 %0, %1, %2" : "=v"(r) : "v"(a), "v"(b)); return r; }
__device__ __forceinline__ void red16x2(float& a, float& b) {
    a += dpp_f(a, 0); b += dpp_f(b, 0); a += dpp_f(a, 1); b += dpp_f(b, 1); a += dpp_f(a, 2); b += dpp_f(b, 2); a += dpp_f(a, 3); b += dpp_f(b, 3);
}
__device__ __forceinline__ void red8x2(float& a, float& b) {
    a += dpp_f(a, 0); b += dpp_f(b, 0); a += dpp_f(a, 1); b += dpp_f(b, 1); a += dpp_f(a, 2); b += dpp_f(b, 2);
}
__device__ __forceinline__ float tanh_(float x) { return 1.0f - 2.0f / (1.0f + __expf(2.0f * x)); }
typedef float f32x2_t __attribute__((ext_vector_type(2))); typedef __bf16 bf16x2_t __attribute__((ext_vector_type(2)));
__device__ __forceinline__ unsigned cvtpk_s(float lo, float hi) { f32x2_t v = {lo, hi}; bf16x2_t b = __builtin_convertvector(v, bf16x2_t); return __builtin_bit_cast(unsigned, b); }
__device__ __forceinline__ bf16x8 pack8(const float* p) {
    v4u w; w.x = cvtpk_s(p[0], p[1]); w.y = cvtpk_s(p[2], p[3]); w.z = cvtpk_s(p[4], p[5]); w.w = cvtpk_s(p[6], p[7]);
    return __builtin_bit_cast(bf16x8, w);
}

typedef short v4i16_t __attribute__((ext_vector_type(4)));
__device__ __forceinline__ void attn_unit(int g, int b, int head, int qt, const bf16* Qb, const bf16* Kb, const bf16* VT, bf16* OG, float* LSE, int lane, LAS unsigned char* vl) {
    const int lgd = 2 * g, dil = 1 << lgd, L = T >> lgd;
    const int p0 = qt * 32, r = p0 >> (11 - lgd), u0 = p0 & (L - 1);
    const int q = lane & 31, h = lane >> 5;
    const size_t rb = ((size_t)g * M + (size_t)b * T) * 512 + head * 64;
    const bf16* Qg = Qb + rb; const bf16* Kg = Kb + rb;
    const bf16* Vg = VT + rb;
    bf16x8 qf[4];
#pragma unroll
    for (int ks = 0; ks < 4; ++ks) qf[ks] = *(const bf16x8*)(Qg + (size_t)(p0 + q) * 512 + 16 * ks + 8 * h);
    const int kt0 = (u0 >= 128) ? 0 : 4 - (u0 >> 5);
    const int kbase = r * L + u0 - 128;
    f32x16 s[5];
#pragma unroll
    for (int kt = 0; kt < 5; ++kt) {
        if (kt >= kt0) {
            f32x16 acc = {};
            const bf16* kp = Kg + (size_t)(kbase + 32 * kt + q) * 512 + 8 * h;
#pragma unroll
            for (int ks = 0; ks < 4; ++ks) { const bf16x8 kf = *(const bf16x8*)(kp + 16 * ks); acc = __builtin_amdgcn_mfma_f32_32x32x16_bf16(kf, qf[ks], acc, 0, 0, 0); }
            if (kt == 0) {
#pragma unroll
                for (int rg = 0; rg < 16; ++rg) { const int krow = (rg & 3) + 8 * (rg >> 2) + 4 * h; if (krow < q) acc[rg] = -INFINITY; }
            }
            if (kt == 4) {
#pragma unroll
                for (int rg = 0; rg < 16; ++rg) { const int krow = (rg & 3) + 8 * (rg >> 2) + 4 * h; if (krow > q) acc[rg] = -INFINITY; }
            }
            s[kt] = acc;
        } else {
#pragma unroll
            for (int rg = 0; rg < 16; ++rg) s[kt][rg] = -INFINITY;
        }
    }
    float mx = -INFINITY;
#pragma unroll
    for (int kt = 0; kt < 5; ++kt)
#pragma unroll
        for (int rg = 0; rg < 16; ++rg) mx = fmaxf(mx, s[kt][rg]);
    mx = fmaxf(mx, __shfl_xor(mx, 32));
    float l = 0.f;
#pragma unroll
    for (int kt = 0; kt < 5; ++kt)
#pragma unroll
        for (int rg = 0; rg < 16; ++rg) { const float p = __builtin_amdgcn_exp2f(s[kt][rg] - mx); s[kt][rg] = p; l += p; }
    l += __shfl_xor(l, 32);
    f32x16 o0 = {}, o1 = {};
#pragma unroll
    for (int kt = 0; kt < 5; ++kt) {
        if (kt >= kt0) {
            {
                const bf16* vsrc = Vg + (size_t)(kbase + 32 * kt + (lane >> 3)) * 512 + (lane & 7) * 8;
#pragma unroll
                for (int i = 0; i < 4; ++i) { const v4u t = *(const v4u*)(vsrc + (size_t)(8 * i) * 512); *(LAS v4u*)(vl + ((lane >> 3) + 8 * i) * 192 + (lane & 7) * 16) = t; }
            }
#pragma unroll
            for (int si = 0; si < 2; ++si) {
                float pp[8];
#pragma unroll
                for (int j = 0; j < 8; ++j) pp[j] = s[kt][8 * si + j];
                const bf16x8 pb = pack8(pp);
                const int gi = lane >> 4, i16 = lane & 15;
                LAS unsigned char* tb = vl + (16 * si + 4 * (gi >> 1) + (i16 >> 2)) * 192 + (16 * (gi & 1) + 4 * (i16 & 3)) * 2;
                const v4i16_t a0 = __builtin_amdgcn_ds_read_tr16_b64_v4i16((LAS v4i16_t*)(tb));
                const v4i16_t a1 = __builtin_amdgcn_ds_read_tr16_b64_v4i16((LAS v4i16_t*)(tb + 8 * 192));
                const v4i16_t c0 = __builtin_amdgcn_ds_read_tr16_b64_v4i16((LAS v4i16_t*)(tb + 64));
                const v4i16_t c1 = __builtin_amdgcn_ds_read_tr16_b64_v4i16((LAS v4i16_t*)(tb + 8 * 192 + 64));
                const bf16x8 va = {a0[0], a0[1], a0[2], a0[3], a1[0], a1[1], a1[2], a1[3]}, vc = {c0[0], c0[1], c0[2], c0[3], c1[0], c1[1], c1[2], c1[3]};
                o0 = __builtin_amdgcn_mfma_f32_32x32x16_bf16(va, pb, o0, 0, 0, 0);
                o1 = __builtin_amdgcn_mfma_f32_32x32x16_bf16(vc, pb, o1, 0, 0, 0);
            }
        }
    }
    const float inv = 1.0f / l;
    const int t = r + dil * (u0 + q);
    bf16* op = OG + ((size_t)g * M + (size_t)b * T + t) * 512 + head * 64 + 4 * h;
#pragma unroll
    for (int rg = 0; rg < 4; ++rg) {
        u32x2 w; w.x = pg8::cvt_pk_bf16(o0[4 * rg] * inv, o0[4 * rg + 1] * inv); w.y = pg8::cvt_pk_bf16(o0[4 * rg + 2] * inv, o0[4 * rg + 3] * inv);
        *(u32x2*)(op + 8 * rg) = w;
        u32x2 w2; w2.x = pg8::cvt_pk_bf16(o1[4 * rg] * inv, o1[4 * rg + 1] * inv); w2.y = pg8::cvt_pk_bf16(o1[4 * rg + 2] * inv, o1[4 * rg + 3] * inv);
        *(u32x2*)(op + 32 + 8 * rg) = w2;
    }
    if (h == 0) LSE[((size_t)g * M + (size_t)b * T + t) * 8 + head] = (mx + __builtin_amdgcn_logf(l)) * LN2;
}

__device__ __forceinline__ void r1_rows(const Frame& F, const bf16* SC, const float* mu, bf16* A1, bf16* A2) {
    float mul[6];
#pragma unroll
    for (int i = 0; i < 6; ++i) { const int e = F.lane + 64 * i; mul[i] = (e < 288) ? mu[3072 + e] : 0.f; }
    for (int m = F.gw; m < M; m += F.NGW) {
        const int t = m & (T - 1);
        const bf16* p = SC + (size_t)m * SCP + 3072;
#pragma unroll
        for (int i = 0; i < 6; ++i) {
            const int e = F.lane + 64 * i;
            if (e < 288) {
                const float x = bf2f(p[e]); const float xp = (t > 0) ? bf2f(p[e - SCP]) : 0.f;
                const float xm = x + (xp - x) * mul[i];
                if (e < 64) A1[(size_t)m * 128 + e] = (bf16)f2bf(tanh_(xm));
                else if (e < 128) A1[(size_t)m * 128 + e] = (bf16)f2bf(xm);
                else A2[(size_t)m * 256 + (e - 128)] = (bf16)f2bf(sigmoidf_(xm));
            } else A2[(size_t)m * 256 + (e - 128)] = 0;
        }
    }
}

__device__ __forceinline__ void attn_item(const Frame& F, int item, const bf16* Qb, const bf16* Kb, const bf16* VT, bf16* OG, float* LSE, bf16* OA) {
    const int b = item >> 5, head = (item >> 2) & 7, tb = item & 3;
#pragma unroll 1
    for (int i = 0; i < 6; ++i) {
        const int u = F.wave + 8 * i, g = u >> 4, q = u & 15;
        const int qt = (g == 0) ? (16 * tb + q) : (g == 1) ? ((q >> 2) * 16 + 4 * tb + (q & 3)) : (q * 4 + tb);
        attn_unit(g, b, head, qt, Qb, Kb, VT, OG, LSE, F.lane, F.lds + RING_OFF + F.wave * 8192);
    }
    VM_WAIT(); __syncthreads();
    for (int it = F.tid; it < 512 * 8; it += 512) {
        const int m = b * T + tb * 512 + (it >> 3), cg = head * 8 + (it & 7);
        const float l0 = LSE[(size_t)m * 8 + head], l1 = LSE[((size_t)M + m) * 8 + head], l2 = LSE[((size_t)2 * M + m) * 8 + head];
        const float mx = fmaxf(l0, fmaxf(l1, l2));
        float e0 = __expf(l0 - mx), e1 = __expf(l1 - mx), e2 = __expf(l2 - mx); const float inv = 1.0f / (e0 + e1 + e2); e0 *= inv; e1 *= inv; e2 *= inv;
        const v4u a = *(const v4u*)(OG + (size_t)m * 512 + cg * 8), bb = *(const v4u*)(OG + ((size_t)M + m) * 512 + cg * 8), c = *(const v4u*)(OG + ((size_t)2 * M + m) * 512 + cg * 8);
        v4u o;
        o.x = pg8::cvt_pk_bf16(e0 * bflo(a.x) + e1 * bflo(bb.x) + e2 * bflo(c.x), e0 * bfhi(a.x) + e1 * bfhi(bb.x) + e2 * bfhi(c.x));
        o.y = pg8::cvt_pk_bf16(e0 * bflo(a.y) + e1 * bflo(bb.y) + e2 * bflo(c.y), e0 * bfhi(a.y) + e1 * bfhi(bb.y) + e2 * bfhi(c.y));
        o.z = pg8::cvt_pk_bf16(e0 * bflo(a.z) + e1 * bflo(bb.z) + e2 * bflo(c.z), e0 * bfhi(a.z) + e1 * bfhi(bb.z) + e2 * bfhi(c.z));
        o.w = pg8::cvt_pk_bf16(e0 * bflo(a.w) + e1 * bflo(bb.w) + e2 * bflo(c.w), e0 * bfhi(a.w) + e1 * bfhi(bb.w) + e2 * bfhi(c.w));
        *(v4u*)(OA + (size_t)m * 512 + cg * 8) = o;
    }
    __syncthreads();
}
__device__ __forceinline__ void combine_groups(const Frame& F, const bf16* OG, const float* LSE, bf16* OA) {
    for (int it = F.vcu * 512 + F.tid; it < M * 64; it += F.G * 512) {
        const int m = it >> 6, cg = it & 63, head = cg >> 3;
        const float l0 = LSE[(size_t)m * 8 + head], l1 = LSE[((size_t)M + m) * 8 + head], l2 = LSE[((size_t)2 * M + m) * 8 + head];
        const float mx = fmaxf(l0, fmaxf(l1, l2));
        float e0 = __expf(l0 - mx), e1 = __expf(l1 - mx), e2 = __expf(l2 - mx); const float inv = 1.0f / (e0 + e1 + e2); e0 *= inv; e1 *= inv; e2 *= inv;
        const v4u a = *(const v4u*)(OG + (size_t)m * 512 + cg * 8), b = *(const v4u*)(OG + ((size_t)M + m) * 512 + cg * 8), c = *(const v4u*)(OG + ((size_t)2 * M + m) * 512 + cg * 8);
        v4u o;
        o.x = pg8::cvt_pk_bf16(e0 * bflo(a.x) + e1 * bflo(b.x) + e2 * bflo(c.x), e0 * bfhi(a.x) + e1 * bfhi(b.x) + e2 * bfhi(c.x));
        o.y = pg8::cvt_pk_bf16(e0 * bflo(a.y) + e1 * bflo(b.y) + e2 * bflo(c.y), e0 * bfhi(a.y) + e1 * bfhi(b.y) + e2 * bfhi(c.y));
        o.z = pg8::cvt_pk_bf16(e0 * bflo(a.z) + e1 * bflo(b.z) + e2 * bflo(c.z), e0 * bfhi(a.z) + e1 * bfhi(b.z) + e2 * bfhi(c.z));
        o.w = pg8::cvt_pk_bf16(e0 * bflo(a.w) + e1 * bflo(b.w) + e2 * bflo(c.w), e0 * bfhi(a.w) + e1 * bfhi(b.w) + e2 * bfhi(c.w));
        *(v4u*)(OA + (size_t)m * 512 + cg * 8) = o;
    }
}

struct EpiWA {
    static constexpr bool PERM = true, AFTER_DRAIN = false;
    float* LW; bf16* AV; const float* w0; const float* a0;
    __device__ __forceinline__ void operator()(const pg8::f32x4 (&acc)[2][2][4][2], const pg8::Unit& u, int wr, int wc, int fr, int fq) const {
        const bool isw = u.pn < 4; const int cb = (u.pn & 3) * 256 + wc * 32 + 8 * fq; const float* bias = isw ? w0 : a0;
#pragma unroll
        for (int bj = 0; bj < 2; ++bj) {
            const int col = cb + bj * 128; const f32x4 b0 = *(const f32x4*)(bias + col), b1 = *(const f32x4*)(bias + col + 4);
#pragma unroll
            for (int ai = 0; ai < 2; ++ai)
#pragma unroll
                for (int m = 0; m < 4; ++m) {
                    const int row = u.pm * 256 + wr * 64 + fr + ai * 128 + m * 16;
                    const pg8::f32x4 v0 = acc[ai][bj][m][0], v1 = acc[ai][bj][m][1];
                    float e[8] = {sigmoidf_(v0[0] + b0[0]), sigmoidf_(v0[1] + b0[1]), sigmoidf_(v0[2] + b0[2]), sigmoidf_(v0[3] + b0[3]), sigmoidf_(v1[0] + b1[0]), sigmoidf_(v1[1] + b1[1]), sigmoidf_(v1[2] + b1[2]), sigmoidf_(v1[3] + b1[3])};
                    if (isw) {
#pragma unroll
                        for (int q = 0; q < 8; ++q) { float x = e[q] * -0.60653065971263342f;
                            x += __builtin_bit_cast(float, __builtin_amdgcn_update_dpp(0, __builtin_bit_cast(int, x), 0x111, 0xF, 0xF, true));
                            x += __builtin_bit_cast(float, __builtin_amdgcn_update_dpp(0, __builtin_bit_cast(int, x), 0x112, 0xF, 0xF, true));
                            x += __builtin_bit_cast(float, __builtin_amdgcn_update_dpp(0, __builtin_bit_cast(int, x), 0x114, 0xF, 0xF, true));
                            x += __builtin_bit_cast(float, __builtin_amdgcn_update_dpp(0, __builtin_bit_cast(int, x), 0x118, 0xF, 0xF, true));
                            e[q] = x; }
                        *(f32x4*)(LW + (size_t)row * 1024 + col) = (f32x4){e[0], e[1], e[2], e[3]}; *(f32x4*)(LW + (size_t)row * 1024 + col + 4) = (f32x4){e[4], e[5], e[6], e[7]};
                    } else {
                        pg8::u32x4 w; w.x = pg8::cvt_pk_bf16(e[0], e[1]); w.y = pg8::cvt_pk_bf16(e[2], e[3]); w.z = pg8::cvt_pk_bf16(e[4], e[5]); w.w = pg8::cvt_pk_bf16(e[6], e[7]);
                        *(pg8::u32x4*)(AV + (size_t)row * 1024 + col) = w;
                    }
                }
        }
    }
};
struct EpiPlain {
    static constexpr bool PERM = true, AFTER_DRAIN = false;
    bf16* O; int ldc;
    __device__ __forceinline__ void operator()(const pg8::f32x4 (&acc)[2][2][4][2], const pg8::Unit& u, int wr, int wc, int fr, int fq) const {
        const int cb = u.pn * 256 + wc * 32 + 8 * fq;
#pragma unroll
        for (int ai = 0; ai < 2; ++ai)
#pragma unroll
            for (int m = 0; m < 4; ++m) {
                const int row = u.pm * 256 + wr * 64 + fr + ai * 128 + m * 16;
#pragma unroll
                for (int bj = 0; bj < 2; ++bj) {
                    const pg8::f32x4 v0 = acc[ai][bj][m][0], v1 = acc[ai][bj][m][1];
                    pg8::u32x4 w; w.x = pg8::cvt_pk_bf16(v0[0], v0[1]); w.y = pg8::cvt_pk_bf16(v0[2], v0[3]); w.z = pg8::cvt_pk_bf16(v1[0], v1[1]); w.w = pg8::cvt_pk_bf16(v1[2], v1[3]);
                    *(pg8::u32x4*)(O + (size_t)row * ldc + cb + bj * 128) = w;
                }
            }
    }
};

struct ScanRegs { u32x2 pr, pk, pv, qr, qk, qv, e4, a4; };
__device__ __forceinline__ void scan_load(ScanRegs& R, const bf16* SC, const bf16* E, const bf16* AV, int b, int t, int cr) {
    const size_t m = (size_t)b * T + t; const bf16* p = SC + m * SCP + cr;
    R.pr = *(const u32x2*)(p); R.pk = *(const u32x2*)(p + 1024); R.pv = *(const u32x2*)(p + 2048);
    if (t > 0) { R.qr = *(const u32x2*)(p - SCP); R.qk = *(const u32x2*)(p - SCP + 1024); R.qv = *(const u32x2*)(p - SCP + 2048); }
    else { R.qr = (u32x2){0u, 0u}; R.qk = (u32x2){0u, 0u}; R.qv = (u32x2){0u, 0u}; }
    R.e4 = *(const u32x2*)(E + m * 1024 + cr); R.a4 = *(const u32x2*)(AV + m * 1024 + cr);
}
__device__ __forceinline__ f32x4 bf4(u32x2 w) { return (f32x4){bflo(w.x), bfhi(w.x), bflo(w.y), bfhi(w.y)}; }
__device__ __forceinline__ void scan_phase(const Frame& F, const Args& a, unsigned char* ws, int first, int stride) {
    const bf16* SC = (const bf16*)(ws + WS_SC); const bf16* E = (const bf16*)(ws + WS_E); const bf16* AV = (const bf16*)(ws + WS_AV);
    float* Y = (float*)(ws + WS_Y); float* CB = (float*)(ws + WS_CB);
    LAS float* L = (LAS float*)(F.lds + RING_OFF); LAS float* YB = (LAS float*)(F.lds + RING_OFF + 49152);
    const int tid = F.tid, lane = F.lane, wave = F.wave;
    for (int chain = first; chain < NB * BHEADS; chain += stride) {
        const int b = chain >> 4, head = chain & 15;
        const int ss = tid >> 4, j4 = (tid & 15) * 4, cr = head * 64 + j4;
        const f32x4 mur = *(const f32x4*)(a.in[I_MU] + cr), muk = *(const f32x4*)(a.in[I_MU] + 1024 + cr), muv = *(const f32x4*)(a.in[I_MU] + 2048 + cr);
        const f32x4 kkw = *(const f32x4*)(a.in[I_KK] + cr), kaw = *(const f32x4*)(a.in[I_KA] + cr), rkw = *(const f32x4*)(a.in[I_RK] + cr);
        const int rloc8 = 8 * wave + (lane >> 3), c8 = (lane & 7) * 8;
        f32x4 Sa = {0.f, 0.f, 0.f, 0.f}, Sb = {0.f, 0.f, 0.f, 0.f};
        ScanRegs cur, nxt; scan_load(cur, SC, E, AV, b, ss, cr);
        for (int ch = 0; ch < T / 32; ++ch) {
            const int t0 = ch * 32;
            if (ch + 1 < T / 32) scan_load(nxt, SC, E, AV, b, t0 + 32 + ss, cr); else nxt = cur;
            {
                const f32x4 pr = bf4(cur.pr), pk = bf4(cur.pk), pv = bf4(cur.pv), qr = bf4(cur.qr), qk = bf4(cur.qk), qv = bf4(cur.qv);
                const f32x4 r = pr + (qr - pr) * mur, k = pk + (qk - pk) * muk, v = pv + (qv - pv) * muv;
                const f32x4 ev = bf4(cur.e4), av = bf4(cur.a4);
                f32x4 w; w[0] = __expf(-ev[0]); w[1] = __expf(-ev[1]); w[2] = __expf(-ev[2]); w[3] = __expf(-ev[3]);
                const f32x4 kr = k * kkw;
                const float n2 = red16((kr[0] * kr[0] + kr[1] * kr[1]) + (kr[2] * kr[2] + kr[3] * kr[3]));
                const float rn = 1.0f / fmaxf(sqrtf(n2), 1e-12f);
                const f32x4 kk = kr * rn;
                const f32x4 kp = k * (1.0f + (av - 1.0f) * kaw);
                const f32x4 bb = kk * av;
                const f32x4 rkk = r * kp * rkw;
                const float cb = red16((rkk[0] + rkk[1]) + (rkk[2] + rkk[3]));
                LAS float* d = L + ss * 384 + j4;
                *(LAS f32x4*)(d) = w; *(LAS f32x4*)(d + 64) = kk; *(LAS f32x4*)(d + 128) = bb; *(LAS f32x4*)(d + 192) = kp; *(LAS f32x4*)(d + 256) = r; *(LAS f32x4*)(d + 320) = v;
                if ((tid & 15) == 0) CB[((size_t)b * T + t0 + ss) * 16 + head] = cb;
            }
            __syncthreads();
            {
                const int k8 = lane & 7;
                const LAS float* d0 = L + k8 * 8; const LAS float* dv = L + 320 + rloc8;
                f32x4 w0 = *(const LAS f32x4*)(d0), w1 = *(const LAS f32x4*)(d0 + 4), kka = *(const LAS f32x4*)(d0 + 64), kkb = *(const LAS f32x4*)(d0 + 68), bba = *(const LAS f32x4*)(d0 + 128), bbb = *(const LAS f32x4*)(d0 + 132),
                      kpa = *(const LAS f32x4*)(d0 + 192), kpb = *(const LAS f32x4*)(d0 + 196), ra = *(const LAS f32x4*)(d0 + 256), rb = *(const LAS f32x4*)(d0 + 260);
                float vi = dv[0];
                float py = 0.f, yk0 = 0.f, yk1 = 0.f, yk2 = 0.f, yk3 = 0.f;
#pragma unroll
                for (int si = 0; si < 32; ++si) {
                    const int sn = (si + 1 < 32) ? (si + 1) : 31;
                    const LAS float* d = d0 + sn * 384;
                    const f32x4 w0n = *(const LAS f32x4*)(d), w1n = *(const LAS f32x4*)(d + 4), kkan = *(const LAS f32x4*)(d + 64), kkbn = *(const LAS f32x4*)(d + 68), bban = *(const LAS f32x4*)(d + 128), bbbn = *(const LAS f32x4*)(d + 132),
                                kpan = *(const LAS f32x4*)(d + 192), kpbn = *(const LAS f32x4*)(d + 196), ran = *(const LAS f32x4*)(d + 256), rbn = *(const LAS f32x4*)(d + 260);
                    const float vin = dv[sn * 384];
                    const f32x4 pa = Sa * kka + Sb * kkb;
                    float ps = (pa[0] + pa[1]) + (pa[2] + pa[3]);
                    red8x2(ps, py);
                    if (si > 0) { const int q = si - 1; if (q < 8) yk0 = (k8 == q) ? py : yk0; else if (q < 16) yk1 = (k8 == q - 8) ? py : yk1; else if (q < 24) yk2 = (k8 == q - 16) ? py : yk2; else yk3 = (k8 == q - 24) ? py : yk3; }
                    const float sa = -ps;
                    Sa = Sa * w0 + (sa * bba + vi * kpa); Sb = Sb * w1 + (sa * bbb + vi * kpb);
                    const f32x4 pb = Sa * ra + Sb * rb;
                    py = (pb[0] + pb[1]) + (pb[2] + pb[3]);
                    w0 = w0n; w1 = w1n; kka = kkan; kkb = kkbn; bba = bban; bbb = bbbn; kpa = kpan; kpb = kpbn; ra = ran; rb = rbn; vi = vin;
                }
                py = red8(py); yk3 = (k8 == 7) ? py : yk3;
                YB[k8 * 64 + rloc8] = yk0; YB[(8 + k8) * 64 + rloc8] = yk1; YB[(16 + k8) * 64 + rloc8] = yk2; YB[(24 + k8) * 64 + rloc8] = yk3;
            }
            __syncthreads();
            {
                const f32x4 yv = *(const LAS f32x4*)(YB + ss * 64 + j4);
                *(f32x4*)(Y + ((size_t)b * T + t0 + ss) * 1024 + head * 64 + j4) = yv;
            }
            cur = nxt;
        }
        { float* so = a.out + O_WKVP + (((size_t)b * 16 + head) * 64 + rloc8) * 64 + c8; *(f32x4*)(so) = Sa; *(f32x4*)(so + 4) = Sb; }
        __syncthreads();
    }
}

__device__ __forceinline__ void r3_rows(const Frame& F, const Args& a, unsigned char* ws) {
    const bf16* SC = (const bf16*)(ws + WS_SC); const bf16* GATE = (const bf16*)(ws + WS_GATE); const float* Y = (const float*)(ws + WS_Y); const float* CB = (const float*)(ws + WS_CB);
    bf16* OB = (bf16*)(ws + WS_OB);
    const int lane = F.lane, c0 = 16 * lane, head = lane >> 2;
    f32x4 gw[4], gb[4], mv[4];
#pragma unroll
    for (int j = 0; j < 4; ++j) { gw[j] = *(const f32x4*)(a.in[I_GNW] + c0 + 4 * j); gb[j] = *(const f32x4*)(a.in[I_GNB] + c0 + 4 * j); mv[j] = *(const f32x4*)(a.in[I_MU] + 2048 + c0 + 4 * j); }
    for (int m = F.gw; m < M; m += F.NGW) {
        const int t = m & (T - 1);
        f32x4 y[4]; float s = 0.f;
#pragma unroll
        for (int j = 0; j < 4; ++j) { y[j] = *(const f32x4*)(Y + (size_t)m * 1024 + c0 + 4 * j); s += (y[j][0] + y[j][1]) + (y[j][2] + y[j][3]); }
        const float mean = red4(s) * (1.0f / 64.0f); float q = 0.f;
#pragma unroll
        for (int j = 0; j < 4; ++j) { y[j] = y[j] - mean; q += (y[j][0] * y[j][0] + y[j][1] * y[j][1]) + (y[j][2] * y[j][2] + y[j][3] * y[j][3]); }
        const float rs = 1.0f / sqrtf(red4(q) * (1.0f / 64.0f) + GN_EPS);
        const float cb = CB[(size_t)m * 16 + head];
        const bf16* p = SC + (size_t)m * SCP + 2048 + c0;
        const v4u p0 = *(const v4u*)(p), p1 = *(const v4u*)(p + 8);
        v4u q0 = {0u, 0u, 0u, 0u}, q1 = {0u, 0u, 0u, 0u};
        if (t > 0) { q0 = *(const v4u*)(p - SCP); q1 = *(const v4u*)(p - SCP + 8); }
        const v4u g0 = *(const v4u*)(GATE + (size_t)m * 1024 + c0), g1 = *(const v4u*)(GATE + (size_t)m * 1024 + c0 + 8);
        const unsigned pw[8] = {p0.x, p0.y, p0.z, p0.w, p1.x, p1.y, p1.z, p1.w}, qw[8] = {q0.x, q0.y, q0.z, q0.w, q1.x, q1.y, q1.z, q1.w}, gw8[8] = {g0.x, g0.y, g0.z, g0.w, g1.x, g1.y, g1.z, g1.w};
        unsigned ow[8];
#pragma unroll
        for (int e = 0; e < 8; ++e) {
            const int j = e >> 1, i0 = (e & 1) * 2;
            const float pa = bflo(pw[e]), pb = bfhi(pw[e]), qa = bflo(qw[e]), qb = bfhi(qw[e]);
            const float va = pa + (qa - pa) * mv[j][i0], vb = pb + (qb - pb) * mv[j][i0 + 1];
            const float oa = (y[j][i0] * rs * gw[j][i0] + gb[j][i0] + cb * va) * bflo(gw8[e]);
            const float ob = (y[j][i0 + 1] * rs * gw[j][i0 + 1] + gb[j][i0 + 1] + cb * vb) * bfhi(gw8[e]);
            ow[e] = pg8::cvt_pk_bf16(oa, ob);
        }
        *(v4u*)(OB + (size_t)m * 1024 + c0) = (v4u){ow[0], ow[1], ow[2], ow[3]};
        *(v4u*)(OB + (size_t)m * 1024 + c0 + 8) = (v4u){ow[4], ow[5], ow[6], ow[7]};
    }
}

struct EpiPA {
    static constexpr bool PERM = true, AFTER_DRAIN = false;
    const bf16* GT; float* Y1;
    __device__ __forceinline__ void operator()(const pg8::f32x4 (&acc)[2][2][4][2], const pg8::Unit& u, int wr, int wc, int fr, int fq) const {
        const int cb = u.pn * 256 + wc * 32 + 8 * fq;
#pragma unroll
        for (int ai = 0; ai < 2; ++ai)
#pragma unroll
            for (int m = 0; m < 4; ++m) {
                const int row = u.pm * 256 + wr * 64 + fr + ai * 128 + m * 16;
#pragma unroll
                for (int bj = 0; bj < 2; ++bj) {
                    const int col = cb + bj * 128; const v4u gq = *(const v4u*)(GT + (size_t)row * 2048 + col);
                    const pg8::f32x4 v0 = acc[ai][bj][m][0], v1 = acc[ai][bj][m][1];
                    *(f32x4*)(Y1 + (size_t)row * 1024 + col) = (f32x4){v0[0] * bflo(gq.x), v0[1] * bfhi(gq.x), v0[2] * bflo(gq.y), v0[3] * bfhi(gq.y)};
                    *(f32x4*)(Y1 + (size_t)row * 1024 + col + 4) = (f32x4){v1[0] * bflo(gq.z), v1[1] * bfhi(gq.z), v1[2] * bflo(gq.w), v1[3] * bfhi(gq.w)};
                }
            }
    }
};
struct EpiPB {
    static constexpr bool PERM = true, AFTER_DRAIN = false;
    const bf16* GT; const float* Y1; bf16* MG;
    __device__ __forceinline__ void operator()(const pg8::f32x4 (&acc)[2][2][4][2], const pg8::Unit& u, int wr, int wc, int fr, int fq) const {
        const int cb = u.pn * 256 + wc * 32 + 8 * fq;
#pragma unroll
        for (int ai = 0; ai < 2; ++ai)
#pragma unroll
            for (int m = 0; m < 4; ++m) {
                const int row = u.pm * 256 + wr * 64 + fr + ai * 128 + m * 16;
#pragma unroll
                for (int bj = 0; bj < 2; ++bj) {
                    const int col = cb + bj * 128; const v4u gq = *(const v4u*)(GT + (size_t)row * 2048 + 1024 + col);
                    const f32x4 y0 = *(const f32x4*)(Y1 + (size_t)row * 1024 + col), y1 = *(const f32x4*)(Y1 + (size_t)row * 1024 + col + 4);
                    const pg8::f32x4 v0 = acc[ai][bj][m][0], v1 = acc[ai][bj][m][1];
                    pg8::u32x4 w; w.x = pg8::cvt_pk_bf16(y0[0] + v0[0] * bflo(gq.x), y0[1] + v0[1] * bfhi(gq.x)); w.y = pg8::cvt_pk_bf16(y0[2] + v0[2] * bflo(gq.y), y0[3] + v0[3] * bfhi(gq.y));
                    w.z = pg8::cvt_pk_bf16(y1[0] + v1[0] * bflo(gq.z), y1[1] + v1[1] * bfhi(gq.z)); w.w = pg8::cvt_pk_bf16(y1[2] + v1[2] * bflo(gq.w), y1[3] + v1[3] * bfhi(gq.w));
                    *(pg8::u32x4*)(MG + (size_t)row * 1024 + col) = w;
                }
            }
    }
};
struct EpiRes {
    static constexpr bool PERM = true, AFTER_DRAIN = false;
    const float* base; float* Xo; bf16* Xb; float* ssq;
    __device__ __forceinline__ void operator()(const pg8::f32x4 (&acc)[2][2][4][2], const pg8::Unit& u, int wr, int wc, int fr, int fq) const {
        const int cb = u.pn * 256 + wc * 32 + 8 * fq;
#pragma unroll
        for (int ai = 0; ai < 2; ++ai)
#pragma unroll
            for (int m = 0; m < 4; ++m) {
                const int row = u.pm * 256 + wr * 64 + fr + ai * 128 + m * 16; float sq = 0.f;
#pragma unroll
                for (int bj = 0; bj < 2; ++bj) {
                    const int col = cb + bj * 128;
                    const f32x4 x0 = *(const f32x4*)(base + (size_t)row * 1024 + col), x1 = *(const f32x4*)(base + (size_t)row * 1024 + col + 4);
                    const pg8::f32x4 a0 = acc[ai][bj][m][0], a1 = acc[ai][bj][m][1];
                    const f32x4 o0 = {x0[0] + a0[0], x0[1] + a0[1], x0[2] + a0[2], x0[3] + a0[3]}, o1 = {x1[0] + a1[0], x1[1] + a1[1], x1[2] + a1[2], x1[3] + a1[3]};
                    *(f32x4*)(Xo + (size_t)row * 1024 + col) = o0; *(f32x4*)(Xo + (size_t)row * 1024 + col + 4) = o1;
                    sq += (o0[0] * o0[0] + o0[1] * o0[1]) + (o0[2] * o0[2] + o0[3] * o0[3]) + (o1[0] * o1[0] + o1[1] * o1[1]) + (o1[2] * o1[2] + o1[3] * o1[3]);
                    if (Xb) { pg8::u32x4 w; w.x = pg8::cvt_pk_bf16(o0[0], o0[1]); w.y = pg8::cvt_pk_bf16(o0[2], o0[3]); w.z = pg8::cvt_pk_bf16(o1[0], o1[1]); w.w = pg8::cvt_pk_bf16(o1[2], o1[3]);
                        *(pg8::u32x4*)(Xb + (size_t)row * 1024 + col) = w; }
                }
                sq += __shfl_xor(sq, 16); sq += __shfl_xor(sq, 32);
                if (fq == 0) atomicAdd(ssq + row, sq);
            }
    }
};
struct EpiGU {
    static constexpr bool PERM = true, AFTER_DRAIN = false;
    const float* ssq; bf16* ACT;
    __device__ __forceinline__ void operator()(const pg8::f32x4 (&acc)[2][2][4][2], const pg8::Unit& u, int wr, int wc, int fr, int fq) const {
        const int col = u.pn * 128 + wc * 32 + 8 * fq;
#pragma unroll
        for (int ai = 0; ai < 2; ++ai)
#pragma unroll
            for (int m = 0; m < 4; ++m) {
                const int row = u.pm * 256 + wr * 64 + fr + ai * 128 + m * 16;
                const float rstd = 1.0f / sqrtf(ssq[row] * (1.0f / DM) + NORM_EPS);
                float o[8];
#pragma unroll
                for (int n = 0; n < 2; ++n)
#pragma unroll
                    for (int j = 0; j < 4; ++j) { const float gv = acc[ai][0][m][n][j] * rstd, uv = acc[ai][1][m][n][j] * rstd; o[4 * n + j] = gv * sigmoidf_(gv) * uv; }
                pg8::u32x4 w; w.x = pg8::cvt_pk_bf16(o[0], o[1]); w.y = pg8::cvt_pk_bf16(o[2], o[3]); w.z = pg8::cvt_pk_bf16(o[4], o[5]); w.w = pg8::cvt_pk_bf16(o[6], o[7]);
                *(pg8::u32x4*)(ACT + (size_t)row * DFF + col) = w;
            }
    }
};

__device__ __forceinline__ f32x16 sgemm32_tile(const bf16* A, int lda, const bf16* Bt, int K, int n0, int lane) {
    const int r = lane & 31, h = lane >> 5;
    const bf16* ap = A + (size_t)r * lda + 8 * h; const bf16* bp = Bt + (size_t)(n0 + r) * K + 8 * h;
    f32x16 acc = {};
#pragma unroll 8
    for (int k = 0; k < K; k += 16) { const bf16x8 av = *(const bf16x8*)(ap + k), bv = *(const bf16x8*)(bp + k); acc = __builtin_amdgcn_mfma_f32_32x32x16_bf16(av, bv, acc, 0, 0, 0); }
    return acc;
}
#define SROW(rg, h) (((rg) & 3) + 8 * ((rg) >> 2) + 4 * (h))

template <int NT, class AF, class EP>
__device__ __forceinline__ void sgemm32_block(const Frame& F, int K, const bf16* Bt, const int (&n0)[NT], const AF& afrag, const EP& epi) {
    LAS float* red = (LAS float*)(F.lds + RING_OFF);
    const int lane = F.lane, r = lane & 31, h = lane >> 5, kw = K / 8, k0 = F.wave * kw;
    f32x16 acc[NT];
#pragma unroll
    for (int t = 0; t < NT; ++t) acc[t] = (f32x16){};
#pragma unroll 2
    for (int k = k0; k < k0 + kw; k += 16) {
        const bf16x8 av = afrag(k);
#pragma unroll
        for (int t = 0; t < NT; ++t) { const bf16x8 bv = *(const bf16x8*)(Bt + (size_t)(n0[t] + r) * K + k + 8 * h); acc[t] = __builtin_amdgcn_mfma_f32_32x32x16_bf16(av, bv, acc[t], 0, 0, 0); }
    }
#pragma unroll
    for (int t = 0; t < NT; ++t)
#pragma unroll
        for (int rg = 0; rg < 16; ++rg) red[((t * 8 + F.wave) * 16 + rg) * 64 + lane] = acc[t][rg];
    __syncthreads();
#pragma unroll
    for (int j = 0; j < 2; ++j) {
        const int idx = F.tid + 512 * j, rg = idx >> 6, l2 = idx & 63;
        float v[NT];
#pragma unroll
        for (int t = 0; t < NT; ++t) { float s = 0.f;
#pragma unroll
            for (int w = 0; w < 8; ++w) s += red[((t * 8 + w) * 16 + rg) * 64 + l2];
            v[t] = s; }
        epi(SROW(rg, l2 >> 5), l2 & 31, v);
    }
    __syncthreads();
}
__device__ __forceinline__ float half_sum32(float v) {
    v = red16(v); v += __shfl_xor(v, 16); return v;
}

__device__ __forceinline__ void s_inproj(const Frame& F, unsigned char* ws) {
    float* PROJ = (float*)(ws + WS_SMP + SM_PROJ); const bf16* A = (const bf16*)(ws + WS_SMP + SM_HSN);
    for (int tl = F.vcu; tl < INP / 64; tl += F.G) {
        const int n0[2] = {64 * tl, 64 * tl + 32};
        sgemm32_block<2>(F, DM, (const bf16*)(ws + WS_WIN), n0, [&](int k) { return *(const bf16x8*)(A + (size_t)(F.lane & 31) * DM + k + 8 * (F.lane >> 5)); },
            [&](int row, int c, const float (&v)[2]) { PROJ[(size_t)row * INP + n0[0] + c] = v[0]; PROJ[(size_t)row * INP + n0[1] + c] = v[1]; });
    }
}

__device__ __forceinline__ float block_max(float v, LAS float* red, int tid) {
#pragma unroll
    for (int o = 1; o < 64; o <<= 1) v = fmaxf(v, __shfl_xor(v, o));
    __syncthreads(); if ((tid & 63) == 0) red[tid >> 6] = v; __syncthreads();
    float r = red[0];
#pragma unroll
    for (int i = 1; i < 8; ++i) r = fmaxf(r, red[i]);
    return r;
}
__device__ __forceinline__ float block_sum(float v, LAS float* red, int tid) {
    v = wave_sum(v);
    __syncthreads(); if ((tid & 63) == 0) red[tid >> 6] = v; __syncthreads();
    float r = 0.f;
#pragma unroll
    for (int i = 0; i < 8; ++i) r += red[i];
    return r;
}

__device__ __forceinline__ void s_attn_item(const Frame& F, const Args& a, unsigned char* ws, int b, int head) {
    const float* PROJ = (const float*)(ws + WS_SMP + SM_PROJ) + (size_t)b * INP; const float* tab = (const float*)(ws + WS_TAB) + (size_t)2048 * 64;
    LAS float* sm = (LAS float*)(F.lds + RING_OFF);
    LAS float* qn = sm;
    LAS float* kn = sm + 64;
    LAS float* vn = sm + 128;
    LAS float* pj = sm + 192;
    LAS float* red = sm + 336;
    LAS float* part = sm + 352;
    LAS float* og = sm + 864;
    LAS float* lse = sm + 1056;
    const int tid = F.tid;
    for (int g = 0; g < 3; ++g) {
        const int dil = 1 << (2 * g), buf = (g == 0) ? 128 : (g == 1) ? 512 : 2048;
        const float* cache = a.in[I_C1 + g]; const size_t okv = (g == 0) ? O_KV1S : (g == 1) ? O_KV2S : O_KV3S;
        __syncthreads();
        if (tid < 64) {
            const int i = tid & 31, isk = tid >> 5; const float* src = PROJ + (3 * g + isk) * 512 + head * 64;
            const float x1 = src[2 * i], x2 = src[2 * i + 1], c = tab[2 * i], s = tab[2 * i + 1];
            const float o1 = x1 * c - x2 * s, o2 = x1 * s + x2 * c;
            if (isk == 0) { qn[i] = o1 * 0.125f; qn[32 + i] = o2 * 0.125f; }
            else { kn[i] = o1; kn[32 + i] = o2; float* ob = a.out + okv + ((size_t)b * 2 + 0) * 512 + head * 64; ob[i] = o1; ob[32 + i] = o2; }
        } else if (tid < 128) {
            const int d = tid - 64; const float v = PROJ[(3 * g + 2) * 512 + head * 64 + d]; vn[d] = v; a.out[okv + ((size_t)b * 2 + 1) * 512 + head * 64 + d] = v;
        }
        __syncthreads();
        const int j = tid >> 2, pt = tid & 3;
        const size_t crow = ((size_t)b * buf + (buf - dil * (j + 1))) * 2;
        const float* kc = cache + ((crow + 0) * 8 + head) * 64 + 16 * pt;
        float sc = 0.f;
#pragma unroll
        for (int d4 = 0; d4 < 4; ++d4) { const f32x4 kv = *(const f32x4*)(kc + 4 * d4); sc += kv[0] * qn[16 * pt + 4 * d4] + kv[1] * qn[16 * pt + 4 * d4 + 1] + kv[2] * qn[16 * pt + 4 * d4 + 2] + kv[3] * qn[16 * pt + 4 * d4 + 3]; }
        sc = red4(sc);
        float snew = 0.f;
        if (tid < 64) snew = qn[tid] * kn[tid];
        snew = block_sum(snew, red, tid);
        const float mx = fmaxf(block_max(sc, red, tid), snew);
        const float pe = __expf(sc - mx), pn = __expf(snew - mx);
        if (pt == 0) pj[j] = pe;
        if (tid == 0) pj[128] = pn;
        const float den = block_sum(pt == 0 ? pe : 0.f, red, tid) + pn;
        const int d = tid & 63, kg = tid >> 6; float acc = 0.f;
#pragma unroll 4
        for (int jj = 0; jj < 16; ++jj) { const int j2 = kg * 16 + jj; const size_t cr2 = ((size_t)b * buf + (buf - dil * (j2 + 1))) * 2; acc += pj[j2] * cache[((cr2 + 1) * 8 + head) * 64 + d]; }
        if (kg == 0) acc += pj[128] * vn[d];
        part[kg * 64 + d] = acc;
        __syncthreads();
        if (tid < 64) { float o = 0.f;
#pragma unroll
            for (int k2 = 0; k2 < 8; ++k2) o += part[k2 * 64 + tid];
            og[g * 64 + tid] = o / den; }
        if (tid == 0) lse[g] = mx + __logf(den);
    }
    __syncthreads();
    if (tid < 64) {
        const float l0 = lse[0], l1 = lse[1], l2 = lse[2], mx = fmaxf(l0, fmaxf(l1, l2));
        const float e0 = __expf(l0 - mx), e1 = __expf(l1 - mx), e2 = __expf(l2 - mx), inv = 1.0f / (e0 + e1 + e2);
        const float o = (e0 * og[tid] + e1 * og[64 + tid] + e2 * og[128 + tid]) * inv;
        ((bf16*)(ws + WS_SMP + SM_OA))[(size_t)b * 512 + head * 64 + tid] = (bf16)f2bf(o);
    }
    __syncthreads();
}

__device__ __forceinline__ void s_rwkv_item(const Frame& F, const Args& a, unsigned char* ws, int b, int head) {
    const float* P = (const float*)(ws + WS_SMP + SM_PROJ) + (size_t)b * INP + ACOLS;
    const float* prev = a.in[I_SSH] + (size_t)b * SCOLS; const float* mu = a.in[I_MU];
    LAS float* sm = (LAS float*)(F.lds + RING_OFF);
    LAS float* xl = sm;
    LAS float* rr = sm + 288;
    LAS float* kr = sm + 352;
    LAS float* vv = sm + 416;
    LAS float* part = sm + 480;
    LAS float* wv = sm + 2016;
    LAS float* av = sm + 2080;
    LAS float* gv = sm + 2144;
    LAS float* kkv = sm + 2208;
    LAS float* kpv = sm + 2272;
    LAS float* bbv = sm + 2336;
    LAS float* yv = sm + 2400;
    LAS float* red = sm + 2464;
    const int tid = F.tid, hc0 = head * 64;
    __syncthreads();
    if (tid < 288) { const int c = 3072 + tid; const float x = P[c], xm = x + (prev[c] - x) * mu[c];
        xl[tid] = (tid < 64) ? tanh_(xm) : (tid < 128) ? xm : sigmoidf_(xm); }
    else if (tid < 288 + 192) { const int e = tid - 288, which = e >> 6, d = e & 63, c = which * 1024 + hc0 + d; const float x = P[c], xm = x + (prev[c] - x) * mu[c];
        if (which == 0) rr[d] = xm; else if (which == 1) kr[d] = xm; else vv[d] = xm; }
    __syncthreads();
    {
        const int c = tid & 63, sl = tid >> 6; const float* W2 = a.in[I_W2] + hc0 + c; const float* A2 = a.in[I_A2] + hc0 + c; const float* G2 = a.in[I_G2] + hc0 + c;
        float sw = 0.f, sa = 0.f, sg = 0.f;
#pragma unroll
        for (int e = 0; e < 8; ++e) { const int k = sl * 8 + e; sw += xl[k] * W2[(size_t)k * BWID]; sa += xl[64 + k] * A2[(size_t)k * BWID]; }
#pragma unroll 4
        for (int e = 0; e < 20; ++e) { const int k = sl * 20 + e; sg += xl[128 + k] * G2[(size_t)k * BWID]; }
        part[sl * 64 + c] = sw; part[512 + sl * 64 + c] = sa; part[1024 + sl * 64 + c] = sg;
    }
    __syncthreads();
    float n2p = 0.f;
    if (tid < 64) {
        float sw = 0.f, sa = 0.f, sg = 0.f;
#pragma unroll
        for (int s2 = 0; s2 < 8; ++s2) { sw += part[s2 * 64 + tid]; sa += part[512 + s2 * 64 + tid]; sg += part[1024 + s2 * 64 + tid]; }
        const float e = 0.60653065971263342f * sigmoidf_(a.in[I_W0][hc0 + tid] + sw);
        wv[tid] = __expf(-e); const float aa = sigmoidf_(a.in[I_A0][hc0 + tid] + sa); av[tid] = aa; gv[tid] = sg;
        const float kraw = kr[tid] * a.in[I_KK][hc0 + tid]; n2p = kraw * kraw; kkv[tid] = kraw;
        kpv[tid] = kr[tid] * (1.0f + (aa - 1.0f) * a.in[I_KA][hc0 + tid]);
    }
    const float n2 = block_sum(n2p, red, tid);
    const float rn = 1.0f / fmaxf(sqrtf(n2), 1e-12f);
    float cbp = 0.f;
    if (tid < 64) { const float kk = kkv[tid] * rn; kkv[tid] = kk; bbv[tid] = kk * av[tid]; cbp = rr[tid] * kpv[tid] * a.in[I_RK][hc0 + tid]; }
    const float cb = block_sum(cbp, red, tid);
    {
        const int i = tid >> 3, j0 = (tid & 7) * 8;
        const float* Sp = a.in[I_SWKV] + (((size_t)b * 16 + head) * 64 + i) * 64 + j0;
        float* So = a.out + O_WKVS + (((size_t)b * 16 + head) * 64 + i) * 64 + j0;
        const f32x4 s0 = *(const f32x4*)(Sp), s1 = *(const f32x4*)(Sp + 4);
        float S[8] = {s0[0], s0[1], s0[2], s0[3], s1[0], s1[1], s1[2], s1[3]};
        float dot = 0.f;
#pragma unroll
        for (int j = 0; j < 8; ++j) dot += S[j] * kkv[j0 + j];
        const float sa = -red8(dot), vi = vv[i];
        float yd = 0.f;
#pragma unroll
        for (int j = 0; j < 8; ++j) { S[j] = S[j] * wv[j0 + j] + sa * bbv[j0 + j] + vi * kpv[j0 + j]; yd += S[j] * rr[j0 + j]; }
        *(f32x4*)(So) = (f32x4){S[0], S[1], S[2], S[3]}; *(f32x4*)(So + 4) = (f32x4){S[4], S[5], S[6], S[7]};
        yd = red8(yd);
        if ((tid & 7) == 0) yv[i] = yd;
    }
    __syncthreads();
    const float yi = (tid < 64) ? yv[tid] : 0.f;
    const float mean = block_sum(yi, red, tid) * (1.0f / 64.0f);
    const float dv = (tid < 64) ? (yi - mean) : 0.f;
    const float var = block_sum(dv * dv, red, tid) * (1.0f / 64.0f);
    if (tid < 64) {
        const float yn = dv * (1.0f / sqrtf(var + GN_EPS)) * a.in[I_GNW][hc0 + tid] + a.in[I_GNB][hc0 + tid];
        const float o = (yn + cb * vv[tid]) * gv[tid];
        ((bf16*)(ws + WS_SMP + SM_OB))[(size_t)b * 1024 + hc0 + tid] = (bf16)f2bf(o);
    }
    __syncthreads();
}

__device__ __forceinline__ void s_proj(const Frame& F, unsigned char* ws) {
    for (int tl = F.vcu; tl < 64; tl += F.G) {
        const int which = tl >> 5; const int n0[1] = {32 * (tl & 31)};
        const bf16* A = (const bf16*)(ws + WS_SMP + (which == 0 ? SM_OA : SM_OB)); const int K = which == 0 ? AWID : BWID;
        float* O = (float*)(ws + WS_SMP + (which == 0 ? SM_YA : SM_YB));
        sgemm32_block<1>(F, K, (const bf16*)(ws + (which == 0 ? WS_WA : WS_WB)), n0, [&](int k) { return *(const bf16x8*)(A + (size_t)(F.lane & 31) * K + k + 8 * (F.lane >> 5)); },
            [&](int row, int c, const float (&v)[1]) { O[(size_t)row * 1024 + n0[0] + c] = v[0]; });
    }
}
__device__ __forceinline__ void s_out(const Frame& F, const Args& a, unsigned char* ws) {
    const float* PROJ = (const float*)(ws + WS_SMP + SM_PROJ); const float* YA = (const float*)(ws + WS_SMP + SM_YA); const float* YBv = (const float*)(ws + WS_SMP + SM_YB);
    float* X1 = (float*)(ws + WS_SMP + SM_X1); bf16* X1B = (bf16*)(ws + WS_SMP + SM_X1B); float* SS = (float*)(ws + WS_SS) + M;
    for (int tl = F.vcu; tl < 32; tl += F.G) {
        const int n0[1] = {32 * tl};
        sgemm32_block<1>(F, DM, (const bf16*)(ws + WS_WO), n0,
            [&](int k) { const int r = F.lane & 31; float mg[8];
#pragma unroll
                for (int j = 0; j < 8; ++j) { const int c = k + 8 * (F.lane >> 5) + j;
                    mg[j] = sigmoidf_(PROJ[(size_t)r * INP + ACOLS + SCP + c]) * YA[(size_t)r * 1024 + c] + sigmoidf_(PROJ[(size_t)r * INP + ACOLS + SCP + 1024 + c]) * YBv[(size_t)r * 1024 + c]; }
                return pack8(mg); },
            [&](int row, int c, const float (&v)[1]) { const int col = n0[0] + c; const float x = a.in[I_XS][(size_t)row * DM + col] + v[0];
                X1[(size_t)row * 1024 + col] = x; X1B[(size_t)row * 1024 + col] = (bf16)f2bf(x);
                const float sq = half_sum32(x * x); if (c == 0) atomicAdd(SS + row, sq); });
    }
}
__device__ __forceinline__ void s_gu(const Frame& F, unsigned char* ws) {
    const float* SS = (const float*)(ws + WS_SS) + M; bf16* ACTS = (bf16*)(ws + WS_SMP + SM_ACT); const bf16* A = (const bf16*)(ws + WS_SMP + SM_X1B);
    for (int tl = F.vcu; tl < 88; tl += F.G) {
        const int jt = tl >> 2, i = tl & 3; const int n0[2] = {256 * jt + 32 * i, 256 * jt + 32 * i + 128};
        sgemm32_block<2>(F, DM, (const bf16*)(ws + WS_WGU), n0, [&](int k) { return *(const bf16x8*)(A + (size_t)(F.lane & 31) * DM + k + 8 * (F.lane >> 5)); },
            [&](int row, int c, const float (&v)[2]) { const float rstd = 1.0f / sqrtf(SS[row] * (1.0f / DM) + NORM_EPS); const float gv = v[0] * rstd, uv = v[1] * rstd;
                ACTS[(size_t)row * DFF + 128 * jt + 32 * i + c] = (bf16)f2bf(gv * sigmoidf_(gv) * uv); });
    }
}
__device__ __forceinline__ void s_down(const Frame& F, unsigned char* ws) {
    const float* X1 = (const float*)(ws + WS_SMP + SM_X1); float* X2 = (float*)(ws + WS_SMP + SM_X2); float* SS2 = (float*)(ws + WS_SS2) + M; const bf16* A = (const bf16*)(ws + WS_SMP + SM_ACT);
    for (int tl = F.vcu; tl < 32; tl += F.G) {
        const int n0[1] = {32 * tl};
        sgemm32_block<1>(F, DFF, (const bf16*)(ws + WS_WD), n0, [&](int k) { return *(const bf16x8*)(A + (size_t)(F.lane & 31) * DFF + k + 8 * (F.lane >> 5)); },
            [&](int row, int c, const float (&v)[1]) { const int col = n0[0] + c; const float x = X1[(size_t)row * 1024 + col] + v[0];
                X2[(size_t)row * 1024 + col] = x; const float sq = half_sum32(x * x); if (c == 0) atomicAdd(SS2 + row, sq); });
    }
}
__device__ __forceinline__ void final_norm(const Frame& F, const Args& a, unsigned char* ws) {
    const float* gfin = a.in[I_NFIN]; const float* SS2 = (const float*)(ws + WS_SS2);
    f32x4 gv[4];
#pragma unroll
    for (int j = 0; j < 4; ++j) gv[j] = *(const f32x4*)(gfin + 4 * F.lane + 256 * j);
    for (int m = F.gw; m < M + SB; m += F.NGW) {
        const float* src = (m < M) ? a.out + O_YP + (size_t)m * DM : (const float*)(ws + WS_SMP + SM_X2) + (size_t)(m - M) * DM;
        float* dst = (m < M) ? a.out + O_YP + (size_t)m * DM : a.out + O_YS + (size_t)(m - M) * DM;
        const float rstd = 1.0f / sqrtf(SS2[m] * (1.0f / DM) + NORM_EPS);
#pragma unroll
        for (int j = 0; j < 4; ++j) { const f32x4 v = *(const f32x4*)(src + 4 * F.lane + 256 * j); *(f32x4*)(dst + 4 * F.lane + 256 * j) = v * rstd * gv[j]; }
    }
}

namespace cs {
constexpr int IA = 0, IB = 4352, IBBT = 8704, IKBT = 11264, IVT = 13824, IVF = 16384, IGC = 20480, ICB = 20736, IMG_SZ = 20992;
constexpr int SM_OFF = 3 * IMG_SZ, SM_SZ = 2560, SMT = 0, SMLAK = 640, SMMRB = 1280, SMMRK = 1920;
constexpr int LB_OFF = SM_OFF + 2 * SM_SZ, YT_OFF = LB_OFF + 1024, YT_SZ = 4096, END = YT_OFF + 2 * YT_SZ;
static_assert(END <= 131072, "chunked scan LDS");
}
__device__ __forceinline__ bf16x8 ld2x8(const LAS unsigned char* p0, const LAS unsigned char* p1) {
    const u32x2 a = *(const LAS u32x2*)p0, b = *(const LAS u32x2*)p1; return __builtin_bit_cast(bf16x8, (v4u){a.x, a.y, b.x, b.y});
}
__device__ __forceinline__ void wave_sum2(float& a, float& b) {
    red16x2(a, b);
    const int ai = __builtin_bit_cast(int, a), bi = __builtin_bit_cast(int, b);
#define RL_(x, l) __builtin_bit_cast(float, __builtin_amdgcn_readlane(x, l))
    const float a0 = RL_(ai, 0), a1 = RL_(ai, 16), a2 = RL_(ai, 32), a3 = RL_(ai, 48), b0 = RL_(bi, 0), b1 = RL_(bi, 16), b2 = RL_(bi, 32), b3 = RL_(bi, 48);
#undef RL_
    a = (a0 + a1) + (a2 + a3); b = (b0 + b1) + (b2 + b3);
}
struct CsLd { unsigned short pr, pk, pv, qr, qk, qv, av; float lw, lwp; };
__device__ __forceinline__ void cs_load(CsLd& R, const bf16* SC, const float* LW, const bf16* AV, int b, int t, int col) {
    const size_t m = (size_t)b * T + t; const bf16* p = SC + m * SCP + col;
    R.pr = p[0]; R.pk = p[1024]; R.pv = p[2048];
    if (t > 0) { R.qr = p[-SCP]; R.qk = p[1024 - SCP]; R.qv = p[2048 - SCP]; } else { R.qr = 0; R.qk = 0; R.qv = 0; }
    R.av = AV[m * 1024 + col]; R.lw = LW[m * 1024 + col]; R.lwp = ((t & 15) != 0) ? LW[(m - 1) * 1024 + col] : 0.f;
}
__device__ __forceinline__ void scan_chunked(const Frame& F, const Args& a, unsigned char* ws, int chain) {
    using namespace cs;
    const bf16* SC = (const bf16*)(ws + WS_SC); const float* LW = (const float*)(ws + WS_Y); const bf16* AV = (const bf16*)(ws + WS_AV); const bf16* GATE = (const bf16*)(ws + WS_GATE);
    bf16* OB = (bf16*)(ws + WS_OB);
    LAS unsigned char* lds = F.lds + RING_OFF;
    const int lane = F.lane, wave = F.wave, b = chain >> 4, head = chain & 15, hc = head * 64;
    const int r32 = lane & 31, h = lane >> 5;
    constexpr int NCH = T / 16;
    f32x16 ST0 = {}, ST1 = {};
    CsLd ld[3], ldn[3]; float lwend = 0.f, lwendn = 0.f; unsigned short gt[3] = {0, 0, 0}, gtn[3] = {0, 0, 0};
    float mur = 0.f, muk = 0.f, muv = 0.f, kkw = 0.f, kaw = 0.f, rkw = 0.f, gnw = 0.f, gnb = 0.f;
    const int wp = wave - 3;
    const int nst = (wave >= 3) ? 3 : (wave == 0 ? 1 : 0), sbase = (wave >= 3) ? wp : 15;
    if (nst > 0) {
        const int c = hc + lane;
        mur = a.in[I_MU][c]; muk = a.in[I_MU][1024 + c]; muv = a.in[I_MU][2048 + c]; kkw = a.in[I_KK][c]; kaw = a.in[I_KA][c]; rkw = a.in[I_RK][c]; gnw = a.in[I_GNW][c]; gnb = a.in[I_GNB][c];
#pragma unroll
        for (int i = 0; i < 3; ++i) { const int s = sbase + 5 * i; if (i < nst) cs_load(ld[i], SC, LW, AV, b, s, c); }
        lwend = LW[((size_t)b * T + 15) * 1024 + c];
    }
    for (int it = -2; it <= NCH; ++it) {
        const int nA = it + 2, nB = it + 1, nC = it, nD = it - 1;
        if (wave == 2) {
            if (nB >= 0 && nB < NCH) {
                const LAS unsigned char* img = lds + (nB % 3) * IMG_SZ; LAS unsigned char* sm = lds + SM_OFF + (nB & 1) * SM_SZ; LAS float* Lb = (LAS float*)(lds + LB_OFF);
                f32x16 P = {};
#pragma unroll
                for (int ks = 0; ks < 4; ++ks) {
                    const LAS unsigned char* pa = img + IA + r32 * 136 + (16 * ks + 8 * h) * 2; const LAS unsigned char* pb = img + IB + r32 * 136 + (16 * ks + 8 * h) * 2;
                    P = __builtin_amdgcn_mfma_f32_32x32x16_bf16(ld2x8(pa, pa + 8), ld2x8(pb, pb + 8), P, 0, 0, 0);
                }
                const int sp = r32, s16 = r32 & 15; const bool lo = sp < 16;
#pragma unroll
                for (int rg = 0; rg < 8; ++rg) {
                    const int t = (rg & 3) + 8 * (rg >> 2) + 4 * h; const float v = (s16 < t) ? P[rg] : 0.f;
                    if (lo) Lb[t * 16 + s16] = v; else *(LAS bf16*)(sm + SMLAK + t * 40 + s16 * 2) = (bf16)(cvtpk_s(v, 0.f) & 0xffff);
                }
#pragma unroll
                for (int rg = 8; rg < 16; ++rg) {
                    const int t = (rg & 3) + 8 * ((rg >> 2) - 2) + 4 * h; const float v = (s16 <= t) ? P[rg] : 0.f;
                    *(LAS bf16*)(sm + (lo ? SMMRB : SMMRK) + t * 40 + s16 * 2) = (bf16)(cvtpk_s(v, 0.f) & 0xffff);
                }
                float Tr[16];
                const int cc = lane & 15;
#pragma unroll
                for (int t = 0; t < 16; ++t) {
                    float acc = (cc == t) ? 1.0f : 0.0f;
#pragma unroll
                    for (int u4 = 0; u4 < (t + 3) / 4; ++u4) {
                        const f32x4 lv = *(const LAS f32x4*)(Lb + t * 16 + 4 * u4);
#pragma unroll
                        for (int q = 0; q < 4; ++q) { const int u = 4 * u4 + q; if (u < t) acc += lv[q] * Tr[u]; }
                    }
                    Tr[t] = acc;
                }
                if (lane < 16) {
#pragma unroll
                    for (int t = 0; t < 16; ++t) *(LAS bf16*)(sm + SMT + t * 40 + cc * 2) = (bf16)(cvtpk_s(Tr[t], 0.f) & 0xffff);
                }
            }
        } else if (wave < 2) {
            if (nC >= 0 && nC < NCH) {
                const LAS unsigned char* img = lds + (nC % 3) * IMG_SZ; const LAS unsigned char* sm = lds + SM_OFF + (nC & 1) * SM_SZ; LAS float* YT = (LAS float*)(lds + YT_OFF + (nC & 1) * YT_SZ);
                const int vcol = 32 * wave + r32, t16 = r32 & 15;
                bf16x8 Bf[4];
                { float tmp[8];
#pragma unroll
                  for (int ks = 0; ks < 4; ++ks) {
#pragma unroll
                      for (int e = 0; e < 8; ++e) tmp[e] = (ks < 2) ? ST0[8 * (ks & 1) + e] : ST1[8 * (ks & 1) + e];
                      Bf[ks] = pack8(tmp); } }
                const LAS unsigned char* pv = img + IVT + vcol * 40 + 16 * h; const bf16x8 Vf = ld2x8(pv, pv + 8);
                f32x16 X = {};
                { const LAS unsigned char* p = sm + SMLAK + t16 * 40 + 16 * h; X = __builtin_amdgcn_mfma_f32_32x32x16_bf16(ld2x8(p, p + 8), Vf, X, 0, 0, 0); }
#pragma unroll
                for (int ks = 0; ks < 4; ++ks) { const LAS unsigned char* p = img + IA + t16 * 136 + (16 * ks + 4 * h) * 2; X = __builtin_amdgcn_mfma_f32_32x32x16_bf16(ld2x8(p, p + 16), Bf[ks], X, 0, 0, 0); }
                f32x16 SA = {};
                { float tmp[8];
#pragma unroll
                  for (int e = 0; e < 8; ++e) tmp[e] = X[e];
                  const LAS unsigned char* p = sm + SMT + t16 * 40 + 8 * h; SA = __builtin_amdgcn_mfma_f32_32x32x16_bf16(ld2x8(p, p + 16), pack8(tmp), SA, 0, 0, 0); }
                bf16x8 SAb;
                { float tmp[8];
#pragma unroll
                  for (int e = 0; e < 8; ++e) tmp[e] = SA[e];
                  SAb = pack8(tmp); }
                f32x16 Y = {};
                { const LAS unsigned char* p = sm + SMMRK + t16 * 40 + 16 * h; Y = __builtin_amdgcn_mfma_f32_32x32x16_bf16(ld2x8(p, p + 8), Vf, Y, 0, 0, 0); }
                { const LAS unsigned char* p = sm + SMMRB + t16 * 40 + 8 * h; Y = __builtin_amdgcn_mfma_f32_32x32x16_bf16(ld2x8(p, p + 16), SAb, Y, 0, 0, 0); }
#pragma unroll
                for (int ks = 0; ks < 4; ++ks) { const LAS unsigned char* p = img + IA + (16 + t16) * 136 + (16 * ks + 4 * h) * 2; Y = __builtin_amdgcn_mfma_f32_32x32x16_bf16(ld2x8(p, p + 16), Bf[ks], Y, 0, 0, 0); }
#pragma unroll
                for (int rg = 0; rg < 8; ++rg) YT[((rg & 3) + 8 * (rg >> 2) + 4 * h) * 64 + vcol] = Y[rg];
                const LAS float* GC = (const LAS float*)(img + IGC);
#pragma unroll
                for (int jt = 0; jt < 2; ++jt) {
                    f32x16 S = jt == 0 ? ST0 : ST1;
#pragma unroll
                    for (int g4 = 0; g4 < 4; ++g4) { const f32x4 dc = *(const LAS f32x4*)(GC + 32 * jt + 8 * g4 + 4 * h);
#pragma unroll
                        for (int q = 0; q < 4; ++q) S[4 * g4 + q] *= dc[q]; }
                    const int jrow = 32 * jt + r32;
                    { const LAS unsigned char* p = img + IBBT + jrow * 40 + 8 * h; S = __builtin_amdgcn_mfma_f32_32x32x16_bf16(ld2x8(p, p + 16), SAb, S, 0, 0, 0); }
                    { const LAS unsigned char* p = img + IKBT + jrow * 40 + 16 * h; S = __builtin_amdgcn_mfma_f32_32x32x16_bf16(ld2x8(p, p + 8), Vf, S, 0, 0, 0); }
                    if (jt == 0) ST0 = S; else ST1 = S;
                }
            }
        }
        auto produce = [&](auto NSTC) {
            constexpr int NST = decltype(NSTC)::value;
            const int c = hc + lane;
            if (nA + 1 < NCH) {
#pragma unroll
                for (int i = 0; i < NST; ++i) { const int s = sbase + 5 * i; cs_load(ldn[i], SC, LW, AV, b, (nA + 1) * 16 + s, c); }
                lwendn = LW[((size_t)b * T + (nA + 1) * 16 + 15) * 1024 + c];
            }
            if (nD + 1 >= 0 && nD + 1 < NCH) {
#pragma unroll
                for (int i = 0; i < NST; ++i) { const int s = sbase + 5 * i; gtn[i] = GATE[((size_t)b * T + (nD + 1) * 16 + s) * 1024 + c]; }
            }
            if (nD >= 0 && nD < NCH) {
                const LAS unsigned char* img = lds + (nD % 3) * IMG_SZ; const LAS float* YT = (const LAS float*)(lds + YT_OFF + (nD & 1) * YT_SZ);
#pragma unroll
                for (int i = 0; i < NST; ++i) { const int s = sbase + 5 * i; {
                    const size_t m = (size_t)b * T + nD * 16 + s;
                    const float gtv = bf2f(gt[i]);
                    const float y = YT[s * 64 + lane]; float s1 = y, s2 = y * y; wave_sum2(s1, s2);
                    const float mean = s1 * (1.0f / 64.0f), var = fmaxf(s2 * (1.0f / 64.0f) - mean * mean, 0.f);
                    const float yn = (y - mean) * __builtin_amdgcn_rsqf(var + GN_EPS) * gnw + gnb;
                    const float cbn = ((const LAS float*)(img + ICB))[s], vv = ((const LAS float*)(img + IVF))[s * 64 + lane];
                    OB[m * 1024 + c] = (bf16)(cvtpk_s((yn + cbn * vv) * gtv, 0.f) & 0xffff);
                } }
            }
            if (nA < NCH) {
                LAS unsigned char* img = lds + (nA % 3) * IMG_SZ;
                const float gC = __expf(lwend);
#pragma unroll
                for (int i = 0; i < NST; ++i) { const int s = sbase + 5 * i; {
                    const CsLd& R = ld[i];
                    const float pr = bf2f(R.pr), pk = bf2f(R.pk), pv = bf2f(R.pv), qr = bf2f(R.qr), qk = bf2f(R.qk), qv = bf2f(R.qv), av = bf2f(R.av);
                    const float r = pr + (qr - pr) * mur, k = pk + (qk - pk) * muk, v = pv + (qv - pv) * muv;
                    const float gs = __expf(R.lw), gp = __expf(R.lwp), ig = __expf(-R.lw), rat = __expf(lwend - R.lw);
                    const float kr = k * kkw, kp = k * (1.0f + (av - 1.0f) * kaw);
                    float n2 = kr * kr, cb = r * kp * rkw; wave_sum2(n2, cb);
                    const float kk = kr * __builtin_amdgcn_rsqf(fmaxf(n2, 1e-24f)), beta = kk * av;
                    const unsigned w0 = cvtpk_s(-kk * gp, r * gs), w1 = cvtpk_s(beta * ig, kp * ig), w2 = cvtpk_s(beta * rat, kp * rat), w3 = cvtpk_s(v, 0.f);
                    *(LAS bf16*)(img + IA + s * 136 + lane * 2) = (bf16)(w0 & 0xffff); *(LAS bf16*)(img + IA + (16 + s) * 136 + lane * 2) = (bf16)(w0 >> 16);
                    *(LAS bf16*)(img + IB + s * 136 + lane * 2) = (bf16)(w1 & 0xffff); *(LAS bf16*)(img + IB + (16 + s) * 136 + lane * 2) = (bf16)(w1 >> 16);
                    *(LAS bf16*)(img + IBBT + lane * 40 + s * 2) = (bf16)(w2 & 0xffff); *(LAS bf16*)(img + IKBT + lane * 40 + s * 2) = (bf16)(w2 >> 16);
                    *(LAS bf16*)(img + IVT + lane * 40 + s * 2) = (bf16)(w3 & 0xffff);
                    ((LAS float*)(img + IVF))[s * 64 + lane] = v;
                    if (lane == 0) ((LAS float*)(img + ICB))[s] = cb;
                    if (NST == 1) ((LAS float*)(img + IGC))[lane] = gC;
                } }
            }
#pragma unroll
            for (int i = 0; i < NST; ++i) { ld[i] = ldn[i]; gt[i] = gtn[i]; }
            lwend = lwendn;
        };
        if (wave >= 3) produce(std::integral_constant<int, 3>{}); else if (wave == 0) produce(std::integral_constant<int, 1>{});
        __syncthreads();
    }
    if (wave < 2) {
        float* so = a.out + O_WKVP + (((size_t)b * 16 + head) * 64 + 32 * wave + r32) * 64;
#pragma unroll
        for (int rg = 0; rg < 16; ++rg) { const int j = (rg & 3) + 8 * (rg >> 2) + 4 * h; so[j] = ST0[rg]; so[32 + j] = ST1[rg]; }
    }
    __syncthreads();
}
__global__ void __launch_bounds__(NWAVES * 64, 2) fwd_kernel(Args args) {
    extern __shared__ __attribute__((aligned(16))) unsigned char lds[];
    Frame F;
    F.lds = (LAS unsigned char*)lds;
    F.MISC = (volatile LAS unsigned*)(F.lds + MISC_OFF);
    F.tid = threadIdx.x; F.lane = F.tid & 63; F.wave = __builtin_amdgcn_readfirstlane(F.tid >> 6);
    F.G = gridDim.x; { const int bx = blockIdx.x; F.vcu = (F.G % 8 == 0) ? (bx % 8) * (F.G / 8) + bx / 8 : bx; }
    F.gw = F.vcu * NWAVES + F.wave; F.NGW = F.G * NWAVES;
    unsigned char* ws = args.ws;
    F.ctl = (gu32*)(ws + WS_CTL);
    for (int u = F.tid; u < (LDS_BYTES - LDSCTL_OFF) / 4; u += NWAVES * 64) ((LAS unsigned*)(F.lds + LDSCTL_OFF))[u] = 0u;
    __syncthreads();
    XcdBarrier bar = xcd_barrier_post((unsigned*)(F.ctl + CW_BAR), F.MISC + 8);
#define GRID_BAR() do { xcd_barrier(bar); int t_ = threadIdx.x; asm volatile("" : "+v"(t_)); F.tid = t_; F.lane = t_ & 63; } while (0)
#ifdef PROBE_TIMING
    unsigned long long ts_[14]; int nts_ = 0;
#define STAMP() do { ts_[nts_++] = __builtin_amdgcn_s_memrealtime(); } while (0)
    STAMP();
#else
#define STAMP() do {} while (0)
#endif

    p0_prologue(F, args, ws);
    GRID_BAR(); STAMP();

    const int NSCAN = (F.G >= 256) ? 128 : 0;
    EpiIn Ein{(bf16*)(ws + WS_Q), (bf16*)(ws + WS_K), (bf16*)(ws + WS_VT), (bf16*)(ws + WS_SC), (bf16*)(ws + WS_GT), args.out, (const float*)(ws + WS_TAB)};
    {
        s_inproj(F, ws);
        pg8::Gemm g{(const pg8::bf16_t*)(ws + WS_XN), (const pg8::bf16_t*)(ws + WS_WIN), M, INP, opaque_int(DM)};
        TileListOrder S; S.init(M, 20, 20, 18, 0, F.G, (int)blockIdx.x);
        pg8::gemm_phase<EpiIn, TileListOrder, true, true>(F.lds + RING_OFF, g, S, Ein);
    }
    GRID_BAR(); STAMP();

    r1_rows(F, (const bf16*)(ws + WS_SC), args.in[I_MU], (bf16*)(ws + WS_A1), (bf16*)(ws + WS_A2));
    GRID_BAR(); STAMP();

    {
        { pg8::Gemm g{(const pg8::bf16_t*)(ws + WS_A1), (const pg8::bf16_t*)(ws + WS_WWA), M, 2048, opaque_int(128)}; pg8::StaticOrder S; S.init(M, 2048, F.G, (int)blockIdx.x);
          EpiWA E{(float*)(ws + WS_Y), (bf16*)(ws + WS_AV), args.in[I_W0], args.in[I_A0]};
          pg8::gemm_phase<EpiWA, pg8::StaticOrder, true, true>(F.lds + RING_OFF, g, S, E); }
        { pg8::Gemm g{(const pg8::bf16_t*)(ws + WS_A2), (const pg8::bf16_t*)(ws + WS_WG), M, 1024, opaque_int(256)}; pg8::StaticOrder S; S.init(M, 1024, F.G, (int)blockIdx.x);
          EpiPlain E{(bf16*)(ws + WS_GATE), 1024};
          pg8::gemm_phase<EpiPlain, pg8::StaticOrder, true, true>(F.lds + RING_OFF, g, S, E); }
    }
    GRID_BAR(); STAMP();

    {
        if (NSCAN == 0) { for (int ch = F.vcu; ch < NB * BHEADS; ch += F.G) scan_chunked(F, args, ws, ch); }
        else if ((int)blockIdx.x < NSCAN) scan_chunked(F, args, ws, (int)blockIdx.x);
        if (NSCAN == 0 || (int)blockIdx.x >= NSCAN) {
            pg8::Gemm g{(const pg8::bf16_t*)(ws + WS_XN), (const pg8::bf16_t*)(ws + WS_WIN), M, INP, opaque_int(DM)};
            TileListOrder S; S.init(M, 20, 18, 0, 38, F.G - NSCAN, (int)blockIdx.x - NSCAN);
            pg8::gemm_phase<EpiIn, TileListOrder, true, true>(F.lds + RING_OFF, g, S, Ein);
        }
    }
    GRID_BAR(); STAMP();

    {
        for (int it = F.vcu; it < NB * AHEADS * 4; it += F.G)
            attn_item(F, it, (const bf16*)(ws + WS_Q), (const bf16*)(ws + WS_K), (const bf16*)(ws + WS_VT), (bf16*)(ws + WS_OG), (float*)(ws + WS_LSE), (bf16*)(ws + WS_OA));
        __syncthreads();
        for (int it = F.vcu; it < SB * AHEADS; it += F.G) s_attn_item(F, args, ws, it >> 3, it & 7);
        for (int it = F.vcu; it < SB * BHEADS; it += F.G) s_rwkv_item(F, args, ws, it >> 4, it & 15);
        { const float* PROJ = (const float*)(ws + WS_SMP + SM_PROJ);
          for (int e = F.vcu * 512 + F.tid; e < SB * SCOLS; e += F.G * 512) { const int b = e / SCOLS, c = e - b * SCOLS; args.out[O_SHS + e] = PROJ[(size_t)b * INP + ACOLS + c]; } }
    }
    GRID_BAR(); STAMP();

    {
        s_proj(F, ws);
        { pg8::Gemm g{(const pg8::bf16_t*)(ws + WS_OA), (const pg8::bf16_t*)(ws + WS_WA), M, DM, opaque_int(AWID)}; pg8::StaticOrder S; S.init(M, DM, F.G, (int)blockIdx.x);
          EpiPA E{(const bf16*)(ws + WS_GT), (float*)(ws + WS_Y1)};
          pg8::gemm_phase<EpiPA, pg8::StaticOrder, true, true>(F.lds + RING_OFF, g, S, E); }
        VM_WAIT(); __syncthreads();
        { pg8::Gemm g{(const pg8::bf16_t*)(ws + WS_OB), (const pg8::bf16_t*)(ws + WS_WB), M, DM, opaque_int(BWID)}; pg8::StaticOrder S; S.init(M, DM, F.G, (int)blockIdx.x);
          EpiPB E{(const bf16*)(ws + WS_GT), (const float*)(ws + WS_Y1), (bf16*)(ws + WS_MG)};
          pg8::gemm_phase<EpiPB, pg8::StaticOrder, true, true>(F.lds + RING_OFF, g, S, E); }
    }
    GRID_BAR(); STAMP();

    {
        s_out(F, args, ws);
        pg8::Gemm g{(const pg8::bf16_t*)(ws + WS_MG), (const pg8::bf16_t*)(ws + WS_WO), M, DM, opaque_int(DM)}; pg8::StaticOrder S; S.init(M, DM, F.G, (int)blockIdx.x);
        EpiRes E{args.in[I_XP], (float*)(ws + WS_X1), (bf16*)(ws + WS_X1B), (float*)(ws + WS_SS)};
        pg8::gemm_phase<EpiRes, pg8::StaticOrder, true, true>(F.lds + RING_OFF, g, S, E);
    }
    GRID_BAR(); STAMP();

    {
        s_gu(F, ws);
        pg8::Gemm g{(const pg8::bf16_t*)(ws + WS_X1B), (const pg8::bf16_t*)(ws + WS_WGU), M, GU, opaque_int(DM)}; pg8::StaticOrder S; S.init(M, GU, F.G, (int)blockIdx.x);
        EpiGU E{(const float*)(ws + WS_SS), (bf16*)(ws + WS_ACT)};
        pg8::gemm_phase<EpiGU, pg8::StaticOrder, true, true>(F.lds + RING_OFF, g, S, E);
    }
    GRID_BAR(); STAMP();

    {
        s_down(F, ws);
        pg8::Gemm g{(const pg8::bf16_t*)(ws + WS_ACT), (const pg8::bf16_t*)(ws + WS_WD), M, DM, opaque_int(DFF)}; pg8::StaticOrder S; S.init(M, DM, F.G, (int)blockIdx.x);
        EpiRes E{(const float*)(ws + WS_X1), args.out + O_YP, nullptr, (float*)(ws + WS_SS2)};
        pg8::gemm_phase<EpiRes, pg8::StaticOrder, true, true>(F.lds + RING_OFF, g, S, E);
    }
    GRID_BAR(); STAMP();

    final_norm(F, args, ws);
#ifdef PROBE_TIMING
    GRID_BAR(); STAMP();
    if (blockIdx.x == 0 && F.tid == 0) {
        const size_t offs[12] = {O_YP, O_YS, O_KV1P, O_KV2P, O_KV3P, O_SHP, O_WKVP, O_KV1S, O_KV2S, O_KV3S, O_SHS, O_WKVS};
        for (int k = 0; k < 11; ++k) args.out[offs[k]] = (float)(ts_[k + 1] - ts_[k]) * 0.01f;
        args.out[offs[11]] = (float)(ts_[11] - ts_[0]) * 0.01f;
    }
#endif
}

extern "C" void kernel_launch(void* const* d_in, const int* in_sizes, int n_in, void* d_out, int out_size, void* d_ws, size_t ws_size, hipStream_t stream) {
    static int grid = 0;
    if (grid == 0) {
        if (n_in != 28 || in_sizes[0] != M * DM || (size_t)out_size != O_END || ws_size < WS_END) {
            fprintf(stderr, "kernel_launch: unexpected shapes: n_in %d in0 %d out %d ws %zu (need %zu)\n", n_in, n_in > 0 ? in_sizes[0] : -1, out_size, ws_size, (size_t)WS_END); grid = -1; return; }
        int dev = 0, cus = 0, per_cu = 0;
        if (hipGetDevice(&dev) != hipSuccess || hipDeviceGetAttribute(&cus, hipDeviceAttributeMultiprocessorCount, dev) != hipSuccess) { grid = -1; return; }
        if (hipFuncSetAttribute((const void*)fwd_kernel, hipFuncAttributeMaxDynamicSharedMemorySize, LDS_BYTES) != hipSuccess) { fprintf(stderr, "kernel_launch: hipFuncSetAttribute failed\n"); grid = -1; return; }
        if (hipOccupancyMaxActiveBlocksPerMultiprocessor(&per_cu, (const void*)fwd_kernel, NWAVES * 64, LDS_BYTES) != hipSuccess || per_cu < 1) {
            fprintf(stderr, "kernel_launch: occupancy query says %d blocks per CU\n", per_cu); (void)hipGetLastError(); grid = -1; return; }
        grid = cus;
    }
    if (grid < 0) return;
    if (hipMemsetAsync((char*)d_ws + WS_CTL, 0, CTL_ZERO_BYTES, stream) != hipSuccess) return;
    Args a{};
    for (int i = 0; i < 28; ++i) a.in[i] = (const float*)d_in[i];
    a.out = (float*)d_out; a.ws = (unsigned char*)d_ws;
    hipLaunchKernelGGL(fwd_kernel, dim3(grid), dim3(NWAVES * 64), LDS_BYTES, stream, a);
}
```

```cpp
#include <hip/hip_runtime.h>
#include <cstdio>
#include <cstdint>
#include <type_traits>
namespace pg8 {
#define PG8_LAS __attribute__((address_space(3)))
typedef unsigned short bf16_t;
typedef short bf16x8 __attribute__((ext_vector_type(8)));
typedef float f32x4 __attribute__((ext_vector_type(4)));
typedef unsigned u32x4 __attribute__((ext_vector_type(4)));
constexpr int BM = 256, BK = 64, HALF = 128, HTB = HALF * BK * 2  , STAGE_BYTES = 8 * HTB, NXCD = 8, WGM = 8;

__host__ __device__ __forceinline__ int lds_byte(int r, int c) { const int st = (r >> 4) * 2 + (c >> 5), rr = r & 15, cc = c & 31, ob = rr * 64 + cc * 2; return st * 1024 + (ob ^ (((ob >> 9) & 1) << 5)); }
__host__ __device__ __forceinline__ void stage_rc(int b, int& R, int& C) { const int st = b / 1024, sb = b % 1024, swz = sb ^ (((sb >> 9) & 1) << 5); R = (st >> 1) * 16 + swz / 64; C = (st & 1) * 32 + (swz % 64) / 2; }
__host__ __device__ __forceinline__ int perm32(int rho) { const int n = rho >> 4, i = rho & 15; return 8 * (i >> 2) + 4 * n + (i & 3); }

struct Unit { int pm, pn; };
struct Gemm { const bf16_t* A; const bf16_t* Bt; int M, N, K; };

struct StaticOrder {
    int nM, nN, nwg, G, c;
    __host__ __device__ void init(int M, int N, int G_, int c_) { nM = M / BM; nN = N / BM; nwg = nM * nN; G = G_; c = c_; }
    __host__ __device__ bool next(int i, Unit& u) const {
        const long L = (long)i * G + c; if (L >= nwg) return false;
        int wgid = (int)L; { const int q = nwg / NXCD, r = nwg % NXCD, xcd = wgid % NXCD, off = wgid / NXCD; wgid = (xcd < r ? xcd * (q + 1) : r * (q + 1) + (xcd - r) * q) + off; }
        const int nig = WGM * nN, gid = wgid / nig, fm = gid * WGM, gsz = (nM - fm) < WGM ? (nM - fm) : WGM;
        u.pm = fm + ((wgid % nig) % gsz); u.pn = (wgid % nig) / gsz; return true;
    }
    __device__ __forceinline__ void a_ready(const Unit&) const {}
    __device__ __forceinline__ void done(const Unit&) const {}
};

__device__ __forceinline__ unsigned cvt_pk_bf16(float lo, float hi) { unsigned r; asm volatile("v_cvt_pk_bf16_f32 %0, %1, %2" : "=v"(r) : "v"(lo), "v"(hi)); return r; }
template <class Epi, class Sched, bool ALIGN_EPI = false, bool SP2 = false>
__device__ __forceinline__ void gemm_phase(PG8_LAS unsigned char* lds, const Gemm g, const Sched& S, const Epi& E) {
    int tid_ = threadIdx.x; asm volatile("" : "+v"(tid_));
    const int tid = tid_, wid = __builtin_amdgcn_readfirstlane(tid >> 6), lane = tid & 63, wr = wid >> 2, wc = wid & 3, fr = lane & 15, fq = lane >> 4;
    const int K = g.K, nt = K / BK;
    unsigned voffA[2], voffB[2];
#pragma unroll
    for (int i = 0; i < 2; ++i) { int R, C; stage_rc(tid * 16 + i * 8192, R, C); const int Rb = Epi::PERM ? ((R & ~31) + perm32(R & 31)) : R;
        voffA[i] = (unsigned)(R * K + C) * 2u; voffB[i] = (unsigned)(Rb * K + C) * 2u; }
    const size_t kstep = (size_t)(BK * 2);
    const size_t hstep = (size_t)HALF * K * 2;
    const size_t tstep = 2 * hstep;
    const unsigned ldsw = (unsigned)wid * 1024u;
    const int aoff = lds_byte(wr * 64 + fr, fq * 8), boff = lds_byte(wc * 32 + fr, fq * 8);
#define PG8_SA(b, h) (((b) * 2 + (h)) * HTB)
#define PG8_SB(b, h) ((4 + (b) * 2 + (h)) * HTB)
#define PG8_STAGE(bufoff, gbase, voff) do { _Pragma("unroll") for (int _i = 0; _i < 2; ++_i) \
        __builtin_amdgcn_global_load_lds((const unsigned*)((const char*)(gbase) + (voff)[_i]), (PG8_LAS unsigned*)(lds + (bufoff) + ldsw + _i * 8192), 16, 0, 0); } while (0)
#define PG8_LDA(dst, b, h) do { _Pragma("unroll") for (int m = 0; m < 4; ++m) _Pragma("unroll") for (int k = 0; k < 2; ++k) dst[m][k] = *(const PG8_LAS bf16x8*)(lds + PG8_SA(b, h) + aoff + m * 2048 + k * 1024); } while (0)
#define PG8_LDB(dst, b, h) do { _Pragma("unroll") for (int n = 0; n < 2; ++n) _Pragma("unroll") for (int k = 0; k < 2; ++k) dst[n][k] = *(const PG8_LAS bf16x8*)(lds + PG8_SB(b, h) + boff + n * 2048 + k * 1024); } while (0)
#define PG8_MMA(ai, bj, At, Bt) do { __builtin_amdgcn_s_setprio(1); _Pragma("unroll") for (int m = 0; m < 4; ++m) _Pragma("unroll") for (int n = 0; n < 2; ++n) _Pragma("unroll") for (int k = 0; k < 2; ++k) \
        acc[ai][bj][m][n] = __builtin_amdgcn_mfma_f32_16x16x32_bf16(Bt[n][k], At[m][k], acc[ai][bj][m][n], 0, 0, 0); __builtin_amdgcn_s_setprio(0); } while (0)
#define PG8_WAIT_V(n) asm volatile("s_waitcnt vmcnt(" #n ")" ::: "memory")
#define PG8_WAIT_L(n) asm volatile("s_waitcnt lgkmcnt(" #n ")" ::: "memory")
#define PG8_BAR __builtin_amdgcn_s_barrier()
#define PG8_SCHED __builtin_amdgcn_sched_barrier(0)
    Unit cur, nxt; int ui = 0;
    if (!S.next(0, cur)) return;
    f32x4 acc[2][2][4][2];
#pragma unroll
    for (int a = 0; a < 2; ++a)
#pragma unroll
        for (int b = 0; b < 2; ++b)
#pragma unroll
            for (int m = 0; m < 4; ++m)
#pragma unroll
                for (int n = 0; n < 2; ++n) acc[a][b][m][n] = (f32x4){0.f, 0.f, 0.f, 0.f};
    bf16x8 At[4][2], B0[2][2], B1[2][2];
    const char* cA = (const char*)g.A + (size_t)cur.pm * tstep; const char* cB = (const char*)g.Bt + (size_t)cur.pn * tstep;
    S.a_ready(cur);
    if constexpr (SP2) {
        PG8_STAGE(PG8_SB(0, 0), cB, voffB); PG8_STAGE(PG8_SB(0, 1), cB + hstep, voffB); PG8_STAGE(PG8_SA(0, 0), cA, voffA); PG8_STAGE(PG8_SA(0, 1), cA + hstep, voffA);
        if (wr == 1) PG8_BAR;
        PG8_WAIT_V(2); PG8_BAR;
        PG8_STAGE(PG8_SB(1, 0), cB + kstep, voffB); PG8_STAGE(PG8_SA(1, 0), cA + kstep, voffA); PG8_STAGE(PG8_SB(1, 1), cB + hstep + kstep, voffB);
        PG8_WAIT_V(6); PG8_BAR;
    } else {
        PG8_STAGE(PG8_SB(0, 0), cB, voffB); PG8_STAGE(PG8_SA(0, 0), cA, voffA); PG8_STAGE(PG8_SB(0, 1), cB + hstep, voffB); PG8_STAGE(PG8_SA(0, 1), cA + hstep, voffA);
        if (wr == 1) PG8_BAR;
        PG8_WAIT_V(4); PG8_BAR;
        PG8_STAGE(PG8_SB(1, 0), cB + kstep, voffB); PG8_STAGE(PG8_SA(1, 0), cA + kstep, voffA); PG8_STAGE(PG8_SB(1, 1), cB + hstep + kstep, voffB);
        PG8_WAIT_V(6); PG8_BAR;
    }
    for (;;) {
        const bool has_next = S.next(ui + 1, nxt);
        const char* nA = has_next ? (const char*)g.A + (size_t)nxt.pm * tstep : cA; const char* nB = has_next ? (const char*)g.Bt + (size_t)nxt.pn * tstep : cB;
        for (int t = 0; t < nt; t += 2) {
            const bool last = (t == nt - 2);
            const char* a1 = cA + (size_t)(t + 1) * kstep;
            const char* a2 = last ? nA : cA + (size_t)(t + 2) * kstep; const char* b2 = last ? nB : cB + (size_t)(t + 2) * kstep;
            const char* a3 = a2 + kstep; const char* b3 = b2 + kstep;
            if (last && has_next) S.a_ready(nxt);
            if constexpr (Epi::MID_T > 0) { if (t == Epi::MID_T) E.mid(acc, cur, wr, wc, fr, fq); }
            if constexpr (SP2) {
            PG8_LDB(B0, 0, 0); PG8_LDB(B1, 0, 1); PG8_SCHED; PG8_LDA(At, 0, 0); PG8_STAGE(PG8_SA(1, 1), a1 + hstep, voffA);
            PG8_WAIT_V(8); PG8_WAIT_L(0); PG8_BAR; PG8_MMA(0, 0, At, B0); PG8_MMA(0, 1, At, B1); PG8_BAR; PG8_SCHED;
            PG8_LDA(At, 0, 1); PG8_STAGE(PG8_SB(0, 0), b2, voffB); PG8_STAGE(PG8_SB(0, 1), b2 + hstep, voffB); PG8_STAGE(PG8_SA(0, 0), a2, voffA);
            PG8_WAIT_V(8); PG8_WAIT_L(0); PG8_BAR; PG8_MMA(1, 0, At, B0); PG8_MMA(1, 1, At, B1); PG8_BAR; PG8_SCHED;
            PG8_LDB(B0, 1, 0); PG8_LDB(B1, 1, 1); PG8_SCHED; PG8_LDA(At, 1, 0); PG8_STAGE(PG8_SA(0, 1), a2 + hstep, voffA);
            PG8_WAIT_V(8); PG8_WAIT_L(0); PG8_BAR; PG8_MMA(0, 0, At, B0); PG8_MMA(0, 1, At, B1); PG8_BAR; PG8_SCHED;
            PG8_LDA(At, 1, 1); PG8_STAGE(PG8_SB(1, 0), b3, voffB); PG8_STAGE(PG8_SB(1, 1), b3 + hstep, voffB); PG8_STAGE(PG8_SA(1, 0), a3, voffA);
            PG8_WAIT_V(8); PG8_WAIT_L(0); PG8_BAR; PG8_MMA(1, 0, At, B0); PG8_MMA(1, 1, At, B1); PG8_BAR; PG8_SCHED;
            } else {
            PG8_LDB(B0, 0, 0); PG8_SCHED; PG8_LDA(At, 0, 0); PG8_STAGE(PG8_SA(1, 1), a1 + hstep, voffA);
            PG8_WAIT_L(8); PG8_BAR; PG8_WAIT_L(0); PG8_MMA(0, 0, At, B0); PG8_BAR; PG8_SCHED;
            PG8_LDB(B1, 0, 1); PG8_STAGE(PG8_SB(0, 0), b2, voffB);
            PG8_BAR; PG8_WAIT_L(0); PG8_MMA(0, 1, At, B1); PG8_BAR;
            PG8_LDA(At, 0, 1); PG8_STAGE(PG8_SA(0, 0), a2, voffA);
            PG8_BAR; PG8_WAIT_L(0); PG8_MMA(1, 0, At, B0); PG8_BAR; PG8_SCHED;
            PG8_STAGE(PG8_SB(0, 1), b2 + hstep, voffB);
            PG8_WAIT_V(6); PG8_BAR; PG8_MMA(1, 1, At, B1); PG8_BAR;
            PG8_LDB(B0, 1, 0); PG8_SCHED; PG8_LDA(At, 1, 0); PG8_STAGE(PG8_SA(0, 1), a2 + hstep, voffA);
            PG8_WAIT_L(8); PG8_BAR; PG8_WAIT_L(0); PG8_MMA(0, 0, At, B0); PG8_BAR; PG8_SCHED;
            PG8_LDB(B1, 1, 1); PG8_STAGE(PG8_SB(1, 0), b3, voffB);
            PG8_BAR; PG8_WAIT_L(0); PG8_MMA(0, 1, At, B1); PG8_BAR;
            PG8_LDA(At, 1, 1); PG8_STAGE(PG8_SA(1, 0), a3, voffA);
            PG8_BAR; PG8_WAIT_L(0); PG8_MMA(1, 0, At, B0); PG8_BAR; PG8_SCHED;
            PG8_STAGE(PG8_SB(1, 1), b3 + hstep, voffB);
            PG8_WAIT_V(6); PG8_BAR; PG8_MMA(1, 1, At, B1); PG8_BAR;
            }
        }
        if constexpr (ALIGN_EPI) { if (wr == 0) PG8_BAR; }
        if constexpr (!Epi::AFTER_DRAIN) { E(acc, cur, wr, wc, fr, fq); S.done(cur); }
        if (!has_next) break;
#pragma unroll
        for (int a = 0; a < 2; ++a)
#pragma unroll
            for (int b = 0; b < 2; ++b)
#pragma unroll
                for (int m = 0; m < 4; ++m)
#pragma unroll
                    for (int n = 0; n < 2; ++n) acc[a][b][m][n] = (f32x4){0.f, 0.f, 0.f, 0.f};
        cur = nxt; cA = nA; cB = nB; ++ui;
        if constexpr (ALIGN_EPI) { if (wr == 1) PG8_BAR; }
    }
    PG8_WAIT_V(0);
    if constexpr (!ALIGN_EPI) { if (wr == 0) PG8_BAR; }
    PG8_BAR;
    if constexpr (Epi::AFTER_DRAIN) { E.fused(acc, cur, wr, wc, fr, fq, lds, wid, lane); S.done(cur); }
#undef PG8_SA
#undef PG8_SB
#undef PG8_STAGE
#undef PG8_LDA
#undef PG8_LDB
#undef PG8_MMA
#undef PG8_WAIT_V
#undef PG8_WAIT_L
#undef PG8_BAR
#undef PG8_SCHED
}
}
#ifndef REP_P0
#define REP_P0 1
#endif
#ifndef REP_P1
#define REP_P1 1
#endif
#ifndef REP_P2
#define REP_P2 1
#endif
#ifndef REP_P3
#define REP_P3 1
#endif
#ifndef REP_P4
#define REP_P4 1
#endif
#ifndef REP_P5
#define REP_P5 1
#endif
#ifndef REP_P6
#define REP_P6 1
#endif
#ifndef REP_P8
#define REP_P8 1
#endif

constexpr int NWAVES = 8;
constexpr int DM = 1024, NB = 8, T = 2048, M = NB * T;
constexpr int SB = 32;
constexpr int PAST = 16384;
constexpr int HD = 64, AHEADS = 8, AWID = 512, BHEADS = 16, BWID = 1024;
constexpr int ACOLS = 4608, SCOLS = 3360, SCP = 3584, INCOLS = 10016, INP = 10240;
constexpr int DFF = 2816, GU = 2 * DFF;
constexpr float NORM_EPS = 1e-6f, GN_EPS = 64e-5f;
constexpr float LOG2E = 1.4426950408889634f, LN2 = 0.6931471805599453f;
constexpr float QSCALE = 0.125f * LOG2E;
constexpr size_t O_YP = 0, O_YS = O_YP + (size_t)M * DM, O_KV1P = O_YS + (size_t)SB * DM, O_KV2P = O_KV1P + (size_t)NB * 128 * 1024,
                 O_KV3P = O_KV2P + (size_t)NB * 512 * 1024, O_SHP = O_KV3P + (size_t)NB * 2048 * 1024, O_WKVP = O_SHP + (size_t)NB * SCOLS,
                 O_KV1S = O_WKVP + (size_t)NB * 16 * 4096, O_KV2S = O_KV1S + (size_t)SB * 1024, O_KV3S = O_KV2S + (size_t)SB * 1024,
                 O_SHS = O_KV3S + (size_t)SB * 1024, O_WKVS = O_SHS + (size_t)SB * SCOLS, O_END = O_WKVS + (size_t)SB * 16 * 4096;
static_assert(O_END == 41684224, "output size");
constexpr size_t MiB = 1u << 20;
constexpr size_t WS_CTL = 0, CTL_ZERO_BYTES = 1 * MiB;
constexpr size_t WS_TAB = 1 * MiB;
constexpr size_t WS_SS = 2 * MiB;
constexpr size_t WS_SS2 = WS_SS + 128 * 1024;
constexpr size_t WS_SMP = 3 * MiB;
constexpr size_t WS_WIN = 8 * MiB, WS_WA = 28 * MiB, WS_WB = 29 * MiB, WS_WO = 31 * MiB, WS_WGU = 33 * MiB, WS_WD = 44 * MiB, WS_WWA = 50 * MiB, WS_WG = 51 * MiB;
constexpr size_t WS_XN = 52 * MiB, WS_Q = 84 * MiB, WS_K = 132 * MiB, WS_VT = 180 * MiB, WS_SC = 228 * MiB, WS_GT = 340 * MiB;
constexpr size_t WS_OG = 404 * MiB, WS_LSE = 452 * MiB, WS_OA = 454 * MiB, WS_A1 = 470 * MiB, WS_A2 = 474 * MiB;
constexpr size_t WS_E = 482 * MiB, WS_AV = 514 * MiB, WS_GATE = 546 * MiB, WS_Y = 578 * MiB, WS_CB = 642 * MiB, WS_OB = 643 * MiB;
constexpr size_t WS_Y1 = 675 * MiB, WS_MG = 739 * MiB, WS_X1 = 771 * MiB, WS_X1B = 835 * MiB, WS_END = 867 * MiB;
constexpr size_t WS_OAB = WS_Y1;
constexpr size_t WS_ACT = WS_Q;
static_assert((size_t)M * DFF * 2 <= WS_VT - WS_Q, "ACT overlay");
constexpr size_t SM_HSN = 0;
constexpr size_t SM_PROJ = 64 * 1024;
constexpr size_t SM_OA = SM_PROJ + (size_t)SB * INP * 4;
constexpr size_t SM_OB = SM_OA + 32 * 1024;
constexpr size_t SM_YA = SM_OB + 64 * 1024;
constexpr size_t SM_YB = SM_YA + 128 * 1024;
constexpr size_t SM_X1 = SM_YB + 128 * 1024;
constexpr size_t SM_X1B = SM_X1 + 128 * 1024;
constexpr size_t SM_ACT = SM_X1B + 64 * 1024;
constexpr size_t SM_X2 = SM_ACT + 192 * 1024;
constexpr size_t SM_OG = SM_X2 + 128 * 1024;
constexpr size_t SM_LSE = SM_OG + 192 * 1024;
constexpr size_t SM_END = SM_LSE + 4096;
static_assert(SM_END <= 5 * MiB, "sample scratch");
constexpr int CW_BAR = 4096;
constexpr int RING_OFF = 0, RING_BYTES = 131072, LDSCTL_OFF = RING_BYTES, MISC_OFF = LDSCTL_OFF + 320, LDS_BYTES = 147456;

#define GAS __attribute__((address_space(1)))
#define LAS __attribute__((address_space(3)))
typedef unsigned short bf16;
typedef unsigned v4u __attribute__((ext_vector_type(4)));
typedef float f32x4 __attribute__((ext_vector_type(4)));
typedef short bf16x8 __attribute__((ext_vector_type(8)));
typedef GAS unsigned gu32;
typedef GAS unsigned long long gu64;
#define RLX_AGENT __ATOMIC_RELAXED, __HIP_MEMORY_SCOPE_AGENT
#define LDS_WAIT() asm volatile("s_waitcnt lgkmcnt(0)" ::: "memory")
#define VM_WAIT() asm volatile("s_waitcnt vmcnt(0)" ::: "memory")
__device__ __forceinline__ unsigned long long rt() { return __builtin_amdgcn_s_memrealtime(); }
__device__ __forceinline__ unsigned f2bf(float f) { unsigned u = __builtin_bit_cast(unsigned, f); return (u + 0x7fffu + ((u >> 16) & 1u)) >> 16; }
__device__ __forceinline__ unsigned pk2(float lo, float hi) { return f2bf(lo) | (f2bf(hi) << 16); }

#define XB_TMO      128
#define XB_XCNT(j)  (256  + 64 * (j))
#define XB_XSUB(j)  (1280 + 64 * (j))
#define XB_XGEN(j)  (2304 + 64 * (j))
#define XB_TOP      3328
#define XB_TOPGEN   3392
#define XCD_BAR_WORDS 3456
#define XB_SPIN_CAP (1u << 18)

__device__ __forceinline__ unsigned xb_ld(unsigned* p)              { return __hip_atomic_load(p, __ATOMIC_RELAXED, __HIP_MEMORY_SCOPE_AGENT); }
__device__ __forceinline__ unsigned xb_add(unsigned* p, unsigned v) { return __hip_atomic_fetch_add(p, v, __ATOMIC_RELAXED, __HIP_MEMORY_SCOPE_AGENT); }
__device__ __forceinline__ unsigned xb_xcc_id() { return (unsigned)__builtin_amdgcn_s_getreg((3 << 11) | 20) & 0xFu; }
#define XB_SPIN(cond, bar) do { unsigned _sp = 0; while (cond) { __builtin_amdgcn_s_sleep(1); \
    if ((++_sp & 255u) == 0u) { if (xb_ld(&(bar)[XB_TMO])) break; if (_sp > XB_SPIN_CAP) { atomicAdd(&(bar)[XB_TMO], 1u); break; } } } } while (0)

struct XcdBarrier {
    unsigned* bar; unsigned x;
    volatile LAS unsigned* st;
};

__device__ __forceinline__ XcdBarrier xcd_barrier_post(unsigned* bar, volatile LAS unsigned* st) {
    XcdBarrier b; b.bar = bar; b.x = xb_xcc_id(); b.st = st;
    if (threadIdx.x == 0) (void)xb_add(&bar[XB_XCNT(b.x)], 1u);
    return b;
}
__device__ __forceinline__ void xcd_barrier_complete(unsigned* bar, unsigned x, unsigned& nloc, unsigned& nx) {
    const unsigned G = gridDim.x * gridDim.y * gridDim.z;
    unsigned sum, cnt, mine, sp = 0u;
    for (;;) {
        sum = 0u; cnt = 0u; mine = 0u;
#pragma unroll
        for (unsigned j = 0; j < 16; ++j) { const unsigned c = xb_ld(&bar[XB_XCNT(j)]); sum += c; cnt += (c > 0u) ? 1u : 0u; mine = (j == x) ? c : mine; }
        if (sum == G) break;
        __builtin_amdgcn_s_sleep(1);
        if ((++sp & 255u) == 0u) { if (xb_ld(&bar[XB_TMO])) break; if (sp > XB_SPIN_CAP) { atomicAdd(&bar[XB_TMO], 1u); break; } }
    }
    nloc = mine > 0u ? mine : 1u; nx = cnt > 0u ? cnt : 1u;
}

__device__ __forceinline__ void xcd_barrier(const XcdBarrier& b) {
    asm volatile("s_waitcnt vmcnt(0)" ::: "memory");
    __syncthreads();
    if (threadIdx.x == 0) {
        unsigned* bar = b.bar;
        __builtin_amdgcn_s_waitcnt(0);
        unsigned nloc = b.st[0], nx = b.st[1];
        if (nloc == 0u) { xcd_barrier_complete(bar, b.x, nloc, nx); b.st[0] = nloc; b.st[1] = nx; }
        const unsigned old = xb_add(&bar[XB_XSUB(b.x)], 1u);
        const unsigned gen = old / nloc;
        if (old + 1u == (gen + 1u) * nloc) {
            __builtin_amdgcn_fence(__ATOMIC_RELEASE, "agent");
            asm volatile("s_waitcnt vmcnt(0)" ::: "memory");
            const unsigned og = xb_add(&bar[XB_TOP], 1u);
            const unsigned tg = og / nx;
            if (og + 1u == (tg + 1u) * nx) xb_add(&bar[XB_TOPGEN], 1u);
            else XB_SPIN(xb_ld(&bar[XB_TOPGEN]) == tg, bar);
            __builtin_amdgcn_fence(__ATOMIC_ACQUIRE, "agent");
            xb_add(&bar[XB_XGEN(b.x)], 1u);
            asm volatile("s_waitcnt vmcnt(0)" ::: "memory");
        } else {
            XB_SPIN(xb_ld(&bar[XB_XGEN(b.x)]) == gen, bar);
            __builtin_amdgcn_fence(__ATOMIC_ACQUIRE, "agent");
            asm volatile("s_waitcnt vmcnt(0)" ::: "memory");
        }
    }
    __syncthreads();
}

struct Args { const float* in[28]; float* out; unsigned char* ws; };
enum { I_XP = 0, I_XS, I_C1, I_C2, I_C3, I_SSH, I_SWKV, I_NMIX, I_WIN, I_MU, I_W0, I_W2, I_A0, I_A2, I_G2, I_KK, I_KA, I_RK, I_GNW, I_GNB,
       I_WPA, I_WPB, I_WOUT, I_NFFN, I_WGATE, I_WUP, I_WDOWN, I_NFIN };
typedef float f32x2 __attribute__((ext_vector_type(2)));
typedef unsigned u32x2 __attribute__((ext_vector_type(2)));

__device__ __forceinline__ float wave_sum(float v) {
#pragma unroll
    for (int o = 1; o < 64; o <<= 1) v += __shfl_xor(v, o);
    return v;
}
__device__ __forceinline__ float bf2f(unsigned short h) { return __builtin_bit_cast(float, (unsigned)h << 16); }
__device__ __forceinline__ float bflo(unsigned w) { return __builtin_bit_cast(float, w << 16); }
__device__ __forceinline__ float bfhi(unsigned w) { return __builtin_bit_cast(float, w & 0xffff0000u); }
__device__ __forceinline__ float sigmoidf_(float x) { return 1.0f / (1.0f + __expf(-x)); }

__device__ const float ROPE_FREQ[32] = {
    1.000000000e+00f, 7.498942614e-01f, 5.623413324e-01f, 4.216965139e-01f, 3.162277639e-01f, 2.371373773e-01f, 1.778279394e-01f, 1.333521307e-01f,
    1.000000015e-01f, 7.498941571e-02f, 5.623413250e-02f, 4.216965288e-02f, 3.162277490e-02f, 2.371373773e-02f, 1.778279431e-02f, 1.333521493e-02f,
    9.999999776e-03f, 7.498941850e-03f, 5.623413250e-03f, 4.216964822e-03f, 3.162277630e-03f, 2.371373586e-03f, 1.778279431e-03f, 1.333521446e-03f,
    1.000000047e-03f, 7.498942432e-04f, 5.623413017e-04f, 4.216965172e-04f, 3.162277571e-04f, 2.371373703e-04f, 1.778279402e-04f, 1.333521504e-04f};
__device__ __forceinline__ void sincos_acc(float xf, float& s, float& c) {
    const double x = (double)xf;
    const double q = __builtin_rint(x * 0.63661977236758134308);
    double r = __builtin_fma(-q, 1.57079632679489655800e+00, x); r = __builtin_fma(-q, 6.12323399573676603587e-17, r);
    const double r2 = r * r;
    double sp = -1.0 / 1307674368000.0; sp = sp * r2 + 1.0 / 6227020800.0; sp = sp * r2 - 1.0 / 39916800.0; sp = sp * r2 + 1.0 / 362880.0; sp = sp * r2 - 1.0 / 5040.0; sp = sp * r2 + 1.0 / 120.0; sp = sp * r2 - 1.0 / 6.0; sp = sp * r2 + 1.0; sp *= r;
    double cp = 1.0 / 20922789888000.0; cp = cp * r2 - 1.0 / 87178291200.0; cp = cp * r2 + 1.0 / 479001600.0; cp = cp * r2 - 1.0 / 3628800.0; cp = cp * r2 + 1.0 / 40320.0; cp = cp * r2 - 1.0 / 720.0; cp = cp * r2 + 1.0 / 24.0; cp = cp * r2 - 0.5; cp = cp * r2 + 1.0;
    const int qi = (int)((long long)q & 3);
    const double ss = (qi & 1) ? cp : sp, cc = (qi & 1) ? sp : cp;
    s = (float)((qi & 2) ? -ss : ss);
    c = (float)(((qi + 1) & 2) ? -cc : cc);
}

template <class Src> __device__ __forceinline__ void tr_item(const Src& src, bf16* WT, int Kd, LAS float* scr, int k0, int n0, int lane) {
#pragma unroll 8
    for (int i = 0; i < 32; ++i) { const int kk = 2 * i + (lane >> 5); scr[kk * 33 + (lane & 31)] = src(k0 + kk, n0 + (lane & 31)); }
    LDS_WAIT(); asm volatile("" ::: "memory");
    const int c = lane & 7;
#pragma unroll
    for (int j = 0; j < 4; ++j) { const int n = (lane >> 3) + 8 * j; const LAS float* s = scr + (8 * c) * 33 + n;
        v4u o; o.x = pk2(s[0 * 33], s[1 * 33]); o.y = pk2(s[2 * 33], s[3 * 33]); o.z = pk2(s[4 * 33], s[5 * 33]); o.w = pk2(s[6 * 33], s[7 * 33]);
        *(GAS v4u*)(WT + (size_t)(n0 + n) * Kd + k0 + 8 * c) = o; }
    LDS_WAIT(); asm volatile("" ::: "memory");
}
__device__ __forceinline__ int win_src_col(int np) {
    if (np < ACOLS) { const int part = np >> 9, kind = part % 3, within = np & 511, head = within >> 6, pos = within & 63;
        const int d = (kind < 2) ? ((pos & 1) * 32 + (pos >> 1)) : pos; return part * 512 + head * 64 + d; }
    if (np < ACOLS + SCP) { const int j = np - ACOLS; return j < SCOLS ? ACOLS + j : -1; }
    return ACOLS + SCOLS + (np - (ACOLS + SCP));
}

struct TileListOrder {
    pg8::StaticOrder S; int n0, b0, b1;
    __device__ void init(int M_, int nt, int n0_, int b0_, int b1_, int G_, int c_) { S.init(M_, nt * 256, G_, c_); n0 = n0_; b0 = b0_; b1 = b1_; }
    __device__ bool next(int i, pg8::Unit& u) const { if (!S.next(i, u)) return false; u.pn = (u.pn < n0) ? b0 + u.pn : b1 + (u.pn - n0); return true; }
    __device__ __forceinline__ void a_ready(const pg8::Unit&) const {}
    __device__ __forceinline__ void done(const pg8::Unit&) const {}
};
struct EpiIn {
    static constexpr bool PERM = true, AFTER_DRAIN = false; static constexpr int MID_T = 0;
    bf16* Q; bf16* Kb; bf16* VT; bf16* SC; bf16* GT; float* out; const float* rope;
    __device__ __forceinline__ void operator()(const pg8::f32x4 (&acc)[2][2][4][2], const pg8::Unit& u, int wr, int wc, int fr, int fq) const {
        const int tn = u.pn;
        const int rowb = u.pm * 256 + wr * 64 + fr;
        if (tn < 18) {
            const int part = tn >> 1, g = part / 3, kind = part - 3 * g, hf = tn & 1;
            const int lgd = 2 * g, dil = 1 << lgd, L = T >> lgd, keep = (g == 0) ? 128 : (g == 1) ? 512 : 2048;
            const size_t okv = (g == 0) ? O_KV1P : (g == 1) ? O_KV2P : O_KV3P;
            const int pos0 = 32 * (wc & 1) + 8 * fq;
#pragma unroll
            for (int ai = 0; ai < 2; ++ai)
#pragma unroll
                for (int m = 0; m < 4; ++m) {
                    const int row = rowb + ai * 128 + m * 16, b = row >> 11, t = row & (T - 1);
                    const int p = (t & (dil - 1)) * L + (t >> lgd);
                    const size_t prow = (size_t)g * M + (size_t)b * T + p;
                    const int tk = t - (T - keep);
                    if (kind < 2) {
                        const int i0 = pos0 >> 1;
                        const pg8::f32x4 cs0 = *(const pg8::f32x4*)(rope + ((size_t)t * 32 + i0) * 2), cs1 = *(const pg8::f32x4*)(rope + ((size_t)t * 32 + i0 + 2) * 2);
#pragma unroll
                        for (int bj = 0; bj < 2; ++bj) {
                            const int head = 4 * hf + 2 * bj + (wc >> 1);
                            const pg8::f32x4 v0 = acc[ai][bj][m][0], v1 = acc[ai][bj][m][1];
                            float o[8];
                            o[0] = v0[0] * cs0[0] - v0[1] * cs0[1]; o[1] = v0[0] * cs0[1] + v0[1] * cs0[0];
                            o[2] = v0[2] * cs0[2] - v0[3] * cs0[3]; o[3] = v0[2] * cs0[3] + v0[3] * cs0[2];
                            o[4] = v1[0] * cs1[0] - v1[1] * cs1[1]; o[5] = v1[0] * cs1[1] + v1[1] * cs1[0];
                            o[6] = v1[2] * cs1[2] - v1[3] * cs1[3]; o[7] = v1[2] * cs1[3] + v1[3] * cs1[2];
                            if (kind == 0) {
                                pg8::u32x4 w; w.x = pg8::cvt_pk_bf16(o[0] * QSCALE, o[1] * QSCALE); w.y = pg8::cvt_pk_bf16(o[2] * QSCALE, o[3] * QSCALE);
                                w.z = pg8::cvt_pk_bf16(o[4] * QSCALE, o[5] * QSCALE); w.w = pg8::cvt_pk_bf16(o[6] * QSCALE, o[7] * QSCALE);
                                *(pg8::u32x4*)(Q + prow * 512 + head * 64 + pos0) = w;
                            } else {
                                pg8::u32x4 w; w.x = pg8::cvt_pk_bf16(o[0], o[1]); w.y = pg8::cvt_pk_bf16(o[2], o[3]); w.z = pg8::cvt_pk_bf16(o[4], o[5]); w.w = pg8::cvt_pk_bf16(o[6], o[7]);
                                *(pg8::u32x4*)(Kb + prow * 512 + head * 64 + pos0) = w;
                                if (tk >= 0) { float* ob = out + okv + (((size_t)b * keep + tk) * 2 + 0) * 512 + head * 64;
                                    *(pg8::f32x4*)(ob + i0) = (pg8::f32x4){o[0], o[2], o[4], o[6]}; *(pg8::f32x4*)(ob + 32 + i0) = (pg8::f32x4){o[1], o[3], o[5], o[7]}; }
                            }
                        }
                    } else {
#pragma unroll
                        for (int bj = 0; bj < 2; ++bj) {
                            const int head = 4 * hf + 2 * bj + (wc >> 1);
                            const pg8::f32x4 v0 = acc[ai][bj][m][0], v1 = acc[ai][bj][m][1];
                            pg8::u32x4 w; w.x = pg8::cvt_pk_bf16(v0[0], v0[1]); w.y = pg8::cvt_pk_bf16(v0[2], v0[3]); w.z = pg8::cvt_pk_bf16(v1[0], v1[1]); w.w = pg8::cvt_pk_bf16(v1[2], v1[3]);
                            *(pg8::u32x4*)(VT + prow * 512 + head * 64 + pos0) = w;
                            if (tk >= 0) { float* ob = out + okv + (((size_t)b * keep + tk) * 2 + 1) * 512 + head * 64 + pos0;
                                *(pg8::f32x4*)(ob) = v0; *(pg8::f32x4*)(ob + 4) = v1; }
                        }
                    }
                }
        } else if (tn < 32) {
            const int cb = (tn - 18) * 256 + wc * 32 + 8 * fq;
#pragma unroll
            for (int ai = 0; ai < 2; ++ai)
#pragma unroll
                for (int m = 0; m < 4; ++m) {
                    const int row = rowb + ai * 128 + m * 16, b = row >> 11, t = row & (T - 1);
#pragma unroll
                    for (int bj = 0; bj < 2; ++bj) {
                        const int col = cb + bj * 128;
                        const pg8::f32x4 v0 = acc[ai][bj][m][0], v1 = acc[ai][bj][m][1];
                        pg8::u32x4 w; w.x = pg8::cvt_pk_bf16(v0[0], v0[1]); w.y = pg8::cvt_pk_bf16(v0[2], v0[3]); w.z = pg8::cvt_pk_bf16(v1[0], v1[1]); w.w = pg8::cvt_pk_bf16(v1[2], v1[3]);
                        *(pg8::u32x4*)(SC + (size_t)row * SCP + col) = w;
                        if (t == T - 1 && col < SCOLS) { float* ob = out + O_SHP + (size_t)b * SCOLS + col; *(pg8::f32x4*)(ob) = v0; *(pg8::f32x4*)(ob + 4) = v1; }
                    }
                }
        } else {
            const int cb = (tn - 32) * 256 + wc * 32 + 8 * fq;
#pragma unroll
            for (int ai = 0; ai < 2; ++ai)
#pragma unroll
                for (int m = 0; m < 4; ++m) {
                    const int row = rowb + ai * 128 + m * 16;
#pragma unroll
                    for (int bj = 0; bj < 2; ++bj) {
                        const int col = cb + bj * 128;
                        const pg8::f32x4 v0 = acc[ai][bj][m][0], v1 = acc[ai][bj][m][1];
                        pg8::u32x4 w; w.x = pg8::cvt_pk_bf16(sigmoidf_(v0[0]), sigmoidf_(v0[1])); w.y = pg8::cvt_pk_bf16(sigmoidf_(v0[2]), sigmoidf_(v0[3]));
                        w.z = pg8::cvt_pk_bf16(sigmoidf_(v1[0]), sigmoidf_(v1[1])); w.w = pg8::cvt_pk_bf16(sigmoidf_(v1[2]), sigmoidf_(v1[3]));
                        *(pg8::u32x4*)(GT + (size_t)row * 2048 + col) = w;
                    }
                }
        }
    }
};

__device__ __forceinline__ int opaque_int(int v) { asm volatile("" : "+s"(v)); return v; }
struct Frame {
    LAS unsigned char* lds; volatile LAS unsigned* MISC; gu32* ctl;
    int tid, lane, wave, vcu, G, gw, NGW;
};

__device__ __forceinline__ void p0_prologue(const Frame& F, const Args& a, unsigned char* ws) {
    LAS float* scr = (LAS float*)(F.lds + RING_OFF + F.wave * 16384);
    const int gw = F.gw, NGW = F.NGW, lane = F.lane;
    constexpr int IT_WIN = 16 * (INP / 32), IT_WA = 8 * 32, IT_WB = 16 * 32, IT_WO = 16 * 32, IT_WGU = 16 * (GU / 32), IT_WD = 44 * 32, IT_WWA = 2 * 64, IT_WG = 4 * 32;
    constexpr int NITEMS = IT_WIN + IT_WA + IT_WB + IT_WO + IT_WGU + IT_WD + IT_WWA + IT_WG;
    for (int it = gw; it < NITEMS; it += NGW) {
        int r = it;
        if (r < IT_WIN) { const int nb = r % (INP / 32), kb = r / (INP / 32); const float* W = a.in[I_WIN];
            tr_item([&](int k, int np) { const int sc = win_src_col(np); return sc >= 0 ? W[(size_t)k * INCOLS + sc] : 0.f; }, (bf16*)(ws + WS_WIN), DM, scr, 64 * kb, 32 * nb, lane); continue; }
        r -= IT_WIN;
        if (r < IT_WA) { const int nb = r % 32, kb = r / 32; const float* W = a.in[I_WPA];
            tr_item([&](int k, int n) { return W[(size_t)k * DM + n]; }, (bf16*)(ws + WS_WA), 1536, scr, 64 * kb, 32 * nb, lane); continue; }
        r -= IT_WA;
        if (r < IT_WB) { const int nb = r % 32, kb = r / 32; const float* W = a.in[I_WPB];
            tr_item([&](int k, int n) { return W[(size_t)(k - AWID) * DM + n]; }, (bf16*)(ws + WS_WA), 1536, scr, AWID + 64 * kb, 32 * nb, lane); continue; }
        r -= IT_WB;
        if (r < IT_WO) { const int nb = r % 32, kb = r / 32; const float* W = a.in[I_WOUT];
            tr_item([&](int k, int n) { return W[(size_t)k * DM + n]; }, (bf16*)(ws + WS_WO), DM, scr, 64 * kb, 32 * nb, lane); continue; }
        r -= IT_WO;
        if (r < IT_WGU) { const int nb = r % (GU / 32), kb = r / (GU / 32); const int n0 = 32 * nb, tile = n0 >> 8, w0 = n0 & 255;
            const float* W = (w0 < 128) ? a.in[I_WGATE] : a.in[I_WUP]; const float* gsc = a.in[I_NFFN]; const int cbase = tile * 128 + (w0 & 127) - n0;
            tr_item([&](int k, int np) { return W[(size_t)k * DFF + cbase + np] * gsc[k]; }, (bf16*)(ws + WS_WGU), DM, scr, 64 * kb, n0, lane); continue; }
        r -= IT_WGU;
        if (r < IT_WD) { const int nb = r % 32, kb = r / 32; const float* W = a.in[I_WDOWN];
            tr_item([&](int k, int n) { return W[(size_t)k * DM + n]; }, (bf16*)(ws + WS_WD), DFF, scr, 64 * kb, 32 * nb, lane); continue; }
        r -= IT_WD;
        if (r < IT_WWA) { const int nb = r % 64, kb = r / 64; const float* W2 = a.in[I_W2]; const float* A2 = a.in[I_A2];
            tr_item([&](int k, int n) { return (n < 1024) ? (k < 64 ? W2[(size_t)k * BWID + n] : 0.f) : (k >= 64 ? A2[(size_t)(k - 64) * BWID + (n - 1024)] : 0.f); }, (bf16*)(ws + WS_WWA), 128, scr, 64 * kb, 32 * nb, lane); continue; }
        r -= IT_WWA;
        { const int nb = r % 32, kb = r / 32; const float* G2 = a.in[I_G2];
            tr_item([&](int k, int n) { return k < 160 ? G2[(size_t)k * BWID + n] : 0.f; }, (bf16*)(ws + WS_WG), 256, scr, 64 * kb, 32 * nb, lane); }
    }
    {
        const float* gmix = a.in[I_NMIX];
        f32x4 gv[4];
#pragma unroll
        for (int j = 0; j < 4; ++j) gv[j] = *(const f32x4*)(gmix + 4 * lane + 256 * j);
        for (int m = gw; m < M + SB; m += NGW) {
            const float* xrow = (m < M) ? a.in[I_XP] + (size_t)m * DM : a.in[I_XS] + (size_t)(m - M) * DM;
            bf16* orow = (m < M) ? (bf16*)(ws + WS_XN) + (size_t)m * DM : (bf16*)(ws + WS_SMP + SM_HSN) + (size_t)(m - M) * DM;
            const GAS f32x4* xr = (const GAS f32x4*)xrow + lane;
            f32x4 v[4]; float s = 0.f;
#pragma unroll
            for (int j = 0; j < 4; ++j) { v[j] = xr[64 * j]; s += (v[j].x * v[j].x + v[j].y * v[j].y) + (v[j].z * v[j].z + v[j].w * v[j].w); }
            const float rstd = 1.0f / sqrtf(wave_sum(s) * (1.f / DM) + NORM_EPS);
            GAS unsigned long long* o8 = (GAS unsigned long long*)orow + lane;
#pragma unroll
            for (int j = 0; j < 4; ++j) { const f32x4 y = v[j] * rstd * gv[j]; o8[64 * j] = (unsigned long long)pk2(y.x, y.y) | ((unsigned long long)pk2(y.z, y.w) << 32); }
        }
    }
    {
        float* tab = (float*)(ws + WS_TAB);
        for (int e = F.vcu * 512 + F.tid; e < 2049 * 32; e += F.G * 512) {
            const int pi = e >> 5, i = e & 31; const float pos = (pi < 2048) ? (float)pi : (float)PAST;
            const float ang = pos * ROPE_FREQ[i]; float s, c; sincos_acc(ang, s, c);
            *(f32x2*)(tab + 2 * (size_t)e) = (f32x2){c, s};
        }
    }
    {
        float* ss = (float*)(ws + WS_SS);
        for (int e = F.vcu * 512 + F.tid; e < 65536; e += F.G * 512) ss[e] = 0.f;
    }
}


typedef float f32x16 __attribute__((ext_vector_type(16)));
__device__ __forceinline__ float dpp_f(float v, const int ctrl_sel) {
    const int x = __builtin_bit_cast(int, v); int r;
    if (ctrl_sel == 0) r = __builtin_amdgcn_update_dpp(0, x, 0xB1, 0xF, 0xF, true);
    else if (ctrl_sel == 1) r = __builtin_amdgcn_update_dpp(0, x, 0x4E, 0xF, 0xF, true);
    else if (ctrl_sel == 2) r = __builtin_amdgcn_update_dpp(0, x, 0x141, 0xF, 0xF, true);
    else r = __builtin_amdgcn_update_dpp(0, x, 0x140, 0xF, 0xF, true);
    return __builtin_bit_cast(float, r);
}
__device__ __forceinline__ float red4(float v) { v += dpp_f(v, 0); v += dpp_f(v, 1); return v; }
__device__ __forceinline__ float red8(float v) { v = red4(v); v += dpp_f(v, 2); return v; }
__device__ __forceinline__ float red16(float v) { v = red8(v); v += dpp_f(v, 3); return v; }
__device__ __forceinline__ float fma_s(float a, float b, float c) { float r; asm("v_fma_f32 %0, %1, %2, %3" : "=v"(r) : "v"(a), "v"(b), "v"(c)); return r; }
__device__ __forceinline__ float mul_s(float a, float b) { float r; asm("v_mul_f32 %0, %1, %2" : "=v"(r) : "v"(a), "v"(b)); return r; }
__device__ __forceinline__ void red16x2(float& a, float& b) {
    a += dpp_f(a, 0); b += dpp_f(b, 0); a += dpp_f(a, 1); b += dpp_f(b, 1); a += dpp_f(a, 2); b += dpp_f(b, 2); a += dpp_f(a, 3); b += dpp_f(b, 3);
}
__device__ __forceinline__ void red8x2(float& a, float& b) {
    a += dpp_f(a, 0); b += dpp_f(b, 0); a += dpp_f(a, 1); b += dpp_f(b, 1); a += dpp_f(a, 2); b += dpp_f(b, 2);
}
__device__ __forceinline__ float tanh_(float x) { return 1.0f - 2.0f / (1.0f + __expf(2.0f * x)); }
typedef float f32x2_t __attribute__((ext_vector_type(2))); typedef __bf16 bf16x2_t __attribute__((ext_vector_type(2)));
__device__ __forceinline__ unsigned cvtpk_s(float lo, float hi) { f32x2_t v = {lo, hi}; bf16x2_t b = __builtin_convertvector(v, bf16x2_t); return __builtin_bit_cast(unsigned, b); }
__device__ __forceinline__ bf16x8 pack8(const float* p) {
    v4u w; w.x = cvtpk_s(p[0], p[1]); w.y = cvtpk_s(p[2], p[3]); w.z = cvtpk_s(p[4], p[5]); w.w = cvtpk_s(p[6], p[7]);
    return __builtin_bit_cast(bf16x8, w);
}

typedef short v4i16_t __attribute__((ext_vector_type(4)));
__device__ __forceinline__ void attn_unit(int g, int b, int head, int qt, const bf16* Qb, const bf16* Kb, const bf16* VT, bf16* OG, float* LSE, int lane, LAS unsigned char* vl) {
    const int lgd = 2 * g, dil = 1 << lgd, L = T >> lgd;
    const int p0 = qt * 32, r = p0 >> (11 - lgd), u0 = p0 & (L - 1);
    const int q = lane & 31, h = lane >> 5;
    const size_t rb = ((size_t)g * M + (size_t)b * T) * 512 + head * 64;
    const bf16* Qg = Qb + rb; const bf16* Kg = Kb + rb;
    const bf16* Vg = VT + rb;
    bf16x8 qf[4];
#pragma unroll
    for (int ks = 0; ks < 4; ++ks) qf[ks] = *(const bf16x8*)(Qg + (size_t)(p0 + q) * 512 + 16 * ks + 8 * h);
    const int kt0 = (u0 >= 128) ? 0 : 4 - (u0 >> 5);
    const int kbase = r * L + u0 - 128;
    f32x16 s[5];
    bf16x8 kc[4], kn[4];
    { const int kp0 = (0 >= kt0) ? kbase : r * L; const bf16* kp = Kg + (size_t)(kp0 + q) * 512 + 8 * h;
#pragma unroll
      for (int ks = 0; ks < 4; ++ks) kc[ks] = *(const bf16x8*)(kp + 16 * ks); }
#pragma unroll
    for (int kt = 0; kt < 5; ++kt) {
        if (kt < 4) { const int kpn = (kt + 1 >= kt0) ? kbase + 32 * (kt + 1) : r * L; const bf16* kp = Kg + (size_t)(kpn + q) * 512 + 8 * h;
#pragma unroll
            for (int ks = 0; ks < 4; ++ks) kn[ks] = *(const bf16x8*)(kp + 16 * ks); }
        f32x16 acc = {};
#pragma unroll
        for (int ks = 0; ks < 4; ++ks) acc = __builtin_amdgcn_mfma_f32_32x32x16_bf16(kc[ks], qf[ks], acc, 0, 0, 0);
        const bool tv = kt >= kt0;
#pragma unroll
        for (int rg = 0; rg < 16; ++rg) { const int krow = (rg & 3) + 8 * (rg >> 2) + 4 * h;
            bool ok = tv; if (kt == 0) ok = ok && (krow >= q); if (kt == 4) ok = ok && (krow <= q);
            acc[rg] = ok ? acc[rg] : -INFINITY; }
        s[kt] = acc;
#pragma unroll
        for (int ks = 0; ks < 4; ++ks) kc[ks] = kn[ks];
    }
    float mx = -INFINITY;
#pragma unroll
    for (int kt = 0; kt < 5; ++kt)
#pragma unroll
        for (int rg = 0; rg < 16; ++rg) mx = fmaxf(mx, s[kt][rg]);
    mx = fmaxf(mx, __shfl_xor(mx, 32));
    float l = 0.f;
#pragma unroll
    for (int kt = 0; kt < 5; ++kt)
#pragma unroll
        for (int rg = 0; rg < 16; ++rg) { const float p = __builtin_amdgcn_exp2f(s[kt][rg] - mx); s[kt][rg] = p; l += p; }
    l += __shfl_xor(l, 32);
    f32x16 o0 = {}, o1 = {};
    v4u vc4[4], vn4[4];
    { const int kp0 = (0 >= kt0) ? kbase : r * L; const bf16* vsrc = Vg + (size_t)(kp0 + (lane >> 3)) * 512 + (lane & 7) * 8;
#pragma unroll
      for (int i = 0; i < 4; ++i) vc4[i] = *(const v4u*)(vsrc + (size_t)(8 * i) * 512); }
#pragma unroll
    for (int kt = 0; kt < 5; ++kt) {
        if (kt < 4) { const int kpn = (kt + 1 >= kt0) ? kbase + 32 * (kt + 1) : r * L; const bf16* vsrc = Vg + (size_t)(kpn + (lane >> 3)) * 512 + (lane & 7) * 8;
#pragma unroll
            for (int i = 0; i < 4; ++i) vn4[i] = *(const v4u*)(vsrc + (size_t)(8 * i) * 512); }
#pragma unroll
        for (int i = 0; i < 4; ++i) *(LAS v4u*)(vl + ((lane >> 3) + 8 * i) * 192 + (lane & 7) * 16) = vc4[i];
#pragma unroll
        for (int si = 0; si < 2; ++si) {
            float pp[8];
#pragma unroll
            for (int j = 0; j < 8; ++j) pp[j] = s[kt][8 * si + j];
            const bf16x8 pb = pack8(pp);
            const int gi = lane >> 4, i16 = lane & 15;
            LAS unsigned char* tb = vl + (16 * si + 4 * (gi >> 1) + (i16 >> 2)) * 192 + (16 * (gi & 1) + 4 * (i16 & 3)) * 2;
            const v4i16_t a0 = __builtin_amdgcn_ds_read_tr16_b64_v4i16((LAS v4i16_t*)(tb));
            const v4i16_t a1 = __builtin_amdgcn_ds_read_tr16_b64_v4i16((LAS v4i16_t*)(tb + 8 * 192));
            const v4i16_t c0 = __builtin_amdgcn_ds_read_tr16_b64_v4i16((LAS v4i16_t*)(tb + 64));
            const v4i16_t c1 = __builtin_amdgcn_ds_read_tr16_b64_v4i16((LAS v4i16_t*)(tb + 8 * 192 + 64));
            const bf16x8 va = {a0[0], a0[1], a0[2], a0[3], a1[0], a1[1], a1[2], a1[3]}, vc = {c0[0], c0[1], c0[2], c0[3], c1[0], c1[1], c1[2], c1[3]};
            o0 = __builtin_amdgcn_mfma_f32_32x32x16_bf16(va, pb, o0, 0, 0, 0);
            o1 = __builtin_amdgcn_mfma_f32_32x32x16_bf16(vc, pb, o1, 0, 0, 0);
        }
#pragma unroll
        for (int i = 0; i < 4; ++i) vc4[i] = vn4[i];
    }
    const float inv = 1.0f / l;
    const int t = r + dil * (u0 + q);
    bf16* op = OG + ((size_t)g * M + (size_t)b * T + t) * 512 + head * 64 + 4 * h;
#pragma unroll
    for (int rg = 0; rg < 4; ++rg) {
        u32x2 w; w.x = pg8::cvt_pk_bf16(o0[4 * rg] * inv, o0[4 * rg + 1] * inv); w.y = pg8::cvt_pk_bf16(o0[4 * rg + 2] * inv, o0[4 * rg + 3] * inv);
        *(u32x2*)(op + 8 * rg) = w;
        u32x2 w2; w2.x = pg8::cvt_pk_bf16(o1[4 * rg] * inv, o1[4 * rg + 1] * inv); w2.y = pg8::cvt_pk_bf16(o1[4 * rg + 2] * inv, o1[4 * rg + 3] * inv);
        *(u32x2*)(op + 32 + 8 * rg) = w2;
    }
    if (h == 0) LSE[((size_t)g * M + (size_t)b * T + t) * 8 + head] = (mx + __builtin_amdgcn_logf(l)) * LN2;
}

__device__ __forceinline__ void r1_rows(const Frame& F, const bf16* SC, const float* mu, bf16* A1, bf16* A2) {
    float mul[6];
#pragma unroll
    for (int i = 0; i < 6; ++i) { const int e = F.lane + 64 * i; mul[i] = (e < 288) ? mu[3072 + e] : 0.f; }
    for (int m = F.gw; m < M; m += F.NGW) {
        const int t = m & (T - 1);
        const bf16* p = SC + (size_t)m * SCP + 3072;
#pragma unroll
        for (int i = 0; i < 6; ++i) {
            const int e = F.lane + 64 * i;
            if (e < 288) {
                const float x = bf2f(p[e]); const float xp = (t > 0) ? bf2f(p[e - SCP]) : 0.f;
                const float xm = x + (xp - x) * mul[i];
                if (e < 64) A1[(size_t)m * 128 + e] = (bf16)f2bf(tanh_(xm));
                else if (e < 128) A1[(size_t)m * 128 + e] = (bf16)f2bf(xm);
                else A2[(size_t)m * 256 + (e - 128)] = (bf16)f2bf(sigmoidf_(xm));
            } else A2[(size_t)m * 256 + (e - 128)] = 0;
        }
    }
}

__device__ __forceinline__ void attn_item(const Frame& F, int item, const bf16* Qb, const bf16* Kb, const bf16* VT, bf16* OG, float* LSE, bf16* OA) {
    const int b = item >> 5, head = (item >> 2) & 7, tb = item & 3;
#pragma unroll 1
    for (int i = 0; i < 6; ++i) {
        const int u = F.wave + 8 * i, g = u >> 4, q = u & 15;
        const int qt = (g == 0) ? (16 * tb + q) : (g == 1) ? ((q >> 2) * 16 + 4 * tb + (q & 3)) : (q * 4 + tb);
        attn_unit(g, b, head, qt, Qb, Kb, VT, OG, LSE, F.lane, F.lds + RING_OFF + F.wave * 8192);
    }
    VM_WAIT(); __syncthreads();
    for (int it = F.tid; it < 512 * 8; it += 512) {
        const int m = b * T + tb * 512 + (it >> 3), cg = head * 8 + (it & 7);
        const float l0 = LSE[(size_t)m * 8 + head], l1 = LSE[((size_t)M + m) * 8 + head], l2 = LSE[((size_t)2 * M + m) * 8 + head];
        const float mx = fmaxf(l0, fmaxf(l1, l2));
        float e0 = __expf(l0 - mx), e1 = __expf(l1 - mx), e2 = __expf(l2 - mx); const float inv = 1.0f / (e0 + e1 + e2); e0 *= inv; e1 *= inv; e2 *= inv;
        const v4u a = *(const v4u*)(OG + (size_t)m * 512 + cg * 8), bb = *(const v4u*)(OG + ((size_t)M + m) * 512 + cg * 8), c = *(const v4u*)(OG + ((size_t)2 * M + m) * 512 + cg * 8);
        v4u o;
        o.x = pg8::cvt_pk_bf16(e0 * bflo(a.x) + e1 * bflo(bb.x) + e2 * bflo(c.x), e0 * bfhi(a.x) + e1 * bfhi(bb.x) + e2 * bfhi(c.x));
        o.y = pg8::cvt_pk_bf16(e0 * bflo(a.y) + e1 * bflo(bb.y) + e2 * bflo(c.y), e0 * bfhi(a.y) + e1 * bfhi(bb.y) + e2 * bfhi(c.y));
        o.z = pg8::cvt_pk_bf16(e0 * bflo(a.z) + e1 * bflo(bb.z) + e2 * bflo(c.z), e0 * bfhi(a.z) + e1 * bfhi(bb.z) + e2 * bfhi(c.z));
        o.w = pg8::cvt_pk_bf16(e0 * bflo(a.w) + e1 * bflo(bb.w) + e2 * bflo(c.w), e0 * bfhi(a.w) + e1 * bfhi(bb.w) + e2 * bfhi(c.w));
        *(v4u*)(OA + (size_t)m * 1536 + cg * 8) = o;
    }
    __syncthreads();
}
__device__ __forceinline__ void combine_groups(const Frame& F, const bf16* OG, const float* LSE, bf16* OA) {
    for (int it = F.vcu * 512 + F.tid; it < M * 64; it += F.G * 512) {
        const int m = it >> 6, cg = it & 63, head = cg >> 3;
        const float l0 = LSE[(size_t)m * 8 + head], l1 = LSE[((size_t)M + m) * 8 + head], l2 = LSE[((size_t)2 * M + m) * 8 + head];
        const float mx = fmaxf(l0, fmaxf(l1, l2));
        float e0 = __expf(l0 - mx), e1 = __expf(l1 - mx), e2 = __expf(l2 - mx); const float inv = 1.0f / (e0 + e1 + e2); e0 *= inv; e1 *= inv; e2 *= inv;
        const v4u a = *(const v4u*)(OG + (size_t)m * 512 + cg * 8), b = *(const v4u*)(OG + ((size_t)M + m) * 512 + cg * 8), c = *(const v4u*)(OG + ((size_t)2 * M + m) * 512 + cg * 8);
        v4u o;
        o.x = pg8::cvt_pk_bf16(e0 * bflo(a.x) + e1 * bflo(b.x) + e2 * bflo(c.x), e0 * bfhi(a.x) + e1 * bfhi(b.x) + e2 * bfhi(c.x));
        o.y = pg8::cvt_pk_bf16(e0 * bflo(a.y) + e1 * bflo(b.y) + e2 * bflo(c.y), e0 * bfhi(a.y) + e1 * bfhi(b.y) + e2 * bfhi(c.y));
        o.z = pg8::cvt_pk_bf16(e0 * bflo(a.z) + e1 * bflo(b.z) + e2 * bflo(c.z), e0 * bfhi(a.z) + e1 * bfhi(b.z) + e2 * bfhi(c.z));
        o.w = pg8::cvt_pk_bf16(e0 * bflo(a.w) + e1 * bflo(b.w) + e2 * bflo(c.w), e0 * bfhi(a.w) + e1 * bfhi(b.w) + e2 * bfhi(c.w));
        *(v4u*)(OA + (size_t)m * 512 + cg * 8) = o;
    }
}

struct EpiWA {
    static constexpr bool PERM = true, AFTER_DRAIN = false; static constexpr int MID_T = 0;
    float* LW; bf16* AV; const float* w0; const float* a0;
    __device__ __forceinline__ void operator()(const pg8::f32x4 (&acc)[2][2][4][2], const pg8::Unit& u, int wr, int wc, int fr, int fq) const {
        const bool isw = u.pn < 4; const int cb = (u.pn & 3) * 256 + wc * 32 + 8 * fq; const float* bias = isw ? w0 : a0;
#pragma unroll
        for (int bj = 0; bj < 2; ++bj) {
            const int col = cb + bj * 128; const f32x4 b0 = *(const f32x4*)(bias + col), b1 = *(const f32x4*)(bias + col + 4);
#pragma unroll
            for (int ai = 0; ai < 2; ++ai)
#pragma unroll
                for (int m = 0; m < 4; ++m) {
                    const int row = u.pm * 256 + wr * 64 + fr + ai * 128 + m * 16;
                    const pg8::f32x4 v0 = acc[ai][bj][m][0], v1 = acc[ai][bj][m][1];
                    float e[8] = {sigmoidf_(v0[0] + b0[0]), sigmoidf_(v0[1] + b0[1]), sigmoidf_(v0[2] + b0[2]), sigmoidf_(v0[3] + b0[3]), sigmoidf_(v1[0] + b1[0]), sigmoidf_(v1[1] + b1[1]), sigmoidf_(v1[2] + b1[2]), sigmoidf_(v1[3] + b1[3])};
                    if (isw) {
#pragma unroll
                        for (int q = 0; q < 8; ++q) { float x = e[q] * -0.60653065971263342f;
                            x += __builtin_bit_cast(float, __builtin_amdgcn_update_dpp(0, __builtin_bit_cast(int, x), 0x111, 0xF, 0xF, true));
                            x += __builtin_bit_cast(float, __builtin_amdgcn_update_dpp(0, __builtin_bit_cast(int, x), 0x112, 0xF, 0xF, true));
                            x += __builtin_bit_cast(float, __builtin_amdgcn_update_dpp(0, __builtin_bit_cast(int, x), 0x114, 0xF, 0xF, true));
                            x += __builtin_bit_cast(float, __builtin_amdgcn_update_dpp(0, __builtin_bit_cast(int, x), 0x118, 0xF, 0xF, true));
                            e[q] = x; }
                        *(f32x4*)(LW + (size_t)row * 1024 + col) = (f32x4){e[0], e[1], e[2], e[3]}; *(f32x4*)(LW + (size_t)row * 1024 + col + 4) = (f32x4){e[4], e[5], e[6], e[7]};
                    } else {
                        pg8::u32x4 w; w.x = pg8::cvt_pk_bf16(e[0], e[1]); w.y = pg8::cvt_pk_bf16(e[2], e[3]); w.z = pg8::cvt_pk_bf16(e[4], e[5]); w.w = pg8::cvt_pk_bf16(e[6], e[7]);
                        *(pg8::u32x4*)(AV + (size_t)row * 1024 + col) = w;
                    }
                }
        }
    }
};
struct EpiPlain {
    static constexpr bool PERM = true, AFTER_DRAIN = false; static constexpr int MID_T = 0;
    bf16* O; int ldc;
    __device__ __forceinline__ void operator()(const pg8::f32x4 (&acc)[2][2][4][2], const pg8::Unit& u, int wr, int wc, int fr, int fq) const {
        const int cb = u.pn * 256 + wc * 32 + 8 * fq;
#pragma unroll
        for (int ai = 0; ai < 2; ++ai)
#pragma unroll
            for (int m = 0; m < 4; ++m) {
                const int row = u.pm * 256 + wr * 64 + fr + ai * 128 + m * 16;
#pragma unroll
                for (int bj = 0; bj < 2; ++bj) {
                    const pg8::f32x4 v0 = acc[ai][bj][m][0], v1 = acc[ai][bj][m][1];
                    pg8::u32x4 w; w.x = pg8::cvt_pk_bf16(v0[0], v0[1]); w.y = pg8::cvt_pk_bf16(v0[2], v0[3]); w.z = pg8::cvt_pk_bf16(v1[0], v1[1]); w.w = pg8::cvt_pk_bf16(v1[2], v1[3]);
                    *(pg8::u32x4*)(O + (size_t)row * ldc + cb + bj * 128) = w;
                }
            }
    }
};

struct ScanRegs { u32x2 pr, pk, pv, qr, qk, qv, e4, a4; };
__device__ __forceinline__ void scan_load(ScanRegs& R, const bf16* SC, const bf16* E, const bf16* AV, int b, int t, int cr) {
    const size_t m = (size_t)b * T + t; const bf16* p = SC + m * SCP + cr;
    R.pr = *(const u32x2*)(p); R.pk = *(const u32x2*)(p + 1024); R.pv = *(const u32x2*)(p + 2048);
    if (t > 0) { R.qr = *(const u32x2*)(p - SCP); R.qk = *(const u32x2*)(p - SCP + 1024); R.qv = *(const u32x2*)(p - SCP + 2048); }
    else { R.qr = (u32x2){0u, 0u}; R.qk = (u32x2){0u, 0u}; R.qv = (u32x2){0u, 0u}; }
    R.e4 = *(const u32x2*)(E + m * 1024 + cr); R.a4 = *(const u32x2*)(AV + m * 1024 + cr);
}
__device__ __forceinline__ f32x4 bf4(u32x2 w) { return (f32x4){bflo(w.x), bfhi(w.x), bflo(w.y), bfhi(w.y)}; }
__device__ __forceinline__ void scan_phase(const Frame& F, const Args& a, unsigned char* ws, int first, int stride) {
    const bf16* SC = (const bf16*)(ws + WS_SC); const bf16* E = (const bf16*)(ws + WS_E); const bf16* AV = (const bf16*)(ws + WS_AV);
    float* Y = (float*)(ws + WS_Y); float* CB = (float*)(ws + WS_CB);
    LAS float* L = (LAS float*)(F.lds + RING_OFF); LAS float* YB = (LAS float*)(F.lds + RING_OFF + 49152);
    const int tid = F.tid, lane = F.lane, wave = F.wave;
    for (int chain = first; chain < NB * BHEADS; chain += stride) {
        const int b = chain >> 4, head = chain & 15;
        const int ss = tid >> 4, j4 = (tid & 15) * 4, cr = head * 64 + j4;
        const f32x4 mur = *(const f32x4*)(a.in[I_MU] + cr), muk = *(const f32x4*)(a.in[I_MU] + 1024 + cr), muv = *(const f32x4*)(a.in[I_MU] + 2048 + cr);
        const f32x4 kkw = *(const f32x4*)(a.in[I_KK] + cr), kaw = *(const f32x4*)(a.in[I_KA] + cr), rkw = *(const f32x4*)(a.in[I_RK] + cr);
        const int rloc8 = 8 * wave + (lane >> 3), c8 = (lane & 7) * 8;
        f32x4 Sa = {0.f, 0.f, 0.f, 0.f}, Sb = {0.f, 0.f, 0.f, 0.f};
        ScanRegs cur, nxt; scan_load(cur, SC, E, AV, b, ss, cr);
        for (int ch = 0; ch < T / 32; ++ch) {
            const int t0 = ch * 32;
            if (ch + 1 < T / 32) scan_load(nxt, SC, E, AV, b, t0 + 32 + ss, cr); else nxt = cur;
            {
                const f32x4 pr = bf4(cur.pr), pk = bf4(cur.pk), pv = bf4(cur.pv), qr = bf4(cur.qr), qk = bf4(cur.qk), qv = bf4(cur.qv);
                const f32x4 r = pr + (qr - pr) * mur, k = pk + (qk - pk) * muk, v = pv + (qv - pv) * muv;
                const f32x4 ev = bf4(cur.e4), av = bf4(cur.a4);
                f32x4 w; w[0] = __expf(-ev[0]); w[1] = __expf(-ev[1]); w[2] = __expf(-ev[2]); w[3] = __expf(-ev[3]);
                const f32x4 kr = k * kkw;
                const float n2 = red16((kr[0] * kr[0] + kr[1] * kr[1]) + (kr[2] * kr[2] + kr[3] * kr[3]));
                const float rn = 1.0f / fmaxf(sqrtf(n2), 1e-12f);
                const f32x4 kk = kr * rn;
                const f32x4 kp = k * (1.0f + (av - 1.0f) * kaw);
                const f32x4 bb = kk * av;
                const f32x4 rkk = r * kp * rkw;
                const float cb = red16((rkk[0] + rkk[1]) + (rkk[2] + rkk[3]));
                LAS float* d = L + ss * 384 + j4;
                *(LAS f32x4*)(d) = w; *(LAS f32x4*)(d + 64) = kk; *(LAS f32x4*)(d + 128) = bb; *(LAS f32x4*)(d + 192) = kp; *(LAS f32x4*)(d + 256) = r; *(LAS f32x4*)(d + 320) = v;
                if ((tid & 15) == 0) CB[((size_t)b * T + t0 + ss) * 16 + head] = cb;
            }
            __syncthreads();
            {
                const int k8 = lane & 7;
                const LAS float* d0 = L + k8 * 8; const LAS float* dv = L + 320 + rloc8;
                f32x4 w0 = *(const LAS f32x4*)(d0), w1 = *(const LAS f32x4*)(d0 + 4), kka = *(const LAS f32x4*)(d0 + 64), kkb = *(const LAS f32x4*)(d0 + 68), bba = *(const LAS f32x4*)(d0 + 128), bbb = *(const LAS f32x4*)(d0 + 132),
                      kpa = *(const LAS f32x4*)(d0 + 192), kpb = *(const LAS f32x4*)(d0 + 196), ra = *(const LAS f32x4*)(d0 + 256), rb = *(const LAS f32x4*)(d0 + 260);
                float vi = dv[0];
                float py = 0.f, yk0 = 0.f, yk1 = 0.f, yk2 = 0.f, yk3 = 0.f;
#pragma unroll
                for (int si = 0; si < 32; ++si) {
                    const int sn = (si + 1 < 32) ? (si + 1) : 31;
                    const LAS float* d = d0 + sn * 384;
                    const f32x4 w0n = *(const LAS f32x4*)(d), w1n = *(const LAS f32x4*)(d + 4), kkan = *(const LAS f32x4*)(d + 64), kkbn = *(const LAS f32x4*)(d + 68), bban = *(const LAS f32x4*)(d + 128), bbbn = *(const LAS f32x4*)(d + 132),
                                kpan = *(const LAS f32x4*)(d + 192), kpbn = *(const LAS f32x4*)(d + 196), ran = *(const LAS f32x4*)(d + 256), rbn = *(const LAS f32x4*)(d + 260);
                    const float vin = dv[sn * 384];
                    const f32x4 pa = Sa * kka + Sb * kkb;
                    float ps = (pa[0] + pa[1]) + (pa[2] + pa[3]);
                    red8x2(ps, py);
                    if (si > 0) { const int q = si - 1; if (q < 8) yk0 = (k8 == q) ? py : yk0; else if (q < 16) yk1 = (k8 == q - 8) ? py : yk1; else if (q < 24) yk2 = (k8 == q - 16) ? py : yk2; else yk3 = (k8 == q - 24) ? py : yk3; }
                    const float sa = -ps;
                    Sa = Sa * w0 + (sa * bba + vi * kpa); Sb = Sb * w1 + (sa * bbb + vi * kpb);
                    const f32x4 pb = Sa * ra + Sb * rb;
                    py = (pb[0] + pb[1]) + (pb[2] + pb[3]);
                    w0 = w0n; w1 = w1n; kka = kkan; kkb = kkbn; bba = bban; bbb = bbbn; kpa = kpan; kpb = kpbn; ra = ran; rb = rbn; vi = vin;
                }
                py = red8(py); yk3 = (k8 == 7) ? py : yk3;
                YB[k8 * 64 + rloc8] = yk0; YB[(8 + k8) * 64 + rloc8] = yk1; YB[(16 + k8) * 64 + rloc8] = yk2; YB[(24 + k8) * 64 + rloc8] = yk3;
            }
            __syncthreads();
            {
                const f32x4 yv = *(const LAS f32x4*)(YB + ss * 64 + j4);
                *(f32x4*)(Y + ((size_t)b * T + t0 + ss) * 1024 + head * 64 + j4) = yv;
            }
            cur = nxt;
        }
        { float* so = a.out + O_WKVP + (((size_t)b * 16 + head) * 64 + rloc8) * 64 + c8; *(f32x4*)(so) = Sa; *(f32x4*)(so + 4) = Sb; }
        __syncthreads();
    }
}

__device__ __forceinline__ void r3_rows(const Frame& F, const Args& a, unsigned char* ws) {
    const bf16* SC = (const bf16*)(ws + WS_SC); const bf16* GATE = (const bf16*)(ws + WS_GATE); const float* Y = (const float*)(ws + WS_Y); const float* CB = (const float*)(ws + WS_CB);
    bf16* OB = (bf16*)(ws + WS_OB);
    const int lane = F.lane, c0 = 16 * lane, head = lane >> 2;
    f32x4 gw[4], gb[4], mv[4];
#pragma unroll
    for (int j = 0; j < 4; ++j) { gw[j] = *(const f32x4*)(a.in[I_GNW] + c0 + 4 * j); gb[j] = *(const f32x4*)(a.in[I_GNB] + c0 + 4 * j); mv[j] = *(const f32x4*)(a.in[I_MU] + 2048 + c0 + 4 * j); }
    for (int m = F.gw; m < M; m += F.NGW) {
        const int t = m & (T - 1);
        f32x4 y[4]; float s = 0.f;
#pragma unroll
        for (int j = 0; j < 4; ++j) { y[j] = *(const f32x4*)(Y + (size_t)m * 1024 + c0 + 4 * j); s += (y[j][0] + y[j][1]) + (y[j][2] + y[j][3]); }
        const float mean = red4(s) * (1.0f / 64.0f); float q = 0.f;
#pragma unroll
        for (int j = 0; j < 4; ++j) { y[j] = y[j] - mean; q += (y[j][0] * y[j][0] + y[j][1] * y[j][1]) + (y[j][2] * y[j][2] + y[j][3] * y[j][3]); }
        const float rs = 1.0f / sqrtf(red4(q) * (1.0f / 64.0f) + GN_EPS);
        const float cb = CB[(size_t)m * 16 + head];
        const bf16* p = SC + (size_t)m * SCP + 2048 + c0;
        const v4u p0 = *(const v4u*)(p), p1 = *(const v4u*)(p + 8);
        v4u q0 = {0u, 0u, 0u, 0u}, q1 = {0u, 0u, 0u, 0u};
        if (t > 0) { q0 = *(const v4u*)(p - SCP); q1 = *(const v4u*)(p - SCP + 8); }
        const v4u g0 = *(const v4u*)(GATE + (size_t)m * 1024 + c0), g1 = *(const v4u*)(GATE + (size_t)m * 1024 + c0 + 8);
        const unsigned pw[8] = {p0.x, p0.y, p0.z, p0.w, p1.x, p1.y, p1.z, p1.w}, qw[8] = {q0.x, q0.y, q0.z, q0.w, q1.x, q1.y, q1.z, q1.w}, gw8[8] = {g0.x, g0.y, g0.z, g0.w, g1.x, g1.y, g1.z, g1.w};
        unsigned ow[8];
#pragma unroll
        for (int e = 0; e < 8; ++e) {
            const int j = e >> 1, i0 = (e & 1) * 2;
            const float pa = bflo(pw[e]), pb = bfhi(pw[e]), qa = bflo(qw[e]), qb = bfhi(qw[e]);
            const float va = pa + (qa - pa) * mv[j][i0], vb = pb + (qb - pb) * mv[j][i0 + 1];
            const float oa = (y[j][i0] * rs * gw[j][i0] + gb[j][i0] + cb * va) * bflo(gw8[e]);
            const float ob = (y[j][i0 + 1] * rs * gw[j][i0 + 1] + gb[j][i0 + 1] + cb * vb) * bfhi(gw8[e]);
            ow[e] = pg8::cvt_pk_bf16(oa, ob);
        }
        *(v4u*)(OB + (size_t)m * 1024 + c0) = (v4u){ow[0], ow[1], ow[2], ow[3]};
        *(v4u*)(OB + (size_t)m * 1024 + c0 + 8) = (v4u){ow[4], ow[5], ow[6], ow[7]};
    }
}

struct EpiPAB {
    static constexpr bool PERM = true, AFTER_DRAIN = false; static constexpr int MID_T = 8;
    const bf16* GT; bf16* MG;
    __device__ __forceinline__ void mid(pg8::f32x4 (&acc)[2][2][4][2], const pg8::Unit& u, int wr, int wc, int fr, int fq) const {
        const int cb = u.pn * 256 + wc * 32 + 8 * fq;
#pragma unroll
        for (int ai = 0; ai < 2; ++ai)
#pragma unroll
            for (int m = 0; m < 4; ++m) {
                const int row = u.pm * 256 + wr * 64 + fr + ai * 128 + m * 16;
#pragma unroll
                for (int bj = 0; bj < 2; ++bj) {
                    const int col = cb + bj * 128; const v4u ga = *(const v4u*)(GT + (size_t)row * 2048 + col), gb = *(const v4u*)(GT + (size_t)row * 2048 + 1024 + col);
                    const float r0 = bflo(ga.x) * __builtin_amdgcn_rcpf(bflo(gb.x)), r1 = bfhi(ga.x) * __builtin_amdgcn_rcpf(bfhi(gb.x)), r2 = bflo(ga.y) * __builtin_amdgcn_rcpf(bflo(gb.y)), r3 = bfhi(ga.y) * __builtin_amdgcn_rcpf(bfhi(gb.y));
                    const float r4 = bflo(ga.z) * __builtin_amdgcn_rcpf(bflo(gb.z)), r5 = bfhi(ga.z) * __builtin_amdgcn_rcpf(bfhi(gb.z)), r6 = bflo(ga.w) * __builtin_amdgcn_rcpf(bflo(gb.w)), r7 = bfhi(ga.w) * __builtin_amdgcn_rcpf(bfhi(gb.w));
                    acc[ai][bj][m][0] = (pg8::f32x4){acc[ai][bj][m][0][0] * r0, acc[ai][bj][m][0][1] * r1, acc[ai][bj][m][0][2] * r2, acc[ai][bj][m][0][3] * r3};
                    acc[ai][bj][m][1] = (pg8::f32x4){acc[ai][bj][m][1][0] * r4, acc[ai][bj][m][1][1] * r5, acc[ai][bj][m][1][2] * r6, acc[ai][bj][m][1][3] * r7};
                }
            }
    }
    __device__ __forceinline__ void operator()(const pg8::f32x4 (&acc)[2][2][4][2], const pg8::Unit& u, int wr, int wc, int fr, int fq) const {
        const int cb = u.pn * 256 + wc * 32 + 8 * fq;
#pragma unroll
        for (int ai = 0; ai < 2; ++ai)
#pragma unroll
            for (int m = 0; m < 4; ++m) {
                const int row = u.pm * 256 + wr * 64 + fr + ai * 128 + m * 16;
#pragma unroll
                for (int bj = 0; bj < 2; ++bj) {
                    const int col = cb + bj * 128; const v4u gq = *(const v4u*)(GT + (size_t)row * 2048 + 1024 + col);
                    const pg8::f32x4 v0 = acc[ai][bj][m][0], v1 = acc[ai][bj][m][1];
                    pg8::u32x4 w; w.x = pg8::cvt_pk_bf16(v0[0] * bflo(gq.x), v0[1] * bfhi(gq.x)); w.y = pg8::cvt_pk_bf16(v0[2] * bflo(gq.y), v0[3] * bfhi(gq.y));
                    w.z = pg8::cvt_pk_bf16(v1[0] * bflo(gq.z), v1[1] * bfhi(gq.z)); w.w = pg8::cvt_pk_bf16(v1[2] * bflo(gq.w), v1[3] * bfhi(gq.w));
                    *(pg8::u32x4*)(MG + (size_t)row * 1024 + col) = w;
                }
            }
    }
};
struct EpiRes {
    static constexpr bool PERM = true, AFTER_DRAIN = false; static constexpr int MID_T = 0;
    const float* base; float* Xo; bf16* Xb; float* ssq;
    __device__ __forceinline__ void operator()(const pg8::f32x4 (&acc)[2][2][4][2], const pg8::Unit& u, int wr, int wc, int fr, int fq) const {
        const int cb = u.pn * 256 + wc * 32 + 8 * fq;
#pragma unroll
        for (int ai = 0; ai < 2; ++ai)
#pragma unroll
            for (int m = 0; m < 4; ++m) {
                const int row = u.pm * 256 + wr * 64 + fr + ai * 128 + m * 16; float sq = 0.f;
#pragma unroll
                for (int bj = 0; bj < 2; ++bj) {
                    const int col = cb + bj * 128;
                    const f32x4 x0 = *(const f32x4*)(base + (size_t)row * 1024 + col), x1 = *(const f32x4*)(base + (size_t)row * 1024 + col + 4);
                    const pg8::f32x4 a0 = acc[ai][bj][m][0], a1 = acc[ai][bj][m][1];
                    const f32x4 o0 = {x0[0] + a0[0], x0[1] + a0[1], x0[2] + a0[2], x0[3] + a0[3]}, o1 = {x1[0] + a1[0], x1[1] + a1[1], x1[2] + a1[2], x1[3] + a1[3]};
                    *(f32x4*)(Xo + (size_t)row * 1024 + col) = o0; *(f32x4*)(Xo + (size_t)row * 1024 + col + 4) = o1;
                    sq += (o0[0] * o0[0] + o0[1] * o0[1]) + (o0[2] * o0[2] + o0[3] * o0[3]) + (o1[0] * o1[0] + o1[1] * o1[1]) + (o1[2] * o1[2] + o1[3] * o1[3]);
                    if (Xb) { pg8::u32x4 w; w.x = pg8::cvt_pk_bf16(o0[0], o0[1]); w.y = pg8::cvt_pk_bf16(o0[2], o0[3]); w.z = pg8::cvt_pk_bf16(o1[0], o1[1]); w.w = pg8::cvt_pk_bf16(o1[2], o1[3]);
                        *(pg8::u32x4*)(Xb + (size_t)row * 1024 + col) = w; }
                }
                sq += __shfl_xor(sq, 16); sq += __shfl_xor(sq, 32);
                if (fq == 0) atomicAdd(ssq + row, sq);
            }
    }
};
struct EpiGU {
    static constexpr bool PERM = true, AFTER_DRAIN = false; static constexpr int MID_T = 0;
    const float* ssq; bf16* ACT;
    __device__ __forceinline__ void operator()(const pg8::f32x4 (&acc)[2][2][4][2], const pg8::Unit& u, int wr, int wc, int fr, int fq) const {
        const int col = u.pn * 128 + wc * 32 + 8 * fq;
#pragma unroll
        for (int ai = 0; ai < 2; ++ai)
#pragma unroll
            for (int m = 0; m < 4; ++m) {
                const int row = u.pm * 256 + wr * 64 + fr + ai * 128 + m * 16;
                const float rstd = 1.0f / sqrtf(ssq[row] * (1.0f / DM) + NORM_EPS);
                float o[8];
#pragma unroll
                for (int n = 0; n < 2; ++n)
#pragma unroll
                    for (int j = 0; j < 4; ++j) { const float gv = acc[ai][0][m][n][j] * rstd, uv = acc[ai][1][m][n][j] * rstd; o[4 * n + j] = gv * sigmoidf_(gv) * uv; }
                pg8::u32x4 w; w.x = pg8::cvt_pk_bf16(o[0], o[1]); w.y = pg8::cvt_pk_bf16(o[2], o[3]); w.z = pg8::cvt_pk_bf16(o[4], o[5]); w.w = pg8::cvt_pk_bf16(o[6], o[7]);
                *(pg8::u32x4*)(ACT + (size_t)row * DFF + col) = w;
            }
    }
};

__device__ __forceinline__ f32x16 sgemm32_tile(const bf16* A, int lda, const bf16* Bt, int K, int n0, int lane) {
    const int r = lane & 31, h = lane >> 5;
    const bf16* ap = A + (size_t)r * lda + 8 * h; const bf16* bp = Bt + (size_t)(n0 + r) * K + 8 * h;
    f32x16 acc = {};
#pragma unroll 8
    for (int k = 0; k < K; k += 16) { const bf16x8 av = *(const bf16x8*)(ap + k), bv = *(const bf16x8*)(bp + k); acc = __builtin_amdgcn_mfma_f32_32x32x16_bf16(av, bv, acc, 0, 0, 0); }
    return acc;
}
#define SROW(rg, h) (((rg) & 3) + 8 * ((rg) >> 2) + 4 * (h))

template <int NT, class AF, class EP>
__device__ __forceinline__ void sgemm32_block(const Frame& F, int K, const bf16* Bt, int ldb, const int (&n0)[NT], const AF& afrag, const EP& epi) {
    LAS float* red = (LAS float*)(F.lds + RING_OFF);
    const int lane = F.lane, r = lane & 31, h = lane >> 5, kw = K / 8, k0 = F.wave * kw;
    f32x16 acc[NT];
#pragma unroll
    for (int t = 0; t < NT; ++t) acc[t] = (f32x16){};
#pragma unroll 2
    for (int k = k0; k < k0 + kw; k += 16) {
        const bf16x8 av = afrag(k);
#pragma unroll
        for (int t = 0; t < NT; ++t) { const bf16x8 bv = *(const bf16x8*)(Bt + (size_t)(n0[t] + r) * ldb + k + 8 * h); acc[t] = __builtin_amdgcn_mfma_f32_32x32x16_bf16(av, bv, acc[t], 0, 0, 0); }
    }
#pragma unroll
    for (int t = 0; t < NT; ++t)
#pragma unroll
        for (int rg = 0; rg < 16; ++rg) red[((t * 8 + F.wave) * 16 + rg) * 64 + lane] = acc[t][rg];
    __syncthreads();
#pragma unroll
    for (int j = 0; j < 2; ++j) {
        const int idx = F.tid + 512 * j, rg = idx >> 6, l2 = idx & 63;
        float v[NT];
#pragma unroll
        for (int t = 0; t < NT; ++t) { float s = 0.f;
#pragma unroll
            for (int w = 0; w < 8; ++w) s += red[((t * 8 + w) * 16 + rg) * 64 + l2];
            v[t] = s; }
        epi(SROW(rg, l2 >> 5), l2 & 31, v);
    }
    __syncthreads();
}
__device__ __forceinline__ float half_sum32(float v) {
    v = red16(v); v += __shfl_xor(v, 16); return v;
}

__device__ __forceinline__ void s_inproj(const Frame& F, unsigned char* ws) {
    float* PROJ = (float*)(ws + WS_SMP + SM_PROJ); const bf16* A = (const bf16*)(ws + WS_SMP + SM_HSN);
    for (int tl = F.vcu; tl < INP / 64; tl += F.G) {
        const int n0[2] = {64 * tl, 64 * tl + 32};
        sgemm32_block<2>(F, DM, (const bf16*)(ws + WS_WIN), DM, n0, [&](int k) { return *(const bf16x8*)(A + (size_t)(F.lane & 31) * DM + k + 8 * (F.lane >> 5)); },
            [&](int row, int c, const float (&v)[2]) { PROJ[(size_t)row * INP + n0[0] + c] = v[0]; PROJ[(size_t)row * INP + n0[1] + c] = v[1]; });
    }
}

__device__ __forceinline__ float block_max(float v, LAS float* red, int tid) {
#pragma unroll
    for (int o = 1; o < 64; o <<= 1) v = fmaxf(v, __shfl_xor(v, o));
    __syncthreads(); if ((tid & 63) == 0) red[tid >> 6] = v; __syncthreads();
    float r = red[0];
#pragma unroll
    for (int i = 1; i < 8; ++i) r = fmaxf(r, red[i]);
    return r;
}
__device__ __forceinline__ float block_sum(float v, LAS float* red, int tid) {
    v = wave_sum(v);
    __syncthreads(); if ((tid & 63) == 0) red[tid >> 6] = v; __syncthreads();
    float r = 0.f;
#pragma unroll
    for (int i = 0; i < 8; ++i) r += red[i];
    return r;
}

__device__ __forceinline__ void s_attn_item(const Frame& F, const Args& a, unsigned char* ws, int b, int head) {
    const float* PROJ = (const float*)(ws + WS_SMP + SM_PROJ) + (size_t)b * INP; const float* tab = (const float*)(ws + WS_TAB) + (size_t)2048 * 64;
    LAS float* sm = (LAS float*)(F.lds + RING_OFF);
    LAS float* qn = sm;
    LAS float* kn = sm + 64;
    LAS float* vn = sm + 128;
    LAS float* pj = sm + 192;
    LAS float* red = sm + 336;
    LAS float* part = sm + 352;
    LAS float* og = sm + 864;
    LAS float* lse = sm + 1056;
    const int tid = F.tid;
    for (int g = 0; g < 3; ++g) {
        const int dil = 1 << (2 * g), buf = (g == 0) ? 128 : (g == 1) ? 512 : 2048;
        const float* cache = a.in[I_C1 + g]; const size_t okv = (g == 0) ? O_KV1S : (g == 1) ? O_KV2S : O_KV3S;
        __syncthreads();
        if (tid < 64) {
            const int i = tid & 31, isk = tid >> 5; const float* src = PROJ + (3 * g + isk) * 512 + head * 64;
            const float x1 = src[2 * i], x2 = src[2 * i + 1], c = tab[2 * i], s = tab[2 * i + 1];
            const float o1 = x1 * c - x2 * s, o2 = x1 * s + x2 * c;
            if (isk == 0) { qn[i] = o1 * 0.125f; qn[32 + i] = o2 * 0.125f; }
            else { kn[i] = o1; kn[32 + i] = o2; float* ob = a.out + okv + ((size_t)b * 2 + 0) * 512 + head * 64; ob[i] = o1; ob[32 + i] = o2; }
        } else if (tid < 128) {
            const int d = tid - 64; const float v = PROJ[(3 * g + 2) * 512 + head * 64 + d]; vn[d] = v; a.out[okv + ((size_t)b * 2 + 1) * 512 + head * 64 + d] = v;
        }
        __syncthreads();
        const int j = tid >> 2, pt = tid & 3;
        const size_t crow = ((size_t)b * buf + (buf - dil * (j + 1))) * 2;
        const float* kc = cache + ((crow + 0) * 8 + head) * 64 + 16 * pt;
        float sc = 0.f;
#pragma unroll
        for (int d4 = 0; d4 < 4; ++d4) { const f32x4 kv = *(const f32x4*)(kc + 4 * d4); sc += kv[0] * qn[16 * pt + 4 * d4] + kv[1] * qn[16 * pt + 4 * d4 + 1] + kv[2] * qn[16 * pt + 4 * d4 + 2] + kv[3] * qn[16 * pt + 4 * d4 + 3]; }
        sc = red4(sc);
        float snew = 0.f;
        if (tid < 64) snew = qn[tid] * kn[tid];
        snew = block_sum(snew, red, tid);
        const float mx = fmaxf(block_max(sc, red, tid), snew);
        const float pe = __expf(sc - mx), pn = __expf(snew - mx);
        if (pt == 0) pj[j] = pe;
        if (tid == 0) pj[128] = pn;
        const float den = block_sum(pt == 0 ? pe : 0.f, red, tid) + pn;
        const int d = tid & 63, kg = tid >> 6; float acc = 0.f;
#pragma unroll 4
        for (int jj = 0; jj < 16; ++jj) { const int j2 = kg * 16 + jj; const size_t cr2 = ((size_t)b * buf + (buf - dil * (j2 + 1))) * 2; acc += pj[j2] * cache[((cr2 + 1) * 8 + head) * 64 + d]; }
        if (kg == 0) acc += pj[128] * vn[d];
        part[kg * 64 + d] = acc;
        __syncthreads();
        if (tid < 64) { float o = 0.f;
#pragma unroll
            for (int k2 = 0; k2 < 8; ++k2) o += part[k2 * 64 + tid];
            og[g * 64 + tid] = o / den; }
        if (tid == 0) lse[g] = mx + __logf(den);
    }
    __syncthreads();
    if (tid < 64) {
        const float l0 = lse[0], l1 = lse[1], l2 = lse[2], mx = fmaxf(l0, fmaxf(l1, l2));
        const float e0 = __expf(l0 - mx), e1 = __expf(l1 - mx), e2 = __expf(l2 - mx), inv = 1.0f / (e0 + e1 + e2);
        const float o = (e0 * og[tid] + e1 * og[64 + tid] + e2 * og[128 + tid]) * inv;
        ((bf16*)(ws + WS_SMP + SM_OA))[(size_t)b * 512 + head * 64 + tid] = (bf16)f2bf(o);
    }
    __syncthreads();
}

__device__ __forceinline__ void s_rwkv_item(const Frame& F, const Args& a, unsigned char* ws, int b, int head) {
    const float* P = (const float*)(ws + WS_SMP + SM_PROJ) + (size_t)b * INP + ACOLS;
    const float* prev = a.in[I_SSH] + (size_t)b * SCOLS; const float* mu = a.in[I_MU];
    LAS float* sm = (LAS float*)(F.lds + RING_OFF);
    LAS float* xl = sm;
    LAS float* rr = sm + 288;
    LAS float* kr = sm + 352;
    LAS float* vv = sm + 416;
    LAS float* part = sm + 480;
    LAS float* wv = sm + 2016;
    LAS float* av = sm + 2080;
    LAS float* gv = sm + 2144;
    LAS float* kkv = sm + 2208;
    LAS float* kpv = sm + 2272;
    LAS float* bbv = sm + 2336;
    LAS float* yv = sm + 2400;
    LAS float* red = sm + 2464;
    const int tid = F.tid, hc0 = head * 64;
    __syncthreads();
    if (tid < 288) { const int c = 3072 + tid; const float x = P[c], xm = x + (prev[c] - x) * mu[c];
        xl[tid] = (tid < 64) ? tanh_(xm) : (tid < 128) ? xm : sigmoidf_(xm); }
    else if (tid < 288 + 192) { const int e = tid - 288, which = e >> 6, d = e & 63, c = which * 1024 + hc0 + d; const float x = P[c], xm = x + (prev[c] - x) * mu[c];
        if (which == 0) rr[d] = xm; else if (which == 1) kr[d] = xm; else vv[d] = xm; }
    __syncthreads();
    {
        const int c = tid & 63, sl = tid >> 6; const float* W2 = a.in[I_W2] + hc0 + c; const float* A2 = a.in[I_A2] + hc0 + c; const float* G2 = a.in[I_G2] + hc0 + c;
        float sw = 0.f, sa = 0.f, sg = 0.f;
#pragma unroll
        for (int e = 0; e < 8; ++e) { const int k = sl * 8 + e; sw += xl[k] * W2[(size_t)k * BWID]; sa += xl[64 + k] * A2[(size_t)k * BWID]; }
#pragma unroll 4
        for (int e = 0; e < 20; ++e) { const int k = sl * 20 + e; sg += xl[128 + k] * G2[(size_t)k * BWID]; }
        part[sl * 64 + c] = sw; part[512 + sl * 64 + c] = sa; part[1024 + sl * 64 + c] = sg;
    }
    __syncthreads();
    float n2p = 0.f;
    if (tid < 64) {
        float sw = 0.f, sa = 0.f, sg = 0.f;
#pragma unroll
        for (int s2 = 0; s2 < 8; ++s2) { sw += part[s2 * 64 + tid]; sa += part[512 + s2 * 64 + tid]; sg += part[1024 + s2 * 64 + tid]; }
        const float e = 0.60653065971263342f * sigmoidf_(a.in[I_W0][hc0 + tid] + sw);
        wv[tid] = __expf(-e); const float aa = sigmoidf_(a.in[I_A0][hc0 + tid] + sa); av[tid] = aa; gv[tid] = sg;
        const float kraw = kr[tid] * a.in[I_KK][hc0 + tid]; n2p = kraw * kraw; kkv[tid] = kraw;
        kpv[tid] = kr[tid] * (1.0f + (aa - 1.0f) * a.in[I_KA][hc0 + tid]);
    }
    const float n2 = block_sum(n2p, red, tid);
    const float rn = 1.0f / fmaxf(sqrtf(n2), 1e-12f);
    float cbp = 0.f;
    if (tid < 64) { const float kk = kkv[tid] * rn; kkv[tid] = kk; bbv[tid] = kk * av[tid]; cbp = rr[tid] * kpv[tid] * a.in[I_RK][hc0 + tid]; }
    const float cb = block_sum(cbp, red, tid);
    {
        const int i = tid >> 3, j0 = (tid & 7) * 8;
        const float* Sp = a.in[I_SWKV] + (((size_t)b * 16 + head) * 64 + i) * 64 + j0;
        float* So = a.out + O_WKVS + (((size_t)b * 16 + head) * 64 + i) * 64 + j0;
        const f32x4 s0 = *(const f32x4*)(Sp), s1 = *(const f32x4*)(Sp + 4);
        float S[8] = {s0[0], s0[1], s0[2], s0[3], s1[0], s1[1], s1[2], s1[3]};
        float dot = 0.f;
#pragma unroll
        for (int j = 0; j < 8; ++j) dot += S[j] * kkv[j0 + j];
        const float sa = -red8(dot), vi = vv[i];
        float yd = 0.f;
#pragma unroll
        for (int j = 0; j < 8; ++j) { S[j] = S[j] * wv[j0 + j] + sa * bbv[j0 + j] + vi * kpv[j0 + j]; yd += S[j] * rr[j0 + j]; }
        *(f32x4*)(So) = (f32x4){S[0], S[1], S[2], S[3]}; *(f32x4*)(So + 4) = (f32x4){S[4], S[5], S[6], S[7]};
        yd = red8(yd);
        if ((tid & 7) == 0) yv[i] = yd;
    }
    __syncthreads();
    const float yi = (tid < 64) ? yv[tid] : 0.f;
    const float mean = block_sum(yi, red, tid) * (1.0f / 64.0f);
    const float dv = (tid < 64) ? (yi - mean) : 0.f;
    const float var = block_sum(dv * dv, red, tid) * (1.0f / 64.0f);
    if (tid < 64) {
        const float yn = dv * (1.0f / sqrtf(var + GN_EPS)) * a.in[I_GNW][hc0 + tid] + a.in[I_GNB][hc0 + tid];
        const float o = (yn + cb * vv[tid]) * gv[tid];
        ((bf16*)(ws + WS_SMP + SM_OB))[(size_t)b * 1024 + hc0 + tid] = (bf16)f2bf(o);
    }
    __syncthreads();
}

__device__ __forceinline__ void s_proj(const Frame& F, unsigned char* ws) {
    for (int tl = F.vcu; tl < 64; tl += F.G) {
        const int which = tl >> 5; const int n0[1] = {32 * (tl & 31)};
        const bf16* A = (const bf16*)(ws + WS_SMP + (which == 0 ? SM_OA : SM_OB)); const int K = which == 0 ? AWID : BWID;
        float* O = (float*)(ws + WS_SMP + (which == 0 ? SM_YA : SM_YB));
        sgemm32_block<1>(F, K, (const bf16*)(ws + WS_WA) + (which == 0 ? 0 : AWID), 1536, n0, [&](int k) { return *(const bf16x8*)(A + (size_t)(F.lane & 31) * K + k + 8 * (F.lane >> 5)); },
            [&](int row, int c, const float (&v)[1]) { O[(size_t)row * 1024 + n0[0] + c] = v[0]; });
    }
}
__device__ __forceinline__ void s_out(const Frame& F, const Args& a, unsigned char* ws) {
    const float* PROJ = (const float*)(ws + WS_SMP + SM_PROJ); const float* YA = (const float*)(ws + WS_SMP + SM_YA); const float* YBv = (const float*)(ws + WS_SMP + SM_YB);
    float* X1 = (float*)(ws + WS_SMP + SM_X1); bf16* X1B = (bf16*)(ws + WS_SMP + SM_X1B); float* SS = (float*)(ws + WS_SS) + M;
    for (int tl = F.vcu; tl < 32; tl += F.G) {
        const int n0[1] = {32 * tl};
        sgemm32_block<1>(F, DM, (const bf16*)(ws + WS_WO), DM, n0,
            [&](int k) { const int r = F.lane & 31; float mg[8];
#pragma unroll
                for (int j = 0; j < 8; ++j) { const int c = k + 8 * (F.lane >> 5) + j;
                    mg[j] = sigmoidf_(PROJ[(size_t)r * INP + ACOLS + SCP + c]) * YA[(size_t)r * 1024 + c] + sigmoidf_(PROJ[(size_t)r * INP + ACOLS + SCP + 1024 + c]) * YBv[(size_t)r * 1024 + c]; }
                return pack8(mg); },
            [&](int row, int c, const float (&v)[1]) { const int col = n0[0] + c; const float x = a.in[I_XS][(size_t)row * DM + col] + v[0];
                X1[(size_t)row * 1024 + col] = x; X1B[(size_t)row * 1024 + col] = (bf16)f2bf(x);
                const float sq = half_sum32(x * x); if (c == 0) atomicAdd(SS + row, sq); });
    }
}
__device__ __forceinline__ void s_gu(const Frame& F, unsigned char* ws) {
    const float* SS = (const float*)(ws + WS_SS) + M; bf16* ACTS = (bf16*)(ws + WS_SMP + SM_ACT); const bf16* A = (const bf16*)(ws + WS_SMP + SM_X1B);
    for (int tl = F.vcu; tl < 88; tl += F.G) {
        const int jt = tl >> 2, i = tl & 3; const int n0[2] = {256 * jt + 32 * i, 256 * jt + 32 * i + 128};
        sgemm32_block<2>(F, DM, (const bf16*)(ws + WS_WGU), DM, n0, [&](int k) { return *(const bf16x8*)(A + (size_t)(F.lane & 31) * DM + k + 8 * (F.lane >> 5)); },
            [&](int row, int c, const float (&v)[2]) { const float rstd = 1.0f / sqrtf(SS[row] * (1.0f / DM) + NORM_EPS); const float gv = v[0] * rstd, uv = v[1] * rstd;
                ACTS[(size_t)row * DFF + 128 * jt + 32 * i + c] = (bf16)f2bf(gv * sigmoidf_(gv) * uv); });
    }
}
__device__ __forceinline__ void s_down(const Frame& F, unsigned char* ws) {
    const float* X1 = (const float*)(ws + WS_SMP + SM_X1); float* X2 = (float*)(ws + WS_SMP + SM_X2); float* SS2 = (float*)(ws + WS_SS2) + M; const bf16* A = (const bf16*)(ws + WS_SMP + SM_ACT);
    for (int tl = F.vcu; tl < 32; tl += F.G) {
        const int n0[1] = {32 * tl};
        sgemm32_block<1>(F, DFF, (const bf16*)(ws + WS_WD), DFF, n0, [&](int k) { return *(const bf16x8*)(A + (size_t)(F.lane & 31) * DFF + k + 8 * (F.lane >> 5)); },
            [&](int row, int c, const float (&v)[1]) { const int col = n0[0] + c; const float x = X1[(size_t)row * 1024 + col] + v[0];
                X2[(size_t)row * 1024 + col] = x; const float sq = half_sum32(x * x); if (c == 0) atomicAdd(SS2 + row, sq); });
    }
}
__device__ __forceinline__ void final_norm(const Frame& F, const Args& a, unsigned char* ws) {
    const float* gfin = a.in[I_NFIN]; const float* SS2 = (const float*)(ws + WS_SS2);
    f32x4 gv[4];
#pragma unroll
    for (int j = 0; j < 4; ++j) gv[j] = *(const f32x4*)(gfin + 4 * F.lane + 256 * j);
    for (int m = F.gw; m < M + SB; m += F.NGW) {
        const float* src = (m < M) ? a.out + O_YP + (size_t)m * DM : (const float*)(ws + WS_SMP + SM_X2) + (size_t)(m - M) * DM;
        float* dst = (m < M) ? a.out + O_YP + (size_t)m * DM : a.out + O_YS + (size_t)(m - M) * DM;
        const float rstd = 1.0f / sqrtf(SS2[m] * (1.0f / DM) + NORM_EPS);
#pragma unroll
        for (int j = 0; j < 4; ++j) { const f32x4 v = *(const f32x4*)(src + 4 * F.lane + 256 * j); *(f32x4*)(dst + 4 * F.lane + 256 * j) = v * rstd * gv[j]; }
    }
}

namespace cs {
constexpr int IA = 0, IB = 4352, IBBT = 8704, IKBT = 11264, IVT = 13824, IVF = 16384, IGC = 20480, ICB = 20736, IMG_SZ = 20992;
constexpr int SM_OFF = 3 * IMG_SZ, SM_SZ = 2560, SMT = 0, SMLAK = 640, SMMRB = 1280, SMMRK = 1920;
constexpr int LB_OFF = SM_OFF + 2 * SM_SZ, YT_OFF = LB_OFF + 1024, YT_SZ = 4096, END = YT_OFF + 2 * YT_SZ;
static_assert(END <= 131072, "chunked scan LDS");
}
__device__ __forceinline__ bf16x8 ld2x8(const LAS unsigned char* p0, const LAS unsigned char* p1) {
    const u32x2 a = *(const LAS u32x2*)p0, b = *(const LAS u32x2*)p1; return __builtin_bit_cast(bf16x8, (v4u){a.x, a.y, b.x, b.y});
}
__device__ __forceinline__ void wave_sum2(float& a, float& b) {
    red16x2(a, b);
    const int ai = __builtin_bit_cast(int, a), bi = __builtin_bit_cast(int, b);
#define RL_(x, l) __builtin_bit_cast(float, __builtin_amdgcn_readlane(x, l))
    const float a0 = RL_(ai, 0), a1 = RL_(ai, 16), a2 = RL_(ai, 32), a3 = RL_(ai, 48), b0 = RL_(bi, 0), b1 = RL_(bi, 16), b2 = RL_(bi, 32), b3 = RL_(bi, 48);
#undef RL_
    a = (a0 + a1) + (a2 + a3); b = (b0 + b1) + (b2 + b3);
}
struct CsLd { unsigned short pr, pk, pv, qr, qk, qv, av; float lw, lwp; };
__device__ __forceinline__ void cs_load(CsLd& R, const bf16* SC, const float* LW, const bf16* AV, int b, int t, int col) {
    const size_t m = (size_t)b * T + t; const bf16* p = SC + m * SCP + col;
    R.pr = p[0]; R.pk = p[1024]; R.pv = p[2048];
    if (t > 0) { R.qr = p[-SCP]; R.qk = p[1024 - SCP]; R.qv = p[2048 - SCP]; } else { R.qr = 0; R.qk = 0; R.qv = 0; }
    R.av = AV[m * 1024 + col]; R.lw = LW[m * 1024 + col]; R.lwp = ((t & 15) != 0) ? LW[(m - 1) * 1024 + col] : 0.f;
}
__device__ __forceinline__ void scan_chunked(const Frame& F, const Args& a, unsigned char* ws, int chain) {
    using namespace cs;
    const bf16* SC = (const bf16*)(ws + WS_SC); const float* LW = (const float*)(ws + WS_Y); const bf16* AV = (const bf16*)(ws + WS_AV); const bf16* GATE = (const bf16*)(ws + WS_GATE);
    bf16* OB = (bf16*)(ws + WS_OAB) + 512;
    LAS unsigned char* lds = F.lds + RING_OFF;
    const int lane = F.lane, wave = F.wave, b = chain >> 4, head = chain & 15, hc = head * 64;
    const int r32 = lane & 31, h = lane >> 5;
    constexpr int NCH = T / 16;
    f32x16 ST0 = {}, ST1 = {};
    CsLd ld[3], ldn[3]; float lwend = 0.f, lwendn = 0.f; unsigned short gt[3] = {0, 0, 0}, gtn[3] = {0, 0, 0};
    float mur = 0.f, muk = 0.f, muv = 0.f, kkw = 0.f, kaw = 0.f, rkw = 0.f, gnw = 0.f, gnb = 0.f;
    const int wp = wave - 3;
    const int nst = (wave >= 3) ? 3 : (wave == 0 ? 1 : 0), sbase = (wave >= 3) ? wp : 15;
    if (nst > 0) {
        const int c = hc + lane;
        mur = a.in[I_MU][c]; muk = a.in[I_MU][1024 + c]; muv = a.in[I_MU][2048 + c]; kkw = a.in[I_KK][c]; kaw = a.in[I_KA][c]; rkw = a.in[I_RK][c]; gnw = a.in[I_GNW][c]; gnb = a.in[I_GNB][c];
#pragma unroll
        for (int i = 0; i < 3; ++i) { const int s = sbase + 5 * i; if (i < nst) cs_load(ld[i], SC, LW, AV, b, s, c); }
        lwend = LW[((size_t)b * T + 15) * 1024 + c];
    }
    for (int it = -2; it <= NCH; ++it) {
        const int nA = it + 2, nB = it + 1, nC = it, nD = it - 1;
        if (wave == 2) {
            if (nB >= 0 && nB < NCH) {
                const LAS unsigned char* img = lds + (nB % 3) * IMG_SZ; LAS unsigned char* sm = lds + SM_OFF + (nB & 1) * SM_SZ; LAS float* Lb = (LAS float*)(lds + LB_OFF);
                f32x16 P = {};
#pragma unroll
                for (int ks = 0; ks < 4; ++ks) {
                    const LAS unsigned char* pa = img + IA + r32 * 136 + (16 * ks + 8 * h) * 2; const LAS unsigned char* pb = img + IB + r32 * 136 + (16 * ks + 8 * h) * 2;
                    P = __builtin_amdgcn_mfma_f32_32x32x16_bf16(ld2x8(pa, pa + 8), ld2x8(pb, pb + 8), P, 0, 0, 0);
                }
                const int sp = r32, s16 = r32 & 15; const bool lo = sp < 16;
#pragma unroll
                for (int rg = 0; rg < 8; ++rg) {
                    const int t = (rg & 3) + 8 * (rg >> 2) + 4 * h; const float v = (s16 < t) ? P[rg] : 0.f;
                    if (lo) Lb[t * 16 + s16] = v; else *(LAS bf16*)(sm + SMLAK + t * 40 + s16 * 2) = (bf16)(cvtpk_s(v, 0.f) & 0xffff);
                }
#pragma unroll
                for (int rg = 8; rg < 16; ++rg) {
                    const int t = (rg & 3) + 8 * ((rg >> 2) - 2) + 4 * h; const float v = (s16 <= t) ? P[rg] : 0.f;
                    *(LAS bf16*)(sm + (lo ? SMMRB : SMMRK) + t * 40 + s16 * 2) = (bf16)(cvtpk_s(v, 0.f) & 0xffff);
                }
                float Tr[16];
                const int cc = lane & 15;
#pragma unroll
                for (int t = 0; t < 16; ++t) {
                    float acc = (cc == t) ? 1.0f : 0.0f;
#pragma unroll
                    for (int u4 = 0; u4 < (t + 3) / 4; ++u4) {
                        const f32x4 lv = *(const LAS f32x4*)(Lb + t * 16 + 4 * u4);
#pragma unroll
                        for (int q = 0; q < 4; ++q) { const int u = 4 * u4 + q; if (u < t) acc += lv[q] * Tr[u]; }
                    }
                    Tr[t] = acc;
                }
                if (lane < 16) {
#pragma unroll
                    for (int t = 0; t < 16; ++t) *(LAS bf16*)(sm + SMT + t * 40 + cc * 2) = (bf16)(cvtpk_s(Tr[t], 0.f) & 0xffff);
                }
            }
        } else if (wave < 2) {
            if (nC >= 0 && nC < NCH) {
                const LAS unsigned char* img = lds + (nC % 3) * IMG_SZ; const LAS unsigned char* sm = lds + SM_OFF + (nC & 1) * SM_SZ; LAS float* YT = (LAS float*)(lds + YT_OFF + (nC & 1) * YT_SZ);
                const int vcol = 32 * wave + r32, t16 = r32 & 15;
                bf16x8 Bf[4];
                { float tmp[8];
#pragma unroll
                  for (int ks = 0; ks < 4; ++ks) {
#pragma unroll
                      for (int e = 0; e < 8; ++e) tmp[e] = (ks < 2) ? ST0[8 * (ks & 1) + e] : ST1[8 * (ks & 1) + e];
                      Bf[ks] = pack8(tmp); } }
                const LAS unsigned char* pv = img + IVT + vcol * 40 + 16 * h; const bf16x8 Vf = ld2x8(pv, pv + 8);
                f32x16 X = {};
                { const LAS unsigned char* p = sm + SMLAK + t16 * 40 + 16 * h; X = __builtin_amdgcn_mfma_f32_32x32x16_bf16(ld2x8(p, p + 8), Vf, X, 0, 0, 0); }
#pragma unroll
                for (int ks = 0; ks < 4; ++ks) { const LAS unsigned char* p = img + IA + t16 * 136 + (16 * ks + 4 * h) * 2; X = __builtin_amdgcn_mfma_f32_32x32x16_bf16(ld2x8(p, p + 16), Bf[ks], X, 0, 0, 0); }
                f32x16 SA = {};
                { float tmp[8];
#pragma unroll
                  for (int e = 0; e < 8; ++e) tmp[e] = X[e];
                  const LAS unsigned char* p = sm + SMT + t16 * 40 + 8 * h; SA = __builtin_amdgcn_mfma_f32_32x32x16_bf16(ld2x8(p, p + 16), pack8(tmp), SA, 0, 0, 0); }
                bf16x8 SAb;
                { float tmp[8];
#pragma unroll
                  for (int e = 0; e < 8; ++e) tmp[e] = SA[e];
                  SAb = pack8(tmp); }
                f32x16 Y = {};
                { const LAS unsigned char* p = sm + SMMRK + t16 * 40 + 16 * h; Y = __builtin_amdgcn_mfma_f32_32x32x16_bf16(ld2x8(p, p + 8), Vf, Y, 0, 0, 0); }
                { const LAS unsigned char* p = sm + SMMRB + t16 * 40 + 8 * h; Y = __builtin_amdgcn_mfma_f32_32x32x16_bf16(ld2x8(p, p + 16), SAb, Y, 0, 0, 0); }
#pragma unroll
                for (int ks = 0; ks < 4; ++ks) { const LAS unsigned char* p = img + IA + (16 + t16) * 136 + (16 * ks + 4 * h) * 2; Y = __builtin_amdgcn_mfma_f32_32x32x16_bf16(ld2x8(p, p + 16), Bf[ks], Y, 0, 0, 0); }
#pragma unroll
                for (int rg = 0; rg < 8; ++rg) YT[((rg & 3) + 8 * (rg >> 2) + 4 * h) * 64 + vcol] = Y[rg];
                const LAS float* GC = (const LAS float*)(img + IGC);
#pragma unroll
                for (int jt = 0; jt < 2; ++jt) {
                    f32x16 S = jt == 0 ? ST0 : ST1;
#pragma unroll
                    for (int g4 = 0; g4 < 4; ++g4) { const f32x4 dc = *(const LAS f32x4*)(GC + 32 * jt + 8 * g4 + 4 * h);
#pragma unroll
                        for (int q = 0; q < 4; ++q) S[4 * g4 + q] *= dc[q]; }
                    const int jrow = 32 * jt + r32;
                    { const LAS unsigned char* p = img + IBBT + jrow * 40 + 8 * h; S = __builtin_amdgcn_mfma_f32_32x32x16_bf16(ld2x8(p, p + 16), SAb, S, 0, 0, 0); }
                    { const LAS unsigned char* p = img + IKBT + jrow * 40 + 16 * h; S = __builtin_amdgcn_mfma_f32_32x32x16_bf16(ld2x8(p, p + 8), Vf, S, 0, 0, 0); }
                    if (jt == 0) ST0 = S; else ST1 = S;
                }
            }
        }
        auto produce = [&](auto NSTC) {
            constexpr int NST = decltype(NSTC)::value;
            const int c = hc + lane;
            if (nA + 1 < NCH) {
#pragma unroll
                for (int i = 0; i < NST; ++i) { const int s = sbase + 5 * i; cs_load(ldn[i], SC, LW, AV, b, (nA + 1) * 16 + s, c); }
                lwendn = LW[((size_t)b * T + (nA + 1) * 16 + 15) * 1024 + c];
            }
            if (nD + 1 >= 0 && nD + 1 < NCH) {
#pragma unroll
                for (int i = 0; i < NST; ++i) { const int s = sbase + 5 * i; gtn[i] = GATE[((size_t)b * T + (nD + 1) * 16 + s) * 1024 + c]; }
            }
            if (nD >= 0 && nD < NCH) {
                const LAS unsigned char* img = lds + (nD % 3) * IMG_SZ; const LAS float* YT = (const LAS float*)(lds + YT_OFF + (nD & 1) * YT_SZ);
#pragma unroll
                for (int i = 0; i < NST; ++i) { const int s = sbase + 5 * i; {
                    const size_t m = (size_t)b * T + nD * 16 + s;
                    const float gtv = bf2f(gt[i]);
                    const float y = YT[s * 64 + lane]; float s1 = y, s2 = y * y; wave_sum2(s1, s2);
                    const float mean = s1 * (1.0f / 64.0f), var = fmaxf(s2 * (1.0f / 64.0f) - mean * mean, 0.f);
                    const float yn = (y - mean) * __builtin_amdgcn_rsqf(var + GN_EPS) * gnw + gnb;
                    const float cbn = ((const LAS float*)(img + ICB))[s], vv = ((const LAS float*)(img + IVF))[s * 64 + lane];
                    OB[m * 1536 + c] = (bf16)(cvtpk_s((yn + cbn * vv) * gtv, 0.f) & 0xffff);
                } }
            }
            if (nA < NCH) {
                LAS unsigned char* img = lds + (nA % 3) * IMG_SZ;
                const float gC = __expf(lwend);
#pragma unroll
                for (int i = 0; i < NST; ++i) { const int s = sbase + 5 * i; {
                    const CsLd& R = ld[i];
                    const float pr = bf2f(R.pr), pk = bf2f(R.pk), pv = bf2f(R.pv), qr = bf2f(R.qr), qk = bf2f(R.qk), qv = bf2f(R.qv), av = bf2f(R.av);
                    const float r = pr + (qr - pr) * mur, k = pk + (qk - pk) * muk, v = pv + (qv - pv) * muv;
                    const float gs = __expf(R.lw), gp = __expf(R.lwp), ig = __expf(-R.lw), rat = __expf(lwend - R.lw);
                    const float kr = k * kkw, kp = k * (1.0f + (av - 1.0f) * kaw);
                    float n2 = kr * kr, cb = r * kp * rkw; wave_sum2(n2, cb);
                    const float kk = kr * __builtin_amdgcn_rsqf(fmaxf(n2, 1e-24f)), beta = kk * av;
                    const unsigned w0 = cvtpk_s(-kk * gp, r * gs), w1 = cvtpk_s(beta * ig, kp * ig), w2 = cvtpk_s(beta * rat, kp * rat), w3 = cvtpk_s(v, 0.f);
                    *(LAS bf16*)(img + IA + s * 136 + lane * 2) = (bf16)(w0 & 0xffff); *(LAS bf16*)(img + IA + (16 + s) * 136 + lane * 2) = (bf16)(w0 >> 16);
                    *(LAS bf16*)(img + IB + s * 136 + lane * 2) = (bf16)(w1 & 0xffff); *(LAS bf16*)(img + IB + (16 + s) * 136 + lane * 2) = (bf16)(w1 >> 16);
                    *(LAS bf16*)(img + IBBT + lane * 40 + s * 2) = (bf16)(w2 & 0xffff); *(LAS bf16*)(img + IKBT + lane * 40 + s * 2) = (bf16)(w2 >> 16);
                    *(LAS bf16*)(img + IVT + lane * 40 + s * 2) = (bf16)(w3 & 0xffff);
                    ((LAS float*)(img + IVF))[s * 64 + lane] = v;
                    if (lane == 0) ((LAS float*)(img + ICB))[s] = cb;
                    if (NST == 1) ((LAS float*)(img + IGC))[lane] = gC;
                } }
            }
#pragma unroll
            for (int i = 0; i < NST; ++i) { ld[i] = ldn[i]; gt[i] = gtn[i]; }
            lwend = lwendn;
        };
        if (wave >= 3) produce(std::integral_constant<int, 3>{}); else if (wave == 0) produce(std::integral_constant<int, 1>{});
        __syncthreads();
    }
    if (wave < 2) {
        float* so = a.out + O_WKVP + (((size_t)b * 16 + head) * 64 + 32 * wave + r32) * 64;
#pragma unroll
        for (int rg = 0; rg < 16; ++rg) { const int j = (rg & 3) + 8 * (rg >> 2) + 4 * h; so[j] = ST0[rg]; so[32 + j] = ST1[rg]; }
    }
    __syncthreads();
}
__global__ void __launch_bounds__(NWAVES * 64, 2) fwd_kernel(Args args) {
    extern __shared__ __attribute__((aligned(16))) unsigned char lds[];
    Frame F;
    F.lds = (LAS unsigned char*)lds;
    F.MISC = (volatile LAS unsigned*)(F.lds + MISC_OFF);
    F.tid = threadIdx.x; F.lane = F.tid & 63; F.wave = __builtin_amdgcn_readfirstlane(F.tid >> 6);
    F.G = gridDim.x; { const int bx = blockIdx.x; F.vcu = (F.G % 8 == 0) ? (bx % 8) * (F.G / 8) + bx / 8 : bx; }
    F.gw = F.vcu * NWAVES + F.wave; F.NGW = F.G * NWAVES;
    unsigned char* ws = args.ws;
    F.ctl = (gu32*)(ws + WS_CTL);
    for (int u = F.tid; u < (LDS_BYTES - LDSCTL_OFF) / 4; u += NWAVES * 64) ((LAS unsigned*)(F.lds + LDSCTL_OFF))[u] = 0u;
    __syncthreads();
    XcdBarrier bar = xcd_barrier_post((unsigned*)(F.ctl + CW_BAR), F.MISC + 8);
#define GRID_BAR() do { xcd_barrier(bar); int t_ = threadIdx.x; asm volatile("" : "+v"(t_)); F.tid = t_; F.lane = t_ & 63; } while (0)
#ifdef PROBE_TIMING
    unsigned long long ts_[14]; int nts_ = 0;
#define STAMP() do { ts_[nts_++] = __builtin_amdgcn_s_memrealtime(); } while (0)
    STAMP();
#else
#define STAMP() do {} while (0)
#endif

    p0_prologue(F, args, ws);
    GRID_BAR(); STAMP();

    const int NSCAN = (F.G >= 256) ? 128 : 0;
    EpiIn Ein{(bf16*)(ws + WS_Q), (bf16*)(ws + WS_K), (bf16*)(ws + WS_VT), (bf16*)(ws + WS_SC), (bf16*)(ws + WS_GT), args.out, (const float*)(ws + WS_TAB)};
    {
        s_inproj(F, ws);
        pg8::Gemm g{(const pg8::bf16_t*)(ws + WS_XN), (const pg8::bf16_t*)(ws + WS_WIN), M, INP, opaque_int(DM)};
        TileListOrder S; S.init(M, 20, 20, 18, 0, F.G, (int)blockIdx.x);
        pg8::gemm_phase<EpiIn, TileListOrder, true, true>(F.lds + RING_OFF, g, S, Ein);
    }
    GRID_BAR(); STAMP();

    r1_rows(F, (const bf16*)(ws + WS_SC), args.in[I_MU], (bf16*)(ws + WS_A1), (bf16*)(ws + WS_A2));
    GRID_BAR(); STAMP();

    {
        { pg8::Gemm g{(const pg8::bf16_t*)(ws + WS_A1), (const pg8::bf16_t*)(ws + WS_WWA), M, 2048, opaque_int(128)}; pg8::StaticOrder S; S.init(M, 2048, F.G, (int)blockIdx.x);
          EpiWA E{(float*)(ws + WS_Y), (bf16*)(ws + WS_AV), args.in[I_W0], args.in[I_A0]};
          pg8::gemm_phase<EpiWA, pg8::StaticOrder, true, true>(F.lds + RING_OFF, g, S, E); }
        { pg8::Gemm g{(const pg8::bf16_t*)(ws + WS_A2), (const pg8::bf16_t*)(ws + WS_WG), M, 1024, opaque_int(256)}; pg8::StaticOrder S; S.init(M, 1024, F.G, (int)blockIdx.x);
          EpiPlain E{(bf16*)(ws + WS_GATE), 1024};
          pg8::gemm_phase<EpiPlain, pg8::StaticOrder, true, true>(F.lds + RING_OFF, g, S, E); }
    }
    GRID_BAR(); STAMP();

    {
        if (NSCAN == 0) { for (int ch = F.vcu; ch < NB * BHEADS; ch += F.G) scan_chunked(F, args, ws, ch); }
        else if ((int)blockIdx.x < NSCAN) scan_chunked(F, args, ws, (int)blockIdx.x);
        if (NSCAN == 0 || (int)blockIdx.x >= NSCAN) {
            pg8::Gemm g{(const pg8::bf16_t*)(ws + WS_XN), (const pg8::bf16_t*)(ws + WS_WIN), M, INP, opaque_int(DM)};
            TileListOrder S; S.init(M, 20, 18, 0, 38, F.G - NSCAN, (int)blockIdx.x - NSCAN);
            pg8::gemm_phase<EpiIn, TileListOrder, true, true>(F.lds + RING_OFF, g, S, Ein);
        }
    }
    GRID_BAR(); STAMP();

    {
        for (int it = F.vcu; it < NB * AHEADS * 4; it += F.G)
            attn_item(F, it, (const bf16*)(ws + WS_Q), (const bf16*)(ws + WS_K), (const bf16*)(ws + WS_VT), (bf16*)(ws + WS_OG), (float*)(ws + WS_LSE), (bf16*)(ws + WS_OAB));
        __syncthreads();
        for (int it = F.vcu; it < SB * AHEADS; it += F.G) s_attn_item(F, args, ws, it >> 3, it & 7);
        for (int it = F.vcu; it < SB * BHEADS; it += F.G) s_rwkv_item(F, args, ws, it >> 4, it & 15);
        { const float* PROJ = (const float*)(ws + WS_SMP + SM_PROJ);
          for (int e = F.vcu * 512 + F.tid; e < SB * SCOLS; e += F.G * 512) { const int b = e / SCOLS, c = e - b * SCOLS; args.out[O_SHS + e] = PROJ[(size_t)b * INP + ACOLS + c]; } }
    }
    GRID_BAR(); STAMP();

    {
        s_proj(F, ws);
        { pg8::Gemm g{(const pg8::bf16_t*)(ws + WS_OAB), (const pg8::bf16_t*)(ws + WS_WA), M, DM, opaque_int(1536)}; pg8::StaticOrder S; S.init(M, DM, F.G, (int)blockIdx.x);
          EpiPAB E{(const bf16*)(ws + WS_GT), (bf16*)(ws + WS_MG)};
          pg8::gemm_phase<EpiPAB, pg8::StaticOrder, true, true>(F.lds + RING_OFF, g, S, E); }
    }
    GRID_BAR(); STAMP();

    {
        s_out(F, args, ws);
        pg8::Gemm g{(const pg8::bf16_t*)(ws + WS_MG), (const pg8::bf16_t*)(ws + WS_WO), M, DM, opaque_int(DM)}; pg8::StaticOrder S; S.init(M, DM, F.G, (int)blockIdx.x);
        EpiRes E{args.in[I_XP], (float*)(ws + WS_X1), (bf16*)(ws + WS_X1B), (float*)(ws + WS_SS)};
        pg8::gemm_phase<EpiRes, pg8::StaticOrder, true, true>(F.lds + RING_OFF, g, S, E);
    }
    GRID_BAR(); STAMP();

    {
        s_gu(F, ws);
        pg8::Gemm g{(const pg8::bf16_t*)(ws + WS_X1B), (const pg8::bf16_t*)(ws + WS_WGU), M, GU, opaque_int(DM)}; pg8::StaticOrder S; S.init(M, GU, F.G, (int)blockIdx.x);
        EpiGU E{(const float*)(ws + WS_SS), (bf16*)(ws + WS_ACT)};
        pg8::gemm_phase<EpiGU, pg8::StaticOrder, true, true>(F.lds + RING_OFF, g, S, E);
    }
    GRID_BAR(); STAMP();

    {
        s_down(F, ws);
        pg8::Gemm g{(const pg8::bf16_t*)(ws + WS_ACT), (const pg8::bf16_t*)(ws + WS_WD), M, DM, opaque_int(DFF)}; pg8::StaticOrder S; S.init(M, DM, F.G, (int)blockIdx.x);
        EpiRes E{(const float*)(ws + WS_X1), args.out + O_YP, nullptr, (float*)(ws + WS_SS2)};
        pg8::gemm_phase<EpiRes, pg8::StaticOrder, true, true>(F.lds + RING_OFF, g, S, E);
    }
    GRID_BAR(); STAMP();

    final_norm(F, args, ws);
#ifdef PROBE_TIMING
    GRID_BAR(); STAMP();
    if (blockIdx.x == 0 && F.tid == 0) {
        const size_t offs[12] = {O_YP, O_YS, O_KV1P, O_KV2P, O_KV3P, O_SHP, O_WKVP, O_KV1S, O_KV2S, O_KV3S, O_SHS, O_WKVS};
        for (int k = 0; k < 11; ++k) args.out[offs[k]] = (float)(ts_[k + 1] - ts_[k]) * 0.01f;
        args.out[offs[11]] = (float)(ts_[11] - ts_[0]) * 0.01f;
    }
#endif
}

extern "C" void kernel_launch(void* const* d_in, const int* in_sizes, int n_in, void* d_out, int out_size, void* d_ws, size_t ws_size, hipStream_t stream) {
    static int grid = 0;
    if (grid == 0) {
        if (n_in != 28 || in_sizes[0] != M * DM || (size_t)out_size != O_END || ws_size < WS_END) {
            fprintf(stderr, "kernel_launch: unexpected shapes: n_in %d in0 %d out %d ws %zu (need %zu)\n", n_in, n_in > 0 ? in_sizes[0] : -1, out_size, ws_size, (size_t)WS_END); grid = -1; return; }
        int dev = 0, cus = 0, per_cu = 0;
        if (hipGetDevice(&dev) != hipSuccess || hipDeviceGetAttribute(&cus, hipDeviceAttributeMultiprocessorCount, dev) != hipSuccess) { grid = -1; return; }
        if (hipFuncSetAttribute((const void*)fwd_kernel, hipFuncAttributeMaxDynamicSharedMemorySize, LDS_BYTES) != hipSuccess) { fprintf(stderr, "kernel_launch: hipFuncSetAttribute failed\n"); grid = -1; return; }
        if (hipOccupancyMaxActiveBlocksPerMultiprocessor(&per_cu, (const void*)fwd_kernel, NWAVES * 64, LDS_BYTES) != hipSuccess || per_cu < 1) {
            fprintf(stderr, "kernel_launch: occupancy query says %d blocks per CU\n", per_cu); (void)hipGetLastError(); grid = -1; return; }
        grid = cus;
    }
    if (grid < 0) return;
    if (hipMemsetAsync((char*)d_ws + WS_CTL, 0, CTL_ZERO_BYTES, stream) != hipSuccess) return;
    Args a{};
    for (int i = 0; i < 28; ++i) a.in[i] = (const float*)d_in[i];
    a.out = (float*)d_out; a.ws = (unsigned char*)d_ws;
    hipLaunchKernelGGL(fwd_kernel, dim3(grid), dim3(NWAVES * 64), LDS_BYTES, stream, a);
}
```
